# Optimizing an MI355X kernel written in HIP

```python
import jax, jax.numpy as jnp
from jax import lax
import numpy as np

D_MODEL = 1024
BATCH = 8
SEQ = 8192
DEPTH = 1

GRID_W = 64
CTX_LEN = 256

NA_HEADS = 8
NA_HEAD_DIM = 64
NA_WIN_ROWS = 8
NA_WIN_COLS = 16
NA_WIDTH = NA_HEADS * NA_HEAD_DIM

GLA_HEADS = 4
GLA_KEY_DIM = 64
GLA_VAL_DIM = 128
GLA_QK_WIDTH = GLA_HEADS * GLA_KEY_DIM
GLA_V_WIDTH = GLA_HEADS * GLA_VAL_DIM
GLA_GATE_RANK = 16
GLA_GATE_TAU = 16.0
GLA_CHUNK = 64

MIX_WIDTH = NA_WIDTH + GLA_V_WIDTH
IN_SPLITS = (NA_WIDTH, NA_WIDTH, NA_WIDTH, GLA_QK_WIDTH, GLA_QK_WIDTH,
             GLA_V_WIDTH, GLA_V_WIDTH, GLA_GATE_RANK, GLA_GATE_RANK)
IN_WIDTH = 3 * NA_WIDTH + 2 * GLA_QK_WIDTH + 2 * GLA_V_WIDTH + 2 * GLA_GATE_RANK

FFN_HIDDEN = ((8 * D_MODEL + 3 * 256 - 1) // (3 * 256)) * 256
ROPE_BASE = 10000.0
NORM_EPS = 1e-6

kernel_name = "hybrid_na_gla_dit_layer"


def rmsnorm(x, g):
    xf = x.astype(jnp.float32)
    y = xf * lax.rsqrt(jnp.mean(xf * xf, axis=-1, keepdims=True) + NORM_EPS)
    return (y * g.astype(jnp.float32)).astype(x.dtype)


def modulate(x, shift, scale):
    return x * (1 + scale) + shift


def ada_mod(cond, w_mod, b_mod):
    return jnp.split(jax.nn.silu(cond) @ w_mod + b_mod, 6, axis=-1)


def split_proj(p):
    offs = [int(o) for o in np.cumsum(IN_SPLITS)[:-1]]
    return jnp.split(p, offs, axis=-1)


def to_heads(t, n_heads):
    b, l, _ = t.shape
    return t.reshape(b, l, n_heads, -1).transpose(0, 2, 1, 3)


def from_heads(t):
    b, h, l, d = t.shape
    return t.transpose(0, 2, 1, 3).reshape(b, l, h * d)


def rope_1d(x, pos):
    half = x.shape[-1] // 2
    inv = ROPE_BASE ** (-jnp.arange(half, dtype=jnp.float32) / half)
    ang = pos.astype(jnp.float32)[:, None] * inv[None, :]
    cos, sin = jnp.cos(ang).astype(x.dtype), jnp.sin(ang).astype(x.dtype)
    x1, x2 = x[..., :half], x[..., half:]
    return jnp.concatenate([x1 * cos - x2 * sin, x1 * sin + x2 * cos], axis=-1)


def axial_rope(x):
    l = x.shape[2]
    t = jnp.arange(l)
    half = x.shape[-1] // 2
    return jnp.concatenate([rope_1d(x[..., :half], t // GRID_W),
                            rope_1d(x[..., half:], t % GRID_W)], axis=-1)


def neighbourhood_attention(q, k, v, k_ctx, v_ctx, rpb):
    b, h, l, dh = q.shape
    rows = l // GRID_W
    kr = min(NA_WIN_ROWS, rows)
    kw = NA_WIN_COLS
    grid = lambda t: t.reshape(b, h, rows, GRID_W, dh)
    qg, kg, vg = grid(q * dh ** -0.5), grid(k), grid(v)
    cols = np.arange(GRID_W)
    col_start = np.clip(cols - kw // 2, 0, GRID_W - kw)
    col_idx = col_start[:, None] + np.arange(kw)[None, :]
    col_off = col_idx - cols[:, None] + (kw - 1)
    rpb_cols = rpb[:, :, col_off]

    def one_row(r):
        rs = jnp.clip(r - kr // 2, 0, rows - kr)
        q_r = lax.dynamic_index_in_dim(qg, r, axis=2, keepdims=False)
        k_band = lax.dynamic_slice_in_dim(kg, rs, kr, axis=2)
        v_band = lax.dynamic_slice_in_dim(vg, rs, kr, axis=2)
        k_win = k_band[:, :, :, col_idx]
        v_win = v_band[:, :, :, col_idx]
        row_off = rs + jnp.arange(kr) - r + (NA_WIN_ROWS - 1)
        bias = jnp.take(rpb_cols, row_off, axis=1).transpose(0, 2, 1, 3)
        s_loc = (jnp.einsum('bhcd,bhrcwd->bhcrw', q_r, k_win).astype(jnp.float32)
                 + bias[None].astype(jnp.float32))
        s_ctx = jnp.einsum('bhcd,bhnd->bhcn', q_r, k_ctx).astype(jnp.float32)
        s = jnp.concatenate([s_loc.reshape(b, h, GRID_W, kr * kw), s_ctx], axis=-1)
        p = jax.nn.softmax(s, axis=-1).astype(v.dtype)
        p_loc = p[..., :kr * kw].reshape(b, h, GRID_W, kr, kw)
        p_ctx = p[..., kr * kw:]
        return (jnp.einsum('bhcrw,bhrcwd->bhcd', p_loc, v_win)
                + jnp.einsum('bhcn,bhnd->bhcd', p_ctx, v_ctx))

    out = lax.map(one_row, jnp.arange(rows))
    return out.transpose(1, 2, 0, 3, 4).reshape(b, h, l, dh)


def ctx_self_attention(q, k, v):
    s = jnp.einsum('bhqd,bhkd->bhqk', q * q.shape[-1] ** -0.5, k).astype(jnp.float32)
    return jnp.einsum('bhqk,bhkd->bhqd', jax.nn.softmax(s, axis=-1).astype(v.dtype), v)


def gla_chunked(q, k, v, logg, s0):
    b_, h, l, _ = q.shape
    dv = v.shape[-1]
    n = l // GLA_CHUNK
    ch = lambda t: t.astype(jnp.float32).reshape(b_, h, n, GLA_CHUNK, t.shape[-1])
    q, k, v, logg = ch(q), ch(k), ch(v), ch(logg)
    bcum = jnp.cumsum(logg, axis=3)
    b_end = bcum[:, :, :, -1:, :]
    q_dec = q * jnp.exp(bcum)
    k_inv = k * jnp.exp(-bcum)
    k_end = k * jnp.exp(b_end - bcum)
    lower = jnp.tril(jnp.ones((GLA_CHUNK, GLA_CHUNK), dtype=bool))
    attn = jnp.where(lower, jnp.einsum('bhncd,bhnsd->bhncs', q_dec, k_inv), 0.0)
    o_intra = jnp.einsum('bhncs,bhnse->bhnce', attn, v)
    kv_chunk = jnp.einsum('bhncd,bhnce->bhnde', k_end, v)
    decay = jnp.exp(b_end[:, :, :, 0, :])

    def step(s, inp):
        d, kv = inp
        return d[..., None] * s + kv, s

    _, s_prev = lax.scan(step, s0.astype(jnp.float32),
                         (jnp.moveaxis(decay, 2, 0), jnp.moveaxis(kv_chunk, 2, 0)))
    s_prev = jnp.moveaxis(s_prev, 0, 2)
    o_inter = jnp.einsum('bhncd,bhnde->bhnce', q_dec, s_prev)
    return (o_intra + o_inter).reshape(b_, h, l, dv)


def gla_final_state(k, v, logg):
    k, v, logg = k.astype(jnp.float32), v.astype(jnp.float32), logg.astype(jnp.float32)
    bcum = jnp.cumsum(logg, axis=2)
    return jnp.einsum('bhtd,bhte->bhde', k * jnp.exp(bcum[:, :, -1:] - bcum), v)


def gla_output(o, r, gain):
    o = o * lax.rsqrt(jnp.mean(o * o, axis=-1, keepdims=True) + NORM_EPS)
    y = from_heads(o) * gain.astype(jnp.float32) * jax.nn.silu(r.astype(jnp.float32))
    return y.astype(r.dtype)


def project(h, w_in, wa2_f, ba_f, wa2_b, ba_b):
    na_q, na_k, na_v, gq, gk, gv, gr, af, ab = split_proj(h @ w_in)
    logf = jax.nn.log_sigmoid((af @ wa2_f + ba_f).astype(jnp.float32)) / GLA_GATE_TAU
    logb = jax.nn.log_sigmoid((ab @ wa2_b + ba_b).astype(jnp.float32)) / GLA_GATE_TAU
    return (to_heads(na_q, NA_HEADS), to_heads(na_k, NA_HEADS), to_heads(na_v, NA_HEADS),
            to_heads(gq, GLA_HEADS), to_heads(gk, GLA_HEADS), to_heads(gv, GLA_HEADS), gr,
            to_heads(logf, GLA_HEADS), to_heads(logb, GLA_HEADS))


def mixer(h, hc, w_in, na_rpb, wa2_f, ba_f, wa2_b, ba_b, gla_norm, w_out, with_ctx_out):
    nq, nk, nv, gq, gk, gv, gr, lf, lb = project(h, w_in, wa2_f, ba_f, wa2_b, ba_b)
    cnq, cnk, cnv, cgq, cgk, cgv, cgr, clf, clb = project(hc, w_in, wa2_f, ba_f, wa2_b, ba_b)
    flip = lambda t: jnp.flip(t, axis=2)
    na_out = from_heads(neighbourhood_attention(nq, nk, nv, cnk, cnv, na_rpb))
    gq = axial_rope(gq) * GLA_KEY_DIM ** -0.5
    gk = axial_rope(gk)
    s_f = gla_final_state(cgk, cgv, clf)
    s_b = gla_final_state(flip(cgk), flip(cgv), flip(clb))
    o = (gla_chunked(gq, gk, gv, lf, s_f)
         + flip(gla_chunked(flip(gq), flip(gk), flip(gv), flip(lb), s_b)))
    gla_out = gla_output(o, gr, gla_norm)
    y = jnp.concatenate([na_out, gla_out.astype(na_out.dtype)], axis=-1) @ w_out
    if not with_ctx_out:
        return y, None
    cgq = cgq * GLA_KEY_DIM ** -0.5
    zero = jnp.zeros_like(s_f)
    co = (gla_chunked(cgq, cgk, cgv, clf, zero)
          + flip(gla_chunked(flip(cgq), flip(cgk), flip(cgv), flip(clb), zero)))
    na_c = from_heads(ctx_self_attention(cnq, cnk, cnv))
    yc = jnp.concatenate([na_c, gla_output(co, cgr, gla_norm).astype(na_c.dtype)], axis=-1) @ w_out
    return y, yc


def swiglu(h, w_gate_up, w_down):
    g, u = jnp.split(h @ w_gate_up, 2, axis=-1)
    return (jax.nn.silu(g) * u) @ w_down


def setup_inputs(seed: int = 0) -> dict:
    key = jax.random.key(seed)
    ks = jax.random.split(key, 20)
    nrm = lambda k, shape, scale: jax.random.normal(k, shape, jnp.float32) * scale
    gain = lambda k, width: 1.0 + nrm(k, (DEPTH, width), 0.05)
    return {
        "x": nrm(ks[0], (BATCH, SEQ, D_MODEL), 1.0),
        "c": nrm(ks[1], (BATCH, D_MODEL), 1.0),
        "ctx": nrm(ks[2], (BATCH, CTX_LEN, D_MODEL), 1.0),
        "c_ctx": nrm(ks[3], (D_MODEL,), 1.0),
        "w_mod": nrm(ks[4], (DEPTH, D_MODEL, 6 * D_MODEL), 0.5 * D_MODEL ** -0.5),
        "b_mod": nrm(ks[5], (DEPTH, 6 * D_MODEL), 0.02),
        "norm_pre_mix": gain(ks[6], D_MODEL),
        "norm_post_mix": gain(ks[7], D_MODEL),
        "norm_pre_ffn": gain(ks[8], D_MODEL),
        "norm_post_ffn": gain(ks[9], D_MODEL),
        "w_in": nrm(ks[10], (DEPTH, D_MODEL, IN_WIDTH), D_MODEL ** -0.5),
        "na_rpb": nrm(ks[11], (DEPTH, NA_HEADS, 2 * NA_WIN_ROWS - 1, 2 * NA_WIN_COLS - 1), 0.1),
        "gla_wa2_f": nrm(ks[12], (DEPTH, GLA_GATE_RANK, GLA_QK_WIDTH), GLA_GATE_RANK ** -0.5),
        "gla_ba_f": nrm(ks[13], (DEPTH, GLA_QK_WIDTH), 0.1),
        "gla_wa2_b": nrm(ks[14], (DEPTH, GLA_GATE_RANK, GLA_QK_WIDTH), GLA_GATE_RANK ** -0.5),
        "gla_ba_b": nrm(ks[15], (DEPTH, GLA_QK_WIDTH), 0.1),
        "gla_norm": gain(ks[16], GLA_V_WIDTH),
        "w_out": nrm(ks[17], (DEPTH, MIX_WIDTH, D_MODEL), MIX_WIDTH ** -0.5),
        "w_gate_up": nrm(ks[18], (DEPTH, D_MODEL, 2 * FFN_HIDDEN), D_MODEL ** -0.5),
        "w_down": nrm(ks[19], (DEPTH, FFN_HIDDEN, D_MODEL), FFN_HIDDEN ** -0.5),
    }


def reference(x, c, ctx, c_ctx, w_mod, b_mod, norm_pre_mix, norm_post_mix, norm_pre_ffn,
              norm_post_ffn, w_in, na_rpb, gla_wa2_f, gla_ba_f, gla_wa2_b, gla_ba_b,
              gla_norm, w_out, w_gate_up, w_down):
    for i in range(DEPTH):
        last = i == DEPTH - 1
        sh1, sc1, gt1, sh2, sc2, gt2 = [m[:, None, :] for m in ada_mod(c, w_mod[i], b_mod[i])]
        csh1, csc1, cgt1, csh2, csc2, cgt2 = ada_mod(c_ctx, w_mod[i], b_mod[i])
        h = modulate(rmsnorm(x, norm_pre_mix[i]), sh1, sc1)
        hc = modulate(rmsnorm(ctx, norm_pre_mix[i]), csh1, csc1)
        y, yc = mixer(h, hc, w_in[i], na_rpb[i], gla_wa2_f[i], gla_ba_f[i], gla_wa2_b[i],
                      gla_ba_b[i], gla_norm[i], w_out[i], not last)
        x = x + gt1 * rmsnorm(y, norm_post_mix[i])
        h = modulate(rmsnorm(x, norm_pre_ffn[i]), sh2, sc2)
        x = x + gt2 * rmsnorm(swiglu(h, w_gate_up[i], w_down[i]), norm_post_ffn[i])
        if not last:
            ctx = ctx + cgt1 * rmsnorm(yc, norm_post_mix[i])
            hc = modulate(rmsnorm(ctx, norm_pre_ffn[i]), csh2, csc2)
            ctx = ctx + cgt2 * rmsnorm(swiglu(hc, w_gate_up[i], w_down[i]), norm_post_ffn[i])
    return x
```

```cpp
#include <hip/hip_runtime.h>
#include <hip/hip_cooperative_groups.h>
#include <cstdio>
#include <cstdint>
namespace cg = cooperative_groups;

#ifndef MK_PER_PHASE
#define MK_PER_PHASE 0
#endif
#ifndef MK_REP_PHASE
#define MK_REP_PHASE -1
#endif
#ifndef MK_CG_SEAMS
#define MK_CG_SEAMS 0
#endif

namespace pg8 {
#define PG8_LAS __attribute__((address_space(3)))
typedef unsigned short bf16_t;
typedef short bf16x8 __attribute__((ext_vector_type(8)));
typedef float f32x4 __attribute__((ext_vector_type(4)));
typedef unsigned u32x4 __attribute__((ext_vector_type(4)));
constexpr int BM = 256, BK = 64, HALF = 128, HTB = HALF * BK * 2, STAGE_BYTES = 8 * HTB, NXCD = 8, WGM = 8;

__host__ __device__ __forceinline__ int lds_byte(int r, int c) { const int st = (r >> 4) * 2 + (c >> 5), rr = r & 15, cc = c & 31, ob = rr * 64 + cc * 2; return st * 1024 + (ob ^ (((ob >> 9) & 1) << 5)); }
__host__ __device__ __forceinline__ void stage_rc(int b, int& R, int& C) { const int st = b / 1024, sb = b % 1024, swz = sb ^ (((sb >> 9) & 1) << 5); R = (st >> 1) * 16 + swz / 64; C = (st & 1) * 32 + (swz % 64) / 2; }
__host__ __device__ __forceinline__ int perm32(int rho) { const int n = rho >> 4, i = rho & 15; return 8 * (i >> 2) + 4 * n + (i & 3); }

struct Unit { int pm, pn, kind; const char* a; const char* b; };
struct Gemm { const bf16_t* A; const bf16_t* Bt; int M, N, K; };

struct StaticOrder {
    int nM, nN, nwg, G, c, rev; const char* A; const char* Bt; size_t tstep;
    __host__ __device__ void init(const Gemm& g, int G_, int c_, int rev_ = 0) { nM = g.M / BM; nN = g.N / BM; nwg = nM * nN; G = G_; c = c_; rev = rev_; A = (const char*)g.A; Bt = (const char*)g.Bt; tstep = (size_t)BM * g.K * 2; }
    __host__ __device__ void map(int wgid, Unit& u) const {
        { const int q = nwg / NXCD, r = nwg % NXCD, xcd = wgid % NXCD, off = wgid / NXCD; wgid = (xcd < r ? xcd * (q + 1) : r * (q + 1) + (xcd - r) * q) + off; }
        const int nig = WGM * nN, gid = wgid / nig, fm = gid * WGM, gsz = (nM - fm) < WGM ? (nM - fm) : WGM;
        u.pm = fm + ((wgid % nig) % gsz); if (rev) u.pm = nM - 1 - u.pm; u.pn = (wgid % nig) / gsz; u.kind = 0; u.a = A + (size_t)u.pm * tstep; u.b = Bt + (size_t)u.pn * tstep;
    }
    __host__ __device__ bool next(int i, Unit& u) const { const long L = (long)i * G + c; if (L >= nwg) return false; map((int)L, u); return true; }
    __device__ __forceinline__ void a_ready(const Unit&) const {}
    __device__ __forceinline__ void done(const Unit&) const {}
};
struct DualOrder {
    StaticOrder o1, o2; int G, c;
    __host__ __device__ bool next(int i, Unit& u) const { const long L = (long)i * G + c; if (L >= o1.nwg + o2.nwg) return false;
        if (L < o1.nwg) o1.map((int)L, u); else { o2.map((int)(L - o1.nwg), u); u.kind = 1; } return true; }
    __device__ __forceinline__ void a_ready(const Unit&) const {}
    __device__ __forceinline__ void done(const Unit&) const {}
};

__device__ __forceinline__ unsigned cvt_pk_bf16(float lo, float hi) { unsigned r; asm volatile("v_cvt_pk_bf16_f32 %0, %1, %2" : "=v"(r) : "v"(lo), "v"(hi)); return r; }

struct EpiStore {
    static constexpr bool PERM = true, AFTER_DRAIN = false;
    bf16_t* O; int nrows;
    __device__ __forceinline__ void operator()(const f32x4 (&acc)[2][2][4][2], const Unit& u, int wr, int wc, int fr, int fq) const {
        const int row0 = u.pm * BM + wr * 64 + fr, col0 = wc * 32 + 8 * fq; bf16_t* blk = O + (size_t)u.pn * nrows * 256;
#pragma unroll
        for (int ai = 0; ai < 2; ++ai)
#pragma unroll
            for (int m = 0; m < 4; ++m) { bf16_t* rowp = blk + (size_t)(row0 + ai * HALF + m * 16) * 256 + col0;
#pragma unroll
                for (int bj = 0; bj < 2; ++bj) { const f32x4 v0 = acc[ai][bj][m][0], v1 = acc[ai][bj][m][1];
                    u32x4 w; w.x = cvt_pk_bf16(v0[0], v0[1]); w.y = cvt_pk_bf16(v0[2], v0[3]); w.z = cvt_pk_bf16(v1[0], v1[1]); w.w = cvt_pk_bf16(v1[2], v1[3]);
                    *(u32x4*)(rowp + bj * HALF) = w; } }
    }
};
struct EpiStoreBlk {
    static constexpr bool PERM = true, AFTER_DRAIN = false;
    bf16_t* O; int nrows;
    __device__ __forceinline__ void operator()(const f32x4 (&acc)[2][2][4][2], const Unit& u, int wr, int wc, int fr, int fq) const {
        const int row0 = u.pm * BM + wr * 64 + fr;
#pragma unroll
        for (int ai = 0; ai < 2; ++ai)
#pragma unroll
            for (int m = 0; m < 4; ++m) { const int r = row0 + ai * HALF + m * 16;
#pragma unroll
                for (int bj = 0; bj < 2; ++bj) { const f32x4 v0 = acc[ai][bj][m][0], v1 = acc[ai][bj][m][1];
                    u32x4 w; w.x = cvt_pk_bf16(v0[0], v0[1]); w.y = cvt_pk_bf16(v0[2], v0[3]); w.z = cvt_pk_bf16(v1[0], v1[1]); w.w = cvt_pk_bf16(v1[2], v1[3]);
                    const int g32 = u.pn * 8 + bj * 4 + wc;
                    *(u32x4*)(O + ((size_t)g32 * (nrows >> 4) + (r >> 4)) * 512 + fq * 128 + (r & 15) * 8) = w; } }
    }
};
struct EpiDual {
    static constexpr bool PERM = true, AFTER_DRAIN = false;
    EpiStore e0; EpiStoreBlk e1;
    __device__ __forceinline__ void operator()(const f32x4 (&acc)[2][2][4][2], const Unit& u, int wr, int wc, int fr, int fq) const { if (u.kind == 0) e0(acc, u, wr, wc, fr, fq); else e1(acc, u, wr, wc, fr, fq); }
};
struct EpiStoreSsq {
    static constexpr bool PERM = true, AFTER_DRAIN = false;
    bf16_t* O; int ldc; float* ssq;
    __device__ __forceinline__ void operator()(const f32x4 (&acc)[2][2][4][2], const Unit& u, int wr, int wc, int fr, int fq) const {
        const int row0 = u.pm * BM + wr * 64 + fr, col0 = u.pn * BM + wc * 32 + 8 * fq;
#pragma unroll
        for (int ai = 0; ai < 2; ++ai)
#pragma unroll
            for (int m = 0; m < 4; ++m) { const int row = row0 + ai * HALF + m * 16; bf16_t* rowp = O + (size_t)row * ldc + col0; float s = 0.f;
#pragma unroll
                for (int bj = 0; bj < 2; ++bj) { const f32x4 v0 = acc[ai][bj][m][0], v1 = acc[ai][bj][m][1];
                    s += (v0[0] * v0[0] + v0[1] * v0[1]) + (v0[2] * v0[2] + v0[3] * v0[3]) + (v1[0] * v1[0] + v1[1] * v1[1]) + (v1[2] * v1[2] + v1[3] * v1[3]);
                    u32x4 w; w.x = cvt_pk_bf16(v0[0], v0[1]); w.y = cvt_pk_bf16(v0[2], v0[3]); w.z = cvt_pk_bf16(v1[0], v1[1]); w.w = cvt_pk_bf16(v1[2], v1[3]);
                    *(u32x4*)(rowp + bj * HALF) = w; }
                s += __shfl_xor(s, 16); s += __shfl_xor(s, 32);
                if (fq == 0) ssq[(size_t)row * 16 + u.pn * 4 + wc] = s; }
    }
};
struct EpiSwiglu {
    static constexpr bool PERM = true, AFTER_DRAIN = false;
    bf16_t* O; int ldc;
    __device__ __forceinline__ void operator()(const f32x4 (&acc)[2][2][4][2], const Unit& u, int wr, int wc, int fr, int fq) const {
        const int row0 = u.pm * BM + wr * 64 + fr, col0 = u.pn * HALF + wc * 32 + 8 * fq;
#pragma unroll
        for (int ai = 0; ai < 2; ++ai)
#pragma unroll
            for (int m = 0; m < 4; ++m) { bf16_t* rowp = O + (size_t)(row0 + ai * HALF + m * 16) * ldc + col0; float a[8];
#pragma unroll
                for (int n = 0; n < 2; ++n)
#pragma unroll
                    for (int i = 0; i < 4; ++i) { const float g = acc[ai][0][m][n][i], uu = acc[ai][1][m][n][i]; a[n * 4 + i] = g * __builtin_amdgcn_rcpf(1.0f + __expf(-g)) * uu; }
                u32x4 w; w.x = cvt_pk_bf16(a[0], a[1]); w.y = cvt_pk_bf16(a[2], a[3]); w.z = cvt_pk_bf16(a[4], a[5]); w.w = cvt_pk_bf16(a[6], a[7]);
                *(u32x4*)rowp = w; }
    }
};

template <class Epi, class Sched, bool ALIGN_EPI = false, bool SP2 = false>
__device__ __forceinline__ void gemm_phase(PG8_LAS unsigned char* lds, const Gemm g, const Sched& S, const Epi& E) {
    const int tid = threadIdx.x, wid = __builtin_amdgcn_readfirstlane(tid >> 6), lane = tid & 63, wr = wid >> 2, wc = wid & 3, fr = lane & 15, fq = lane >> 4;
    const int K = g.K, nt = K / BK;
    unsigned voffA[2], voffB[2];
#pragma unroll
    for (int i = 0; i < 2; ++i) { int R, C; stage_rc(tid * 16 + i * 8192, R, C); const int Rb = Epi::PERM ? ((R & ~31) + perm32(R & 31)) : R;
        voffA[i] = (unsigned)(R * K + C) * 2u; voffB[i] = (unsigned)(Rb * K + C) * 2u; }
    const size_t kstep = (size_t)(BK * 2);
    const size_t hstep = (size_t)HALF * K * 2;
    const unsigned ldsw = (unsigned)wid * 1024u;
    const int aoff = lds_byte(wr * 64 + fr, fq * 8), boff = lds_byte(wc * 32 + fr, fq * 8);
#define PG8_SA(b, h) (((b) * 2 + (h)) * HTB)
#define PG8_SB(b, h) ((4 + (b) * 2 + (h)) * HTB)
#define PG8_STAGE(bufoff, gbase, voff) do { _Pragma("unroll") for (int _i = 0; _i < 2; ++_i) \
        __builtin_amdgcn_global_load_lds((const unsigned*)((const char*)(gbase) + (voff)[_i]), (PG8_LAS unsigned*)(lds + (bufoff) + ldsw + _i * 8192), 16, 0, 0); } while (0)
#define PG8_LDA(dst, b, h) do { _Pragma("unroll") for (int m = 0; m < 4; ++m) _Pragma("unroll") for (int k = 0; k < 2; ++k) dst[m][k] = *(const PG8_LAS bf16x8*)(lds + PG8_SA(b, h) + aoff + m * 2048 + k * 1024); } while (0)
#define PG8_LDB(dst, b, h) do { _Pragma("unroll") for (int n = 0; n < 2; ++n) _Pragma("unroll") for (int k = 0; k < 2; ++k) dst[n][k] = *(const PG8_LAS bf16x8*)(lds + PG8_SB(b, h) + boff + n * 2048 + k * 1024); } while (0)
#define PG8_MMA(ai, bj, At, Bt) do { __builtin_amdgcn_s_setprio(1); _Pragma("unroll") for (int m = 0; m < 4; ++m) _Pragma("unroll") for (int n = 0; n < 2; ++n) _Pragma("unroll") for (int k = 0; k < 2; ++k) \
        acc[ai][bj][m][n] = __builtin_amdgcn_mfma_f32_16x16x32_bf16(Bt[n][k], At[m][k], acc[ai][bj][m][n], 0, 0, 0); __builtin_amdgcn_s_setprio(0); } while (0)
#define PG8_WAIT_V(n) asm volatile("s_waitcnt vmcnt(" #n ")" ::: "memory")
#define PG8_WAIT_L(n) asm volatile("s_waitcnt lgkmcnt(" #n ")" ::: "memory")
#define PG8_BAR __builtin_amdgcn_s_barrier()
#define PG8_SCHED __builtin_amdgcn_sched_barrier(0)
    Unit cur, nxt; int ui = 0;
    if (!S.next(0, cur)) return;
    f32x4 acc[2][2][4][2];
#pragma unroll
    for (int a = 0; a < 2; ++a)
#pragma unroll
        for (int b = 0; b < 2; ++b)
#pragma unroll
            for (int m = 0; m < 4; ++m)
#pragma unroll
                for (int n = 0; n < 2; ++n) acc[a][b][m][n] = (f32x4){0.f, 0.f, 0.f, 0.f};
    bf16x8 At[4][2], B0[2][2], B1[2][2];
    const char* cA = cur.a; const char* cB = cur.b;
    S.a_ready(cur);
    if constexpr (SP2) {
        PG8_STAGE(PG8_SB(0, 0), cB, voffB); PG8_STAGE(PG8_SB(0, 1), cB + hstep, voffB); PG8_STAGE(PG8_SA(0, 0), cA, voffA); PG8_STAGE(PG8_SA(0, 1), cA + hstep, voffA);
        if (wr == 1) PG8_BAR;
        PG8_WAIT_V(2); PG8_BAR;
        PG8_STAGE(PG8_SB(1, 0), cB + kstep, voffB); PG8_STAGE(PG8_SA(1, 0), cA + kstep, voffA); PG8_STAGE(PG8_SB(1, 1), cB + hstep + kstep, voffB);
        PG8_WAIT_V(6); PG8_BAR;
    } else {
        PG8_STAGE(PG8_SB(0, 0), cB, voffB); PG8_STAGE(PG8_SA(0, 0), cA, voffA); PG8_STAGE(PG8_SB(0, 1), cB + hstep, voffB); PG8_STAGE(PG8_SA(0, 1), cA + hstep, voffA);
        if (wr == 1) PG8_BAR;
        PG8_WAIT_V(4); PG8_BAR;
        PG8_STAGE(PG8_SB(1, 0), cB + kstep, voffB); PG8_STAGE(PG8_SA(1, 0), cA + kstep, voffA); PG8_STAGE(PG8_SB(1, 1), cB + hstep + kstep, voffB);
        PG8_WAIT_V(6); PG8_BAR;
    }
    for (;;) {
        const bool has_next = S.next(ui + 1, nxt);
        const char* nA = has_next ? nxt.a : cA; const char* nB = has_next ? nxt.b : cB;
        for (int t = 0; t < nt; t += 2) {
            const bool last = (t == nt - 2);
            const char* a1 = cA + (size_t)(t + 1) * kstep;
            const char* a2 = last ? nA : cA + (size_t)(t + 2) * kstep; const char* b2 = last ? nB : cB + (size_t)(t + 2) * kstep;
            const char* a3 = a2 + kstep; const char* b3 = b2 + kstep;
            if (last && has_next) S.a_ready(nxt);
            if constexpr (SP2) {
            PG8_LDB(B0, 0, 0); PG8_LDB(B1, 0, 1); PG8_SCHED; PG8_LDA(At, 0, 0); PG8_STAGE(PG8_SA(1, 1), a1 + hstep, voffA);
            PG8_WAIT_V(8); PG8_WAIT_L(0); PG8_BAR; PG8_MMA(0, 0, At, B0); PG8_MMA(0, 1, At, B1); PG8_BAR; PG8_SCHED;
            PG8_LDA(At, 0, 1); PG8_STAGE(PG8_SB(0, 0), b2, voffB); PG8_STAGE(PG8_SB(0, 1), b2 + hstep, voffB); PG8_STAGE(PG8_SA(0, 0), a2, voffA);
            PG8_WAIT_V(8); PG8_WAIT_L(0); PG8_BAR; PG8_MMA(1, 0, At, B0); PG8_MMA(1, 1, At, B1); PG8_BAR; PG8_SCHED;
            PG8_LDB(B0, 1, 0); PG8_LDB(B1, 1, 1); PG8_SCHED; PG8_LDA(At, 1, 0); PG8_STAGE(PG8_SA(0, 1), a2 + hstep, voffA);
            PG8_WAIT_V(8); PG8_WAIT_L(0); PG8_BAR; PG8_MMA(0, 0, At, B0); PG8_MMA(0, 1, At, B1); PG8_BAR; PG8_SCHED;
            PG8_LDA(At, 1, 1); PG8_STAGE(PG8_SB(1, 0), b3, voffB); PG8_STAGE(PG8_SB(1, 1), b3 + hstep, voffB); PG8_STAGE(PG8_SA(1, 0), a3, voffA);
            PG8_WAIT_V(8); PG8_WAIT_L(0); PG8_BAR; PG8_MMA(1, 0, At, B0); PG8_MMA(1, 1, At, B1); PG8_BAR; PG8_SCHED;
            } else {
            PG8_LDB(B0, 0, 0); PG8_SCHED; PG8_LDA(At, 0, 0); PG8_STAGE(PG8_SA(1, 1), a1 + hstep, voffA);
            PG8_WAIT_L(8); PG8_BAR; PG8_WAIT_L(0); PG8_MMA(0, 0, At, B0); PG8_BAR; PG8_SCHED;
            PG8_LDB(B1, 0, 1); PG8_STAGE(PG8_SB(0, 0), b2, voffB);
            PG8_BAR; PG8_WAIT_L(0); PG8_MMA(0, 1, At, B1); PG8_BAR;
            PG8_LDA(At, 0, 1); PG8_STAGE(PG8_SA(0, 0), a2, voffA);
            PG8_BAR; PG8_WAIT_L(0); PG8_MMA(1, 0, At, B0); PG8_BAR; PG8_SCHED;
            PG8_STAGE(PG8_SB(0, 1), b2 + hstep, voffB);
            PG8_WAIT_V(6); PG8_BAR; PG8_MMA(1, 1, At, B1); PG8_BAR;
            PG8_LDB(B0, 1, 0); PG8_SCHED; PG8_LDA(At, 1, 0); PG8_STAGE(PG8_SA(0, 1), a2 + hstep, voffA);
            PG8_WAIT_L(8); PG8_BAR; PG8_WAIT_L(0); PG8_MMA(0, 0, At, B0); PG8_BAR; PG8_SCHED;
            PG8_LDB(B1, 1, 1); PG8_STAGE(PG8_SB(1, 0), b3, voffB);
            PG8_BAR; PG8_WAIT_L(0); PG8_MMA(0, 1, At, B1); PG8_BAR;
            PG8_LDA(At, 1, 1); PG8_STAGE(PG8_SA(1, 0), a3, voffA);
            PG8_BAR; PG8_WAIT_L(0); PG8_MMA(1, 0, At, B0); PG8_BAR; PG8_SCHED;
            PG8_STAGE(PG8_SB(1, 1), b3 + hstep, voffB);
            PG8_WAIT_V(6); PG8_BAR; PG8_MMA(1, 1, At, B1); PG8_BAR;
            }
        }
        if constexpr (ALIGN_EPI) { if (wr == 0) PG8_BAR; }
        if constexpr (!Epi::AFTER_DRAIN) { E(acc, cur, wr, wc, fr, fq); S.done(cur); }
        if (!has_next) break;
#pragma unroll
        for (int a = 0; a < 2; ++a)
#pragma unroll
            for (int b = 0; b < 2; ++b)
#pragma unroll
                for (int m = 0; m < 4; ++m)
#pragma unroll
                    for (int n = 0; n < 2; ++n) acc[a][b][m][n] = (f32x4){0.f, 0.f, 0.f, 0.f};
        cur = nxt; cA = nA; cB = nB; ++ui;
        if constexpr (ALIGN_EPI) { if (wr == 1) PG8_BAR; }
    }
    PG8_WAIT_V(0);
    if constexpr (!ALIGN_EPI) { if (wr == 0) PG8_BAR; }
    PG8_BAR;
#undef PG8_SA
#undef PG8_SB
#undef PG8_STAGE
#undef PG8_LDA
#undef PG8_LDB
#undef PG8_MMA
#undef PG8_WAIT_V
#undef PG8_WAIT_L
#undef PG8_BAR
#undef PG8_SCHED
}
}

typedef unsigned short bf16;
typedef short bf16x8 __attribute__((ext_vector_type(8)));
typedef float f32x4 __attribute__((ext_vector_type(4)));
typedef unsigned u32x4 __attribute__((ext_vector_type(4)));
typedef unsigned u32x2 __attribute__((ext_vector_type(2)));
#define LAS __attribute__((address_space(3)))

constexpr int NB = 8, SEQ = 8192, DM = 1024, CTXL = 256;
constexpr int MLAT = NB * SEQ, MCTX = NB * CTXL, MTOT = MLAT + MCTX;
constexpr int LDP = 2304;
constexpr int CQ = 0, CK = 512, CGQ = 1024, CGK = 1280, CGR = 1536, CAF = 2048, CAB = 2064;
__device__ __forceinline__ size_t vt_off(int row, int tok) { return ((size_t)(tok >> 5) * 64 + (row >> 4)) * 512 + ((tok >> 3) & 3) * 128 + (row & 15) * 8; }
__device__ __forceinline__ size_t p1_off(int row, int col) { return ((size_t)(col >> 8) * MTOT + row) * 256 + (col & 255); }
constexpr int FFN = 2816, NMOD = 6 * DM;
constexpr int NCH = 132;
constexpr float EPS = 1e-6f;

constexpr size_t MiB = 1u << 20;
constexpr size_t WS_CTL = 0, CTL_ZERO_BYTES = 1 * MiB;
constexpr size_t WS_MOD = 1 * MiB;
constexpr size_t WS_ROPE = 1 * MiB + 512 * 1024;
constexpr size_t WS_WMAIN = 2 * MiB;
constexpr size_t WS_WV = 7 * MiB;
constexpr size_t WS_WOUT = 9 * MiB;
constexpr size_t WS_WGU = 11 * MiB;
constexpr size_t WS_WDOWN = 22 * MiB;
constexpr size_t WS_H = 32 * MiB;
constexpr size_t WS_P1 = 164 * MiB;
constexpr size_t WS_VT = 461 * MiB;
constexpr size_t WS_KV = 593 * MiB;
constexpr size_t WS_DEC = 725 * MiB;
constexpr size_t WS_SSQ1 = 728 * MiB;
constexpr size_t WS_SSQ2 = 732 * MiB;
constexpr size_t WS_MIX = 736 * MiB;
constexpr size_t WS_Y = WS_KV;
constexpr size_t WS_ACT = WS_P1;
constexpr size_t WS_DOWN = WS_MIX;
constexpr size_t WS_X1B = 864 * MiB;
constexpr size_t WS_END = 992 * MiB;
static_assert(WS_P1 + (size_t)MTOT * LDP * 2 <= WS_VT && WS_VT + (size_t)1024 * MTOT * 2 <= WS_KV && WS_KV + (size_t)64 * NCH * 128 * 64 * 2 <= WS_DEC, "ws map");
static_assert(WS_ACT + (size_t)MLAT * FFN * 2 <= WS_KV && WS_H + (size_t)MTOT * DM * 2 <= WS_P1 && WS_MIX + (size_t)MLAT * DM * 2 <= WS_END, "ws map 2");

constexpr int LDS_BYTES = 147456;
constexpr int NTHREADS = 512;

__device__ __forceinline__ unsigned f2bf(float f) { unsigned u = __builtin_bit_cast(unsigned, f); return (u + 0x7fffu + ((u >> 16) & 1u)) >> 16; }
typedef float f32x2_t __attribute__((ext_vector_type(2)));
typedef __bf16 bf16x2_t __attribute__((ext_vector_type(2)));
__device__ __forceinline__ unsigned pk2(float lo, float hi) { const f32x2_t v = {lo, hi}; return __builtin_bit_cast(unsigned, __builtin_convertvector(v, bf16x2_t)); }
__device__ __forceinline__ float bflo(unsigned w) { return __builtin_bit_cast(float, w << 16); }
__device__ __forceinline__ float bfhi(unsigned w) { return __builtin_bit_cast(float, w & 0xffff0000u); }
__device__ __forceinline__ float wave_sum(float v) {
#pragma unroll
    for (int o = 1; o < 64; o <<= 1) v += __shfl_xor(v, o);
    return v;
}
__device__ __forceinline__ void unpack8(const u32x4 w, float (&o)[8]) { o[0] = bflo(w.x); o[1] = bfhi(w.x); o[2] = bflo(w.y); o[3] = bfhi(w.y); o[4] = bflo(w.z); o[5] = bfhi(w.z); o[6] = bflo(w.w); o[7] = bfhi(w.w); }
__device__ __forceinline__ float logsig16(float z) { return (fminf(z, 0.f) - __logf(1.0f + __expf(-fabsf(z)))) * (1.0f / 16.0f); }

#define XB_TMO      128
#define XB_XCNT(j)  (256  + 64 * (j))
#define XB_XSUB(j)  (1280 + 64 * (j))
#define XB_XGEN(j)  (2304 + 64 * (j))
#define XB_TOP      3328
#define XB_TOPGEN   3392
#define XCD_BAR_WORDS 3456
#define XB_SPIN_CAP (1u << 18)
__device__ __forceinline__ unsigned xb_ld(unsigned* p)              { return __hip_atomic_load(p, __ATOMIC_RELAXED, __HIP_MEMORY_SCOPE_AGENT); }
__device__ __forceinline__ unsigned xb_add(unsigned* p, unsigned v) { return __hip_atomic_fetch_add(p, v, __ATOMIC_RELAXED, __HIP_MEMORY_SCOPE_AGENT); }
__device__ __forceinline__ unsigned xb_xcc_id() { return (unsigned)__builtin_amdgcn_s_getreg((3 << 11) | 20) & 0xFu; }
#define XB_SPIN(cond, bar) do { unsigned _sp = 0; while (cond) { __builtin_amdgcn_s_sleep(1); \
    if ((++_sp & 255u) == 0u) { if (xb_ld(&(bar)[XB_TMO])) break; if (_sp > XB_SPIN_CAP) { atomicAdd(&(bar)[XB_TMO], 1u); break; } } } } while (0)
struct XcdBarrier { unsigned* bar; unsigned x; volatile unsigned* st; };
__device__ __forceinline__ XcdBarrier xcd_barrier_post(unsigned* bar, volatile unsigned* st) {
    XcdBarrier b; b.bar = bar; b.x = xb_xcc_id(); b.st = st;
    if (threadIdx.x == 0) (void)xb_add(&bar[XB_XCNT(b.x)], 1u);
    return b;
}
__device__ __forceinline__ void xcd_barrier_complete(unsigned* bar, unsigned x, unsigned& nloc, unsigned& nx) {
    const unsigned G = gridDim.x * gridDim.y * gridDim.z;
    unsigned sum, cnt, mine, sp = 0u;
    for (;;) {
        sum = 0u; cnt = 0u; mine = 0u;
#pragma unroll
        for (unsigned j = 0; j < 16; ++j) { const unsigned c = xb_ld(&bar[XB_XCNT(j)]); sum += c; cnt += (c > 0u) ? 1u : 0u; mine = (j == x) ? c : mine; }
        if (sum == G) break;
        __builtin_amdgcn_s_sleep(1);
        if ((++sp & 255u) == 0u) { if (xb_ld(&bar[XB_TMO])) break; if (sp > XB_SPIN_CAP) { atomicAdd(&bar[XB_TMO], 1u); break; } }
    }
    nloc = mine > 0u ? mine : 1u; nx = cnt > 0u ? cnt : 1u;
}
__device__ __forceinline__ void xcd_barrier(const XcdBarrier& b) {
    asm volatile("s_waitcnt vmcnt(0)" ::: "memory");
    __syncthreads();
    if (threadIdx.x == 0) {
        unsigned* bar = b.bar;
        __builtin_amdgcn_s_waitcnt(0);
        unsigned nloc = b.st[0], nx = b.st[1];
        if (nloc == 0u) { xcd_barrier_complete(bar, b.x, nloc, nx); b.st[0] = nloc; b.st[1] = nx; }
        const unsigned old = xb_add(&bar[XB_XSUB(b.x)], 1u);
        const unsigned gen = old / nloc;
        if (old + 1u == (gen + 1u) * nloc) {
            __builtin_amdgcn_fence(__ATOMIC_RELEASE, "agent");
            asm volatile("s_waitcnt vmcnt(0)" ::: "memory");
            const unsigned og = xb_add(&bar[XB_TOP], 1u);
            const unsigned tg = og / nx;
            if (og + 1u == (tg + 1u) * nx) xb_add(&bar[XB_TOPGEN], 1u);
            else XB_SPIN(xb_ld(&bar[XB_TOPGEN]) == tg, bar);
            __builtin_amdgcn_fence(__ATOMIC_ACQUIRE, "agent");
            xb_add(&bar[XB_XGEN(b.x)], 1u);
            asm volatile("s_waitcnt vmcnt(0)" ::: "memory");
        } else {
            XB_SPIN(xb_ld(&bar[XB_XGEN(b.x)]) == gen, bar);
            __builtin_amdgcn_fence(__ATOMIC_ACQUIRE, "agent");
            asm volatile("s_waitcnt vmcnt(0)" ::: "memory");
        }
    }
    __syncthreads();
}

struct Frame {
    unsigned char* lds;
    int tid, lane, wave, G;
    const float *x, *c, *ctx, *c_ctx, *w_mod, *b_mod, *g_pre_mix, *g_post_mix, *g_pre_ffn, *g_post_ffn, *w_in, *rpb, *wa2_f, *ba_f, *wa2_b, *ba_b, *gla_norm, *w_out, *w_gu, *w_down;
    float* out;
    float *MOD, *ROPE, *DEC, *SSQ1, *SSQ2;
    bf16 *WMAIN, *WV, *WOUT, *WGU, *WDOWN, *H, *P1, *VT, *KV, *MIX, *Y, *ACT, *DOWN, *X1B;
};

__device__ __forceinline__ void ph0_mod(const Frame& F) {
    float* S = (float*)F.lds;
    float* PART = S + 9 * 1024;
    for (int i = F.tid; i < 9 * 1024; i += NTHREADS) { const int r = i >> 10, k = i & 1023; const float v = r < 8 ? F.c[r * 1024 + k] : F.c_ctx[k]; S[i] = v / (1.0f + expf(-v)); }
    __syncthreads();
    for (int cgp = blockIdx.x; cgp < 256; cgp += F.G) {
        const int n0 = cgp * 24, cgi = F.tid % 6, ks = F.tid / 6;
        float acc[9][4];
#pragma unroll
        for (int r = 0; r < 9; ++r)
#pragma unroll
            for (int j = 0; j < 4; ++j) acc[r][j] = 0.f;
        if (ks < 85) {
            for (int k = ks; k < 1024; k += 85) { const f32x4 w = *(const f32x4*)(F.w_mod + (size_t)k * NMOD + n0 + 4 * cgi);
#pragma unroll
                for (int r = 0; r < 9; ++r) { const float s = S[r * 1024 + k]; acc[r][0] += s * w[0]; acc[r][1] += s * w[1]; acc[r][2] += s * w[2]; acc[r][3] += s * w[3]; } }
#pragma unroll
            for (int r = 0; r < 9; ++r)
#pragma unroll
                for (int j = 0; j < 4; ++j) PART[(ks * 9 + r) * 24 + cgi * 4 + j] = acc[r][j];
        }
        __syncthreads();
        if (F.tid < 216) { const int r = F.tid / 24, col = F.tid % 24; float s = 0.f; for (int k2 = 0; k2 < 85; ++k2) s += PART[(k2 * 9 + r) * 24 + col]; F.MOD[r * NMOD + n0 + col] = s + F.b_mod[n0 + col]; }
        __syncthreads();
    }
    for (int i = blockIdx.x * NTHREADS + F.tid; i < 128 * 16; i += F.G * NTHREADS) {
        const int pos = i >> 4, ii = i & 15; const float inv = (float)pow(10000.0, -(double)ii / 16.0); const float ang = (float)pos * inv;
        F.ROPE[i] = (float)cos((double)ang); F.ROPE[2048 + i] = (float)sin((double)ang);
    }
}

__device__ __forceinline__ void transpose_item(const float* W, int ldn, int k0, int nsrc0, bf16* WT, int ldk, int drow0, float* scr, int lane) {
#pragma unroll 8
    for (int i = 0; i < 32; ++i) { const int kk = 2 * i + (lane >> 5); scr[kk * 33 + (lane & 31)] = W[(size_t)(k0 + kk) * ldn + nsrc0 + (lane & 31)]; }
    __builtin_amdgcn_wave_barrier();
    const int c = lane & 7;
#pragma unroll
    for (int j = 0; j < 4; ++j) { const int n = (lane >> 3) + 8 * j; const float* s = scr + (8 * c) * 33 + n;
        u32x4 o; o.x = pk2(s[0 * 33], s[1 * 33]); o.y = pk2(s[2 * 33], s[3 * 33]); o.z = pk2(s[4 * 33], s[5 * 33]); o.w = pk2(s[6 * 33], s[7 * 33]);
        *(u32x4*)(WT + (size_t)(drow0 + n) * ldk + k0 + 8 * c) = o; }
    __builtin_amdgcn_wave_barrier();
}
__device__ __forceinline__ void ph1_rows(const Frame& F) {
    const int gw = blockIdx.x * 8 + F.wave, NGW = F.G * 8;
    int curb = -1; f32x4 cA[4], cB[4];
#pragma unroll
    for (int j = 0; j < 4; ++j) { cA[j] = (f32x4){0.f, 0.f, 0.f, 0.f}; cB[j] = cA[j]; }
    for (int row0 = gw; row0 < MTOT; row0 += 2 * NGW) {
        const int nr = (row0 + NGW < MTOT) ? 2 : 1;
        f32x4 v[2][4];
#pragma unroll
        for (int q = 0; q < 2; ++q) { const int row = (q < nr) ? row0 + q * NGW : row0; const float* src = row < MLAT ? F.x + (size_t)row * DM : F.ctx + (size_t)(row - MLAT) * DM;
#pragma unroll
            for (int j = 0; j < 4; ++j) v[q][j] = __builtin_nontemporal_load((const f32x4*)src + F.lane + 64 * j); }
#pragma unroll
        for (int q = 0; q < 2; ++q) { if (q < nr) { const int row = row0 + q * NGW; const int b = row < MLAT ? (row >> 13) : 8; float ss = 0.f;
#pragma unroll
            for (int j = 0; j < 4; ++j) ss += (v[q][j][0] * v[q][j][0] + v[q][j][1] * v[q][j][1]) + (v[q][j][2] * v[q][j][2] + v[q][j][3] * v[q][j][3]);
            if (b != curb) { curb = b;
#pragma unroll
                for (int j = 0; j < 4; ++j) { const int col = 4 * (F.lane + 64 * j); const f32x4 g = *(const f32x4*)(F.g_pre_mix + col), sh = *(const f32x4*)(F.MOD + b * NMOD + col), sc = *(const f32x4*)(F.MOD + b * NMOD + DM + col);
                    cA[j] = g * (sc + 1.0f); cB[j] = sh; } }
            const float rstd = 1.0f / sqrtf(wave_sum(ss) * (1.0f / DM) + EPS);
#pragma unroll
            for (int j = 0; j < 4; ++j) { const f32x4 o = v[q][j] * rstd * cA[j] + cB[j]; u32x2 w; w.x = pk2(o[0], o[1]); w.y = pk2(o[2], o[3]); *(u32x2*)(F.H + (size_t)row * DM + 4 * (F.lane + 64 * j)) = w; } } }
    }
    float* scr = (float*)(F.lds + F.wave * 16384);
    constexpr int I_MAIN = 16 * 65, I_V = 16 * 32, I_OUT = 16 * 32, I_GU = 16 * 176, I_DOWN = 44 * 32, NITEMS = I_MAIN + I_V + I_OUT + I_GU + I_DOWN;
    for (int it = gw; it < NITEMS; it += NGW) {
        int r = it;
        if (r < I_MAIN) { const int kb = r / 65, nb = r % 65, dr = nb * 32; const int sc = dr < 1024 ? dr : (dr < 1536 ? dr + 512 : dr + 1024); transpose_item(F.w_in, 3104, kb * 64, sc, F.WMAIN, DM, dr, scr, F.lane); continue; } r -= I_MAIN;
        if (r < I_V) { const int kb = r / 32, nb = r % 32, dr = nb * 32; const int sc = dr < 512 ? dr + 1024 : dr + 1536; transpose_item(F.w_in, 3104, kb * 64, sc, F.WV, DM, dr, scr, F.lane); continue; } r -= I_V;
        if (r < I_OUT) { const int kb = r / 32, nb = r % 32; transpose_item(F.w_out, DM, kb * 64, nb * 32, F.WOUT, DM, nb * 32, scr, F.lane); continue; } r -= I_OUT;
        if (r < I_GU) { const int kb = r / 176, nb = r % 176, dr = nb * 32, pn = dr >> 8, jj = dr & 255; const int sc = jj < 128 ? 128 * pn + jj : FFN + 128 * pn + (jj - 128); transpose_item(F.w_gu, 2 * FFN, kb * 64, sc, F.WGU, DM, dr, scr, F.lane); continue; } r -= I_GU;
        { const int kb = r / 32, nb = r % 32; transpose_item(F.w_down, DM, kb * 64, nb * 32, F.WDOWN, FFN, nb * 32, scr, F.lane); }
    }
    for (int i = blockIdx.x * NTHREADS + F.tid; i < 224 * 1024 / 8; i += F.G * NTHREADS) *((u32x4*)(F.WMAIN + (size_t)2080 * DM) + i) = (u32x4){0u, 0u, 0u, 0u};
}

struct RopeCS { f32x4 c0, c1, s0, s1; };
__device__ __forceinline__ void rope_cs_issue(const float* rope, int dc, int posr, int posc, RopeCS& R) {
    const int pos = (dc >> 2) ? posc : posr, i0 = 8 * (dc & 1);
    R.c0 = *(const f32x4*)(rope + pos * 16 + i0); R.c1 = *(const f32x4*)(rope + pos * 16 + i0 + 4); R.s0 = *(const f32x4*)(rope + 2048 + pos * 16 + i0); R.s1 = *(const f32x4*)(rope + 2048 + pos * 16 + i0 + 4);
}
__device__ __forceinline__ int rope_partner(int dc) { return ((dc & 3) < 2) ? dc + 2 : dc - 2; }
__device__ __forceinline__ void rope_apply(const u32x4 mine, const u32x4 part, const RopeCS& R, int dc, bool do_rope, float (&o)[8]) {
    float a[8]; unpack8(mine, a);
    if (!do_rope) {
#pragma unroll
        for (int j = 0; j < 8; ++j) o[j] = a[j];
        return; }
    float p[8]; unpack8(part, p);
    const bool first = (dc & 3) < 2;
    const float cs[8] = {R.c0[0], R.c0[1], R.c0[2], R.c0[3], R.c1[0], R.c1[1], R.c1[2], R.c1[3]}, sn[8] = {R.s0[0], R.s0[1], R.s0[2], R.s0[3], R.s1[0], R.s1[1], R.s1[2], R.s1[3]};
#pragma unroll
    for (int j = 0; j < 8; ++j) o[j] = first ? (a[j] * cs[j] - p[j] * sn[j]) : (p[j] * sn[j] + a[j] * cs[j]);
}
constexpr int AS16 = 40;
__device__ __forceinline__ void gate_mfma(const bf16* as16, int half, int dirofs, const bf16x8 wb, float ba, int lane, float (&lg)[8]) {
    const int i = lane & 15, fq = lane >> 4, kap = 8 * (i >> 2) + (i & 3);
    const bf16x8 zero = (bf16x8){0, 0, 0, 0, 0, 0, 0, 0};
    bf16x8 a0 = *(const bf16x8*)(as16 + (32 * half + kap) * AS16 + dirofs + 8 * (fq & 1));
    bf16x8 a1 = *(const bf16x8*)(as16 + (32 * half + kap + 4) * AS16 + dirofs + 8 * (fq & 1));
    if (fq >= 2) { a0 = zero; a1 = zero; }
    const f32x4 z0 = __builtin_amdgcn_mfma_f32_16x16x32_bf16(a0, wb, (f32x4){0.f, 0.f, 0.f, 0.f}, 0, 0, 0), z1 = __builtin_amdgcn_mfma_f32_16x16x32_bf16(a1, wb, (f32x4){0.f, 0.f, 0.f, 0.f}, 0, 0, 0);
#pragma unroll
    for (int r = 0; r < 4; ++r) { lg[r] = logsig16(z0[r] + ba); lg[4 + r] = logsig16(z1[r] + ba); }
}
__device__ __forceinline__ void stage_gate_weights(const Frame& F, u32x4* WB, float* BAS) {
    for (int e = F.tid; e < 2048; e += NTHREADS) { const int ln = e & 63, dt = (e >> 6) & 3, dirh = e >> 8, fq = ln >> 4, dd = ln & 15; const float* wa = (dirh >> 2) ? F.wa2_b : F.wa2_f; const int hh = dirh & 3;
        u32x4 v = (u32x4){0u, 0u, 0u, 0u};
        if (fq < 2) { float t[8];
#pragma unroll
            for (int jj = 0; jj < 8; ++jj) t[jj] = wa[(8 * fq + jj) * 256 + hh * 64 + 16 * dt + dd];
            v.x = pk2(t[0], t[1]); v.y = pk2(t[2], t[3]); v.z = pk2(t[4], t[5]); v.w = pk2(t[6], t[7]); }
        WB[e] = v; }
    { const int dh = F.tid >> 6, dd = F.tid & 63; BAS[F.tid] = ((dh >> 2) ? F.ba_b : F.ba_f)[(dh & 3) * 64 + dd]; }
}

__device__ __forceinline__ void ph3_gla_kv(const Frame& F) {
    float* KF = (float*)F.lds;
    bf16* ASb = (bf16*)(KF + 64 * 68);
    float* STF = (float*)(ASb + 64 * AS16);
    float* STB = STF + 512;
    bf16* KETF = (bf16*)(STB + 512);
    bf16* KETB = KETF + 64 * 72;
    u32x4* WB = (u32x4*)(KETB + 64 * 72);
    float* BAS = (float*)(WB + 2048);
    const int tid = F.tid, lane = F.lane, w = F.wave;
    stage_gate_weights(F, WB, BAS);
    __syncthreads();
    const int c = tid >> 3, dc = tid & 7, pdc = rope_partner(dc), fr = lane & 15, fq = lane >> 4;
    auto geom = [&](int it, int& h, int& ch, int& tok0, bool& isctx, size_t& itf, size_t& itb) {
        const int n = it % NCH, bh = it / NCH; h = bh & 3; const int b = bh >> 2;
        isctx = n < 4; ch = isctx ? n : n - 4;
        tok0 = isctx ? MLAT + b * CTXL + 64 * ch : b * SEQ + 64 * ch;
        const int nb = isctx ? 3 - n : 4 + (127 - ch);
        itf = (size_t)(bh * 2) * NCH + n; itb = (size_t)(bh * 2 + 1) * NCH + nb;
    };
    u32x4 pkm, pkp, paw; RopeCS pcs; bf16x8 pbv[2];
    auto issue_a = [&](int it) { int h, ch, tok0; bool isctx; size_t itf, itb; geom(it, h, ch, tok0, isctx, itf, itb);
        pkm = *(const u32x4*)(F.P1 + p1_off(tok0 + c, CGK + h * 64 + 8 * dc)); pkp = *(const u32x4*)(F.P1 + p1_off(tok0 + c, CGK + h * 64 + 8 * pdc)); paw = *(const u32x4*)(F.P1 + p1_off(tok0 + c, CAF + 8 * (dc & 3)));
        rope_cs_issue(F.ROPE, dc, ch, c, pcs); };
    auto issue_c = [&](int it) { int h, ch, tok0; bool isctx; size_t itf, itb; geom(it, h, ch, tok0, isctx, itf, itb);
        pbv[0] = *(const bf16x8*)(F.VT + vt_off(512 + h * 128 + 16 * w + fr, tok0 + 8 * fq)); pbv[1] = *(const bf16x8*)(F.VT + vt_off(512 + h * 128 + 16 * w + fr, tok0 + 32 + 8 * fq)); };
    const int NIT = 32 * NCH;
    if ((int)blockIdx.x < NIT) { issue_a(blockIdx.x); issue_c(blockIdx.x); }
    for (int it = blockIdx.x; it < NIT; it += F.G) {
        int h, ch, tok0; bool isctx; size_t itf, itb; geom(it, h, ch, tok0, isctx, itf, itb);
        const int itn = (it + F.G < NIT) ? it + F.G : it;
        {
            float k8[8];
            rope_apply(pkm, pkp, pcs, dc, !isctx, k8);
            *(f32x4*)(KF + c * 68 + 8 * dc) = (f32x4){k8[0], k8[1], k8[2], k8[3]}; *(f32x4*)(KF + c * 68 + 8 * dc + 4) = (f32x4){k8[4], k8[5], k8[6], k8[7]};
            if (dc < 4) *(u32x4*)(ASb + c * AS16 + 8 * dc) = paw;
            issue_a(itn);
        }
        const int gdt = w & 3, ghalf = w >> 2, d = 16 * gdt + fr, seg = 4 * ghalf + fq;
        const bf16x8 wbf = __builtin_bit_cast(bf16x8, WB[(h * 4 + gdt) * 64 + lane]), wbb = __builtin_bit_cast(bf16x8, WB[((4 + h) * 4 + gdt) * 64 + lane]);
        const float baf = BAS[h * 64 + d], bab = BAS[(4 + h) * 64 + d];
        __syncthreads();
        {
            float rf[8], rb[8];
            gate_mfma(ASb, ghalf, 0, wbf, baf, lane, rf);
            gate_mfma(ASb, ghalf, 16, wbb, bab, lane, rb);
#pragma unroll
            for (int i = 1; i < 8; ++i) rf[i] += rf[i - 1];
#pragma unroll
            for (int i = 6; i >= 0; --i) rb[i] += rb[i + 1];
            STF[seg * 64 + d] = rf[7]; STB[seg * 64 + d] = rb[0];
            __syncthreads();
            float offf = 0.f, offb = 0.f, bendf = 0.f, bendb = 0.f;
#pragma unroll
            for (int s2 = 0; s2 < 8; ++s2) { const float tf = STF[s2 * 64 + d], tb = STB[s2 * 64 + d]; bendf += tf; bendb += tb; if (s2 < seg) offf += tf; if (s2 > seg) offb += tb; }
            float kef[8], keb[8];
#pragma unroll
            for (int i = 0; i < 8; ++i) { const float kk = KF[(8 * seg + i) * 68 + d]; kef[i] = kk * __expf(bendf - (offf + rf[i])); keb[i] = kk * __expf(bendb - (offb + rb[i])); }
            u32x4 o; o.x = pk2(kef[0], kef[1]); o.y = pk2(kef[2], kef[3]); o.z = pk2(kef[4], kef[5]); o.w = pk2(kef[6], kef[7]);
            *(u32x4*)(KETF + d * 72 + 8 * seg) = o;
            o.x = pk2(keb[0], keb[1]); o.y = pk2(keb[2], keb[3]); o.z = pk2(keb[4], keb[5]); o.w = pk2(keb[6], keb[7]);
            *(u32x4*)(KETB + d * 72 + 8 * seg) = o;
            if (seg == 0) F.DEC[itf * 64 + d] = __expf(bendf);
            if (seg == 1) F.DEC[itb * 64 + d] = __expf(bendb);
        }
        __syncthreads();
        {
            const bf16x8 bv0 = pbv[0], bv1 = pbv[1];
            bf16* dstf = F.KV + (itf * 128 + 16 * w + fr) * 64 + 8 * fq; bf16* dstb = F.KV + (itb * 128 + 16 * w + fr) * 64 + 8 * fq;
            const int kapr = 8 * (fr >> 2) + (fr & 3);
#pragma unroll
            for (int p = 0; p < 2; ++p) { f32x4 af_[2], ab_[2];
#pragma unroll
                for (int t = 0; t < 2; ++t) { const int row = 32 * p + kapr + 4 * t; f32x4 accf = (f32x4){0.f, 0.f, 0.f, 0.f}, accb = accf;
                    const bf16x8 af0 = *(const bf16x8*)(KETF + row * 72 + 8 * fq), af1 = *(const bf16x8*)(KETF + row * 72 + 32 + 8 * fq);
                    const bf16x8 ab0 = *(const bf16x8*)(KETB + row * 72 + 8 * fq), ab1 = *(const bf16x8*)(KETB + row * 72 + 32 + 8 * fq);
                    accf = __builtin_amdgcn_mfma_f32_16x16x32_bf16(af0, bv0, accf, 0, 0, 0); accb = __builtin_amdgcn_mfma_f32_16x16x32_bf16(ab0, bv0, accb, 0, 0, 0);
                    accf = __builtin_amdgcn_mfma_f32_16x16x32_bf16(af1, bv1, accf, 0, 0, 0); accb = __builtin_amdgcn_mfma_f32_16x16x32_bf16(ab1, bv1, accb, 0, 0, 0);
                    af_[t] = accf; ab_[t] = accb; }
                u32x4 o; o.x = pk2(af_[0][0], af_[0][1]); o.y = pk2(af_[0][2], af_[0][3]); o.z = pk2(af_[1][0], af_[1][1]); o.w = pk2(af_[1][2], af_[1][3]); *(u32x4*)(dstf + 32 * p) = o;
                o.x = pk2(ab_[0][0], ab_[0][1]); o.y = pk2(ab_[0][2], ab_[0][3]); o.z = pk2(ab_[1][0], ab_[1][1]); o.w = pk2(ab_[1][2], ab_[1][3]); *(u32x4*)(dstb + 32 * p) = o; }
            issue_c(itn);
        }
    }
    __syncthreads();
}

__device__ __forceinline__ void ph4_gla_scan(const Frame& F) {
    constexpr int UB = 12;
    for (int idx = blockIdx.x * NTHREADS + F.tid; idx < 64 * 2048; idx += F.G * NTHREADS) {
        const int seq = idx >> 11, within = idx & 2047, e = within >> 4, d = 4 * (within & 15);
        bf16* p = F.KV + ((size_t)seq * NCH * 128 + e) * 64 + d; const float* dp = F.DEC + (size_t)seq * NCH * 64 + d;
        float s0 = 0.f, s1 = 0.f, s2 = 0.f, s3 = 0.f;
        for (int n0 = 0; n0 < NCH; n0 += UB) {
            u32x2 kv[UB]; f32x4 dc[UB];
#pragma unroll
            for (int u = 0; u < UB; ++u) { kv[u] = *(const u32x2*)(p + (size_t)(n0 + u) * 128 * 64); dc[u] = *(const f32x4*)(dp + (n0 + u) * 64); }
#pragma unroll
            for (int u = 0; u < UB; ++u) {
                u32x2 o; o.x = pk2(s0, s1); o.y = pk2(s2, s3); *(u32x2*)(p + (size_t)(n0 + u) * 128 * 64) = o;
                s0 = dc[u][0] * s0 + bflo(kv[u].x); s1 = dc[u][1] * s1 + bfhi(kv[u].x); s2 = dc[u][2] * s2 + bflo(kv[u].y); s3 = dc[u][3] * s3 + bfhi(kv[u].y); }
        }
    }
}

__device__ __forceinline__ void ph5_gla_out(const Frame& F) {
    float* BCF = (float*)F.lds;
    float* BCB = BCF + 64 * 68;
    float* STF = BCB + 64 * 68;
    float* STB = STF + 512;
    bf16* ASb = (bf16*)(STB + 512);
    float* SS = (float*)(ASb + 64 * AS16);
    bf16* QDF = (bf16*)(SS + 512);
    bf16* KIF = QDF + 64 * 72;
    bf16* QDB = KIF + 64 * 72;
    bf16* KIB = QDB + 64 * 72;
    bf16* AT = KIB + 64 * 72;
    u32x4* WB = (u32x4*)(AT + 64 * 72);
    float* BAS = (float*)(WB + 2048);
    const int tid = F.tid, lane = F.lane, w = F.wave, fr = lane & 15, fq = lane >> 4;
    stage_gate_weights(F, WB, BAS);
    __syncthreads();
    const int c = tid >> 3, dc = tid & 7, pdc = rope_partner(dc);
    u32x4 pqm, pqp, pkm, pkp, paw; RopeCS pcs; u32x2 pgr[4]; bf16x8 pav[2], pasf[2], pasb[2];
    auto issue_a = [&](int it) { const int j = it & 127, h = (it >> 7) & 3, b = it >> 9; const int tok0 = b * SEQ + 64 * j;
        pqm = *(const u32x4*)(F.P1 + p1_off(tok0 + c, CGQ + h * 64 + 8 * dc)); pqp = *(const u32x4*)(F.P1 + p1_off(tok0 + c, CGQ + h * 64 + 8 * pdc));
        pkm = *(const u32x4*)(F.P1 + p1_off(tok0 + c, CGK + h * 64 + 8 * dc)); pkp = *(const u32x4*)(F.P1 + p1_off(tok0 + c, CGK + h * 64 + 8 * pdc));
        paw = *(const u32x4*)(F.P1 + p1_off(tok0 + c, CAF + 8 * (dc & 3)));
        rope_cs_issue(F.ROPE, dc, j, c, pcs);
#pragma unroll
        for (int ct = 0; ct < 4; ++ct) pgr[ct] = *(const u32x2*)(F.P1 + p1_off(tok0 + 16 * ct + fr, CGR + h * 128 + 16 * w + 4 * fq)); };
    auto issue_e = [&](int it) { const int j = it & 127, h = (it >> 7) & 3, b = it >> 9; const int tok0 = b * SEQ + 64 * j;
        const int seqf = (b * 4 + h) * 2, seqb = seqf + 1;
        const bf16* vrow = F.VT + vt_off(512 + h * 128 + 16 * w + fr, tok0 + 8 * fq); const bf16* vrow1 = F.VT + vt_off(512 + h * 128 + 16 * w + fr, tok0 + 32 + 8 * fq);
        const bf16* sfp = F.KV + (((size_t)seqf * NCH + 4 + j) * 128 + 16 * w + fr) * 64 + 8 * fq;
        const bf16* sbp = F.KV + (((size_t)seqb * NCH + 4 + (127 - j)) * 128 + 16 * w + fr) * 64 + 8 * fq;
        pav[0] = *(const bf16x8*)vrow; pav[1] = *(const bf16x8*)vrow1; pasf[0] = *(const bf16x8*)sfp; pasf[1] = *(const bf16x8*)(sfp + 32); pasb[0] = *(const bf16x8*)sbp; pasb[1] = *(const bf16x8*)(sbp + 32); };
    const int NIT = NB * 4 * 128;
    if ((int)blockIdx.x < NIT) { issue_a(blockIdx.x); issue_e(blockIdx.x); }
    for (int it = blockIdx.x; it < NIT; it += F.G) {
        const int j = it & 127, h = (it >> 7) & 3, b = it >> 9;
        const int tok0 = b * SEQ + 64 * j;
        const int itn = (it + F.G < NIT) ? it + F.G : it;
        float q8[8], k8[8]; u32x2 gr[4];
        {
            rope_apply(pqm, pqp, pcs, dc, true, q8);
            rope_apply(pkm, pkp, pcs, dc, true, k8);
            if (dc < 4) *(u32x4*)(ASb + c * AS16 + 8 * dc) = paw;
#pragma unroll
            for (int ct = 0; ct < 4; ++ct) gr[ct] = pgr[ct];
            issue_a(itn);
        }
        {
            const int gdt = w & 3, ghalf = w >> 2, d = 16 * gdt + fr, seg = 4 * ghalf + fq;
            const bf16x8 wbf = __builtin_bit_cast(bf16x8, WB[(h * 4 + gdt) * 64 + lane]), wbb = __builtin_bit_cast(bf16x8, WB[((4 + h) * 4 + gdt) * 64 + lane]);
            const float baf = BAS[h * 64 + d], bab = BAS[(4 + h) * 64 + d];
            __syncthreads();
            float rf[8], rb[8];
            gate_mfma(ASb, ghalf, 0, wbf, baf, lane, rf);
            gate_mfma(ASb, ghalf, 16, wbb, bab, lane, rb);
#pragma unroll
            for (int i = 1; i < 8; ++i) rf[i] += rf[i - 1];
#pragma unroll
            for (int i = 6; i >= 0; --i) rb[i] += rb[i + 1];
            STF[seg * 64 + d] = rf[7]; STB[seg * 64 + d] = rb[0];
            __syncthreads();
            float offf = 0.f, offb = 0.f;
#pragma unroll
            for (int s2 = 0; s2 < 8; ++s2) { if (s2 < seg) offf += STF[s2 * 64 + d]; if (s2 > seg) offb += STB[s2 * 64 + d]; }
#pragma unroll
            for (int i = 0; i < 8; ++i) { BCF[(8 * seg + i) * 68 + d] = offf + rf[i]; BCB[(8 * seg + i) * 68 + d] = offb + rb[i]; }
        }
        __syncthreads();
        {
            const f32x4 f0 = *(const f32x4*)(BCF + c * 68 + 8 * dc), f1 = *(const f32x4*)(BCF + c * 68 + 8 * dc + 4), b0 = *(const f32x4*)(BCB + c * 68 + 8 * dc), b1 = *(const f32x4*)(BCB + c * 68 + 8 * dc + 4);
            const float bf[8] = {f0[0], f0[1], f0[2], f0[3], f1[0], f1[1], f1[2], f1[3]}, bb[8] = {b0[0], b0[1], b0[2], b0[3], b1[0], b1[1], b1[2], b1[3]};
            float qf[8], kf[8], qb[8], kb[8];
#pragma unroll
            for (int i = 0; i < 8; ++i) { qf[i] = q8[i] * __expf(bf[i]) * 0.125f; kf[i] = k8[i] * __expf(-bf[i]); qb[i] = q8[i] * __expf(bb[i]) * 0.125f; kb[i] = k8[i] * __expf(-bb[i]); }
            u32x4 o;
            o.x = pk2(qf[0], qf[1]); o.y = pk2(qf[2], qf[3]); o.z = pk2(qf[4], qf[5]); o.w = pk2(qf[6], qf[7]); *(u32x4*)(QDF + c * 72 + 8 * dc) = o;
            o.x = pk2(kf[0], kf[1]); o.y = pk2(kf[2], kf[3]); o.z = pk2(kf[4], kf[5]); o.w = pk2(kf[6], kf[7]); *(u32x4*)(KIF + c * 72 + 8 * dc) = o;
            o.x = pk2(qb[0], qb[1]); o.y = pk2(qb[2], qb[3]); o.z = pk2(qb[4], qb[5]); o.w = pk2(qb[6], qb[7]); *(u32x4*)(QDB + c * 72 + 8 * dc) = o;
            o.x = pk2(kb[0], kb[1]); o.y = pk2(kb[2], kb[3]); o.z = pk2(kb[4], kb[5]); o.w = pk2(kb[6], kb[7]); *(u32x4*)(KIB + c * 72 + 8 * dc) = o;
        }
        __syncthreads();
        {
            const int ct = w & 3, sp = w >> 2;
            const bf16x8 bqf0 = *(const bf16x8*)(QDF + (16 * ct + fr) * 72 + 8 * fq), bqf1 = *(const bf16x8*)(QDF + (16 * ct + fr) * 72 + 32 + 8 * fq);
            const bf16x8 bqb0 = *(const bf16x8*)(QDB + (16 * ct + fr) * 72 + 8 * fq), bqb1 = *(const bf16x8*)(QDB + (16 * ct + fr) * 72 + 32 + 8 * fq);
#pragma unroll
            for (int t = 0; t < 2; ++t) { const int st = 2 * sp + t;
                f32x4 af = (f32x4){0.f, 0.f, 0.f, 0.f}, ab = af;
                af = __builtin_amdgcn_mfma_f32_16x16x32_bf16(*(const bf16x8*)(KIF + (16 * st + fr) * 72 + 8 * fq), bqf0, af, 0, 0, 0);
                af = __builtin_amdgcn_mfma_f32_16x16x32_bf16(*(const bf16x8*)(KIF + (16 * st + fr) * 72 + 32 + 8 * fq), bqf1, af, 0, 0, 0);
                ab = __builtin_amdgcn_mfma_f32_16x16x32_bf16(*(const bf16x8*)(KIB + (16 * st + fr) * 72 + 8 * fq), bqb0, ab, 0, 0, 0);
                ab = __builtin_amdgcn_mfma_f32_16x16x32_bf16(*(const bf16x8*)(KIB + (16 * st + fr) * 72 + 32 + 8 * fq), bqb1, ab, 0, 0, 0);
                const int cc = 16 * ct + fr, s0 = 16 * st + 4 * fq; float tt[4];
#pragma unroll
                for (int r = 0; r < 4; ++r) { const int s = s0 + r; tt[r] = (s <= cc ? af[r] : 0.f) + (s >= cc ? ab[r] : 0.f); }
                u32x2 o; o.x = pk2(tt[0], tt[1]); o.y = pk2(tt[2], tt[3]); *(u32x2*)(AT + cc * 72 + s0) = o; }
        }
        __syncthreads();
        f32x4 o4[4];
        {
#pragma unroll
            for (int ct = 0; ct < 4; ++ct) { f32x4 acc = (f32x4){0.f, 0.f, 0.f, 0.f};
#pragma unroll
                for (int ks = 0; ks < 2; ++ks) {
                    acc = __builtin_amdgcn_mfma_f32_16x16x32_bf16(pav[ks], *(const bf16x8*)(AT + (16 * ct + fr) * 72 + 32 * ks + 8 * fq), acc, 0, 0, 0);
                    acc = __builtin_amdgcn_mfma_f32_16x16x32_bf16(pasf[ks], *(const bf16x8*)(QDF + (16 * ct + fr) * 72 + 32 * ks + 8 * fq), acc, 0, 0, 0);
                    acc = __builtin_amdgcn_mfma_f32_16x16x32_bf16(pasb[ks], *(const bf16x8*)(QDB + (16 * ct + fr) * 72 + 32 * ks + 8 * fq), acc, 0, 0, 0); }
                o4[ct] = acc;
                float p = (acc[0] * acc[0] + acc[1] * acc[1]) + (acc[2] * acc[2] + acc[3] * acc[3]); p += __shfl_xor(p, 16); p += __shfl_xor(p, 32);
                if (fq == 0) SS[w * 64 + 16 * ct + fr] = p; }
            issue_e(itn);
        }
        __syncthreads();
        {
            const f32x4 gn = *(const f32x4*)(F.gla_norm + h * 128 + 16 * w + 4 * fq);
#pragma unroll
            for (int ct = 0; ct < 4; ++ct) { const int cc = 16 * ct + fr; float tot = 0.f;
#pragma unroll
                for (int w2 = 0; w2 < 8; ++w2) tot += SS[w2 * 64 + cc];
                const float rs = 1.0f / sqrtf(tot * (1.0f / 128.0f) + EPS);
                const float g[4] = {bflo(gr[ct].x), bfhi(gr[ct].x), bflo(gr[ct].y), bfhi(gr[ct].y)}; float y[4];
#pragma unroll
                for (int r = 0; r < 4; ++r) y[r] = o4[ct][r] * rs * gn[r] * (g[r] * __builtin_amdgcn_rcpf(1.0f + __expf(-g[r])));
                u32x2 o; o.x = pk2(y[0], y[1]); o.y = pk2(y[2], y[3]); *(u32x2*)(F.MIX + (size_t)(tok0 + cc) * DM + 512 + h * 128 + 16 * w + 4 * fq) = o; }
        }
        __syncthreads();
    }
}

__device__ __forceinline__ void ph5_na(const Frame& F) {
    constexpr int NT = 4;
    constexpr float LOG2E = 1.4426950408889634f, QS = 0.125f * LOG2E;
    bf16* CKs = (bf16*)F.lds;
    bf16* CVs = CKs + 256 * 72;
    float* RPB = (float*)(CVs + 64 * 264);
    bf16* QSw = (bf16*)(RPB + 468) + F.wave * (4 * 16 * 64);
    const int tid = F.tid, lane = F.lane, w = F.wave, qi = lane & 15, fq = lane >> 4;
    const int j = w & 3, sub = w >> 2;
    const int c = 16 * j + qi;
    const int kc0 = (j == 0) ? 0 : (j == 1) ? 8 : (j == 2) ? 24 : 32;
    const int cs = (c - 8 < 0) ? 0 : (c - 8 > 48 ? 48 : c - 8);
    const int kap = 8 * (qi >> 2) + (qi & 3);
    unsigned cmask = 0;
#pragma unroll
    for (int e = 0; e < 8; ++e) { const int kc = kc0 + 8 * fq + e; if (kc >= cs && kc < cs + 16) cmask |= 1u << e; }
    const int dc0 = kc0 + 8 * fq - c + 15;
    int dcc[8];
#pragma unroll
    for (int e = 0; e < 8; ++e) { const int t = dc0 + e; dcc[e] = t < 0 ? 0 : (t > 30 ? 30 : t); }
    const float NEG_INF = -__builtin_inff();
    const int ipw = (1024 + F.G - 1) / F.G;
    int cur_bh = -1;
    for (int it = blockIdx.x * ipw; it < (blockIdx.x + 1) * ipw && it < 1024; ++it) {
        const int rg = it & 15, bh = it >> 4, head = bh & 7, b = bh >> 3;
        if (bh != cur_bh) {
            cur_bh = bh;
            __syncthreads();
            { const int row = tid >> 1, hf = tid & 1; const bf16* src = F.P1 + p1_off(MLAT + b * CTXL + row, CK + head * 64 + 32 * hf);
              u32x4 v0 = *(const u32x4*)src, v1 = *(const u32x4*)(src + 8), v2 = *(const u32x4*)(src + 16), v3 = *(const u32x4*)(src + 24);
              bf16* dst = CKs + row * 72 + 32 * hf; *(u32x4*)dst = v0; *(u32x4*)(dst + 8) = v1; *(u32x4*)(dst + 16) = v2; *(u32x4*)(dst + 24) = v3; }
            { const int row = tid >> 3, sg = tid & 7; const int t0 = MLAT + b * CTXL + 32 * sg;
              u32x4 v0 = *(const u32x4*)(F.VT + vt_off(head * 64 + row, t0)), v1 = *(const u32x4*)(F.VT + vt_off(head * 64 + row, t0 + 8)), v2 = *(const u32x4*)(F.VT + vt_off(head * 64 + row, t0 + 16)), v3 = *(const u32x4*)(F.VT + vt_off(head * 64 + row, t0 + 24));
              bf16* dst = CVs + row * 264 + 32 * sg; *(u32x4*)dst = v0; *(u32x4*)(dst + 8) = v1; *(u32x4*)(dst + 16) = v2; *(u32x4*)(dst + 24) = v3; }
            if (tid < 465) RPB[tid] = F.rpb[head * 465 + tid] * LOG2E;
            __syncthreads();
        }
        const int rA = 8 * rg + 4 * sub;
        {
            bf16x8 qt[NT][2];
#pragma unroll
            for (int nt = 0; nt < NT; ++nt) { const bf16* qp = F.P1 + p1_off(b * SEQ + (rA + nt) * 64 + c, CQ + head * 64 + 8 * fq); qt[nt][0] = *(const bf16x8*)qp; qt[nt][1] = *(const bf16x8*)(qp + 32); }
#pragma unroll
            for (int nt = 0; nt < NT; ++nt)
#pragma unroll
                for (int ks = 0; ks < 2; ++ks) *(bf16x8*)(QSw + (nt * 16 + qi) * 64 + 8 * ((4 * ks + fq) ^ (qi & 7))) = qt[nt][ks];
        }
        float m[NT], l[NT]; f32x4 O[4][NT];
#pragma unroll
        for (int nt = 0; nt < NT; ++nt) { m[nt] = NEG_INF; l[nt] = 0.f;
#pragma unroll
            for (int dt = 0; dt < 4; ++dt) O[dt][nt] = (f32x4){0.f, 0.f, 0.f, 0.f}; }
        auto na_tile = [&](int nt, bool local, int kr, const bf16x8 (&kf)[2][2], const bf16x8 (&vf)[4]) {
            const int r = rA + nt;
            const bf16x8 q0 = *(const bf16x8*)(QSw + (nt * 16 + qi) * 64 + 8 * (fq ^ (qi & 7))), q1 = *(const bf16x8*)(QSw + (nt * 16 + qi) * 64 + 8 * ((4 + fq) ^ (qi & 7)));
            f32x4 s0 = (f32x4){0.f, 0.f, 0.f, 0.f}, s1 = s0;
            s0 = __builtin_amdgcn_mfma_f32_16x16x32_bf16(kf[0][0], q0, s0, 0, 0, 0); s0 = __builtin_amdgcn_mfma_f32_16x16x32_bf16(kf[0][1], q1, s0, 0, 0, 0);
            s1 = __builtin_amdgcn_mfma_f32_16x16x32_bf16(kf[1][0], q0, s1, 0, 0, 0); s1 = __builtin_amdgcn_mfma_f32_16x16x32_bf16(kf[1][1], q1, s1, 0, 0, 0);
            float sc[8];
            if (local) { const float* rp = RPB + (kr - r + 7) * 31; float bias[8];
#pragma unroll
                for (int e = 0; e < 8; ++e) bias[e] = rp[dcc[e]];
#pragma unroll
                for (int e = 0; e < 8; ++e) { const float a = (e < 4) ? s0[e & 3] : s1[e & 3]; sc[e] = ((cmask >> e) & 1u) ? a * QS + bias[e] : NEG_INF; }
            } else {
#pragma unroll
                for (int e = 0; e < 8; ++e) { const float a = (e < 4) ? s0[e & 3] : s1[e & 3]; sc[e] = a * QS; }
            }
            const float lmax = fmaxf(fmaxf(fmaxf(sc[0], sc[1]), fmaxf(sc[2], sc[3])), fmaxf(fmaxf(sc[4], sc[5]), fmaxf(sc[6], sc[7])));
            if (!__all(lmax <= m[nt] + 11.0f)) {
                float mx = fmaxf(lmax, __shfl_xor(lmax, 16)); mx = fmaxf(mx, __shfl_xor(mx, 32));
                const float mn = fmaxf(m[nt], mx), alpha = __builtin_amdgcn_exp2f(m[nt] - mn); m[nt] = mn; l[nt] *= alpha;
#pragma unroll
                for (int dt = 0; dt < 4; ++dt) O[dt][nt] = O[dt][nt] * alpha; }
            const float mn = m[nt];
            float p[8], ps = 0.f;
#pragma unroll
            for (int e = 0; e < 8; ++e) { p[e] = __builtin_amdgcn_exp2f(sc[e] - mn); ps += p[e]; }
            l[nt] += ps;
            u32x4 pw; pw.x = pk2(p[0], p[1]); pw.y = pk2(p[2], p[3]); pw.z = pk2(p[4], p[5]); pw.w = pk2(p[6], p[7]);
            const bf16x8 pf = __builtin_bit_cast(bf16x8, pw);
#pragma unroll
            for (int dt = 0; dt < 4; ++dt) O[dt][nt] = __builtin_amdgcn_mfma_f32_16x16x32_bf16(vf[dt], pf, O[dt][nt], 0, 0, 0);
            __builtin_amdgcn_sched_barrier(0);
        };
#pragma unroll 1
        for (int s = 0; s < 8; ++s) {
            bf16x8 kf[2][2], vf[4];
#pragma unroll
            for (int t = 0; t < 2; ++t) { const bf16* kp = CKs + (32 * s + kap + 4 * t) * 72 + 8 * fq; kf[t][0] = *(const bf16x8*)kp; kf[t][1] = *(const bf16x8*)(kp + 32); }
#pragma unroll
            for (int dt = 0; dt < 4; ++dt) vf[dt] = *(const bf16x8*)(CVs + (dt * 16 + qi) * 264 + 32 * s + 8 * fq);
#pragma unroll
            for (int nt = 0; nt < NT; ++nt) na_tile(nt, false, 0, kf, vf);
        }
        const int rsA = (rA - 4 < 0) ? 0 : (rA - 4 > 120 ? 120 : rA - 4);
        const int rlast = rA + NT - 1; const int rsB = (rlast - 4 < 0) ? 0 : (rlast - 4 > 120 ? 120 : rlast - 4);
        const int nloc = rsB + 8 - rsA, slast = nloc - 1;
        auto na_loadk = [&](int s, bf16x8 (&kf)[2][2]) {
            const int base_tok = b * SEQ + (rsA + s) * 64 + kc0;
#pragma unroll
            for (int t = 0; t < 2; ++t) { const bf16* kp = F.P1 + p1_off(base_tok + kap + 4 * t, CK + head * 64 + 8 * fq); kf[t][0] = *(const bf16x8*)kp; kf[t][1] = *(const bf16x8*)(kp + 32); }
        };
        auto na_step = [&](int s, const bf16x8 (&kf)[2][2]) {
            const int kr = rsA + s; const int base_tok = b * SEQ + kr * 64 + kc0;
            bf16x8 vf[4];
#pragma unroll
            for (int dt = 0; dt < 4; ++dt) vf[dt] = *(const bf16x8*)(F.VT + vt_off(head * 64 + dt * 16 + qi, base_tok + 8 * fq));
#pragma unroll
            for (int nt = 0; nt < NT; ++nt) {
                const int r = rA + nt; const int rs = (r - 4 < 0) ? 0 : (r - 4 > 120 ? 120 : r - 4);
                if (kr < rs || kr >= rs + 8) continue;
                na_tile(nt, true, kr, kf, vf);
            }
        };
        bf16x8 kfA[2][2], kfB[2][2];
        na_loadk(0, kfA);
        for (int s = 0; s < slast; s += 2) {
            na_loadk(s + 1, kfB);
            na_step(s, kfA);
            na_loadk((s + 2 < slast) ? s + 2 : slast, kfA);
            na_step(s + 1, kfB);
        }
        if (nloc & 1) na_step(slast, kfA);
#pragma unroll
        for (int nt = 0; nt < NT; ++nt) { float lt = l[nt]; lt += __shfl_xor(lt, 16); lt += __shfl_xor(lt, 32); const float inv = 1.0f / lt;
            bf16* op = F.MIX + (size_t)(b * SEQ + (rA + nt) * 64 + c) * DM + head * 64 + 4 * fq;
#pragma unroll
            for (int dt = 0; dt < 4; ++dt) { const f32x4 o = O[dt][nt] * inv; u32x2 ow; ow.x = pk2(o[0], o[1]); ow.y = pk2(o[2], o[3]); *(u32x2*)(op + 16 * dt) = ow; } }
    }
    __syncthreads();
}

__device__ __forceinline__ void ph7_mid(const Frame& F) {
    const int gw = blockIdx.x * 8 + F.wave, NGW = F.G * 8;
    int curb = -1; f32x4 c1[4], cA[4], cB[4];
#pragma unroll
    for (int j = 0; j < 4; ++j) { c1[j] = (f32x4){0.f, 0.f, 0.f, 0.f}; cA[j] = c1[j]; cB[j] = c1[j]; }
    for (int row0 = gw; row0 < MLAT; row0 += 2 * NGW) {
        const int nr = (row0 + NGW < MLAT) ? 2 : 1;
        f32x4 v[2][4]; u32x2 yw[2][4]; float sqp[2];
#pragma unroll
        for (int q = 0; q < 2; ++q) { const int row = (q < nr) ? row0 + q * NGW : row0;
#pragma unroll
            for (int j = 0; j < 4; ++j) { v[q][j] = __builtin_nontemporal_load((const f32x4*)(F.x + (size_t)row * DM) + F.lane + 64 * j); yw[q][j] = *((const u32x2*)(F.Y + (size_t)row * DM) + F.lane + 64 * j); }
            sqp[q] = F.lane < 16 ? F.SSQ1[(size_t)row * 16 + F.lane] : 0.f; }
#pragma unroll
        for (int q = 0; q < 2; ++q) { if (q < nr) { const int row = row0 + q * NGW; const int b = row >> 13;
            const float sq1 = wave_sum(sqp[q]);
            if (b != curb) { curb = b;
#pragma unroll
                for (int j = 0; j < 4; ++j) { const int col = 4 * (F.lane + 64 * j); const float* mb = F.MOD + b * NMOD;
                    c1[j] = *(const f32x4*)(mb + 2 * DM + col) * *(const f32x4*)(F.g_post_mix + col);
                    cA[j] = *(const f32x4*)(F.g_pre_ffn + col) * (*(const f32x4*)(mb + 4 * DM + col) + 1.0f); cB[j] = *(const f32x4*)(mb + 3 * DM + col); } }
            const float rstd1 = 1.0f / sqrtf(sq1 * (1.0f / DM) + EPS);
            float ss = 0.f;
#pragma unroll
            for (int j = 0; j < 4; ++j) { const f32x4 y = (f32x4){bflo(yw[q][j].x), bfhi(yw[q][j].x), bflo(yw[q][j].y), bfhi(yw[q][j].y)}; v[q][j] = v[q][j] + c1[j] * (y * rstd1);
                ss += (v[q][j][0] * v[q][j][0] + v[q][j][1] * v[q][j][1]) + (v[q][j][2] * v[q][j][2] + v[q][j][3] * v[q][j][3]);
                u32x2 xw; xw.x = pk2(v[q][j][0], v[q][j][1]); xw.y = pk2(v[q][j][2], v[q][j][3]); *(u32x2*)(F.X1B + (size_t)row * DM + 4 * (F.lane + 64 * j)) = xw; }
            const float rstd2 = 1.0f / sqrtf(wave_sum(ss) * (1.0f / DM) + EPS);
#pragma unroll
            for (int j = 0; j < 4; ++j) { const f32x4 o = v[q][j] * rstd2 * cA[j] + cB[j]; u32x2 wv; wv.x = pk2(o[0], o[1]); wv.y = pk2(o[2], o[3]); *(u32x2*)(F.H + (size_t)row * DM + 4 * (F.lane + 64 * j)) = wv; } } }
    }
}
__device__ __forceinline__ void ph10_final(const Frame& F) {
    const int gw = blockIdx.x * 8 + F.wave, NGW = F.G * 8;
    int curb = -1; f32x4 c2[4];
#pragma unroll
    for (int j = 0; j < 4; ++j) c2[j] = (f32x4){0.f, 0.f, 0.f, 0.f};
    for (int row0 = gw; row0 < MLAT; row0 += 2 * NGW) {
        const int nr = (row0 + NGW < MLAT) ? 2 : 1;
        u32x2 xw[2][4], dw[2][4]; float sp2[2];
#pragma unroll
        for (int q = 0; q < 2; ++q) { const int row = (q < nr) ? row0 + q * NGW : row0;
#pragma unroll
            for (int j = 0; j < 4; ++j) { xw[q][j] = *((const u32x2*)(F.X1B + (size_t)row * DM) + F.lane + 64 * j); dw[q][j] = *((const u32x2*)(F.DOWN + (size_t)row * DM) + F.lane + 64 * j); }
            sp2[q] = F.lane < 16 ? F.SSQ2[(size_t)row * 16 + F.lane] : 0.f; }
#pragma unroll
        for (int q = 0; q < 2; ++q) { if (q < nr) { const int row = row0 + q * NGW; const int b = row >> 13;
            const float sq2 = wave_sum(sp2[q]);
            if (b != curb) { curb = b;
#pragma unroll
                for (int j = 0; j < 4; ++j) { const int col = 4 * (F.lane + 64 * j); const float* mb = F.MOD + b * NMOD; c2[j] = *(const f32x4*)(mb + 5 * DM + col) * *(const f32x4*)(F.g_post_ffn + col); } }
            const float rstd2 = 1.0f / sqrtf(sq2 * (1.0f / DM) + EPS);
#pragma unroll
            for (int j = 0; j < 4; ++j) { const f32x4 x1 = (f32x4){bflo(xw[q][j].x), bfhi(xw[q][j].x), bflo(xw[q][j].y), bfhi(xw[q][j].y)}, d = (f32x4){bflo(dw[q][j].x), bfhi(dw[q][j].x), bflo(dw[q][j].y), bfhi(dw[q][j].y)};
                const f32x4 o = x1 + c2[j] * (d * rstd2); *((f32x4*)(F.out + (size_t)row * DM) + F.lane + 64 * j) = o; } } }
    }
}

struct Args { const float* in[20]; float* out; unsigned char* ws; int ph_lo, ph_hi; };
constexpr int NPHASES = 11;

__global__ void __launch_bounds__(NTHREADS, 2) mk_fwd(Args args) {
    extern __shared__ __attribute__((aligned(16))) unsigned char lds[];
    cg::grid_group grid = cg::this_grid();
    Frame F;
    F.lds = lds; F.tid = threadIdx.x; F.lane = F.tid & 63; F.wave = __builtin_amdgcn_readfirstlane(F.tid >> 6); F.G = gridDim.x;
    F.x = args.in[0]; F.c = args.in[1]; F.ctx = args.in[2]; F.c_ctx = args.in[3]; F.w_mod = args.in[4]; F.b_mod = args.in[5]; F.g_pre_mix = args.in[6]; F.g_post_mix = args.in[7];
    F.g_pre_ffn = args.in[8]; F.g_post_ffn = args.in[9]; F.w_in = args.in[10]; F.rpb = args.in[11]; F.wa2_f = args.in[12]; F.ba_f = args.in[13]; F.wa2_b = args.in[14]; F.ba_b = args.in[15];
    F.gla_norm = args.in[16]; F.w_out = args.in[17]; F.w_gu = args.in[18]; F.w_down = args.in[19]; F.out = args.out;
    unsigned char* ws = args.ws;
    F.MOD = (float*)(ws + WS_MOD); F.ROPE = (float*)(ws + WS_ROPE); F.DEC = (float*)(ws + WS_DEC); F.SSQ1 = (float*)(ws + WS_SSQ1); F.SSQ2 = (float*)(ws + WS_SSQ2);
    F.WMAIN = (bf16*)(ws + WS_WMAIN); F.WV = (bf16*)(ws + WS_WV); F.WOUT = (bf16*)(ws + WS_WOUT); F.WGU = (bf16*)(ws + WS_WGU); F.WDOWN = (bf16*)(ws + WS_WDOWN);
    F.H = (bf16*)(ws + WS_H); F.P1 = (bf16*)(ws + WS_P1); F.VT = (bf16*)(ws + WS_VT); F.KV = (bf16*)(ws + WS_KV); F.MIX = (bf16*)(ws + WS_MIX); F.Y = (bf16*)(ws + WS_Y); F.ACT = (bf16*)(ws + WS_ACT); F.DOWN = (bf16*)(ws + WS_DOWN); F.X1B = (bf16*)(ws + WS_X1B);
    PG8_LAS unsigned char* glds = (PG8_LAS unsigned char*)lds;
    const int lo = args.ph_lo, hi = args.ph_hi;
    volatile unsigned* MISC = (volatile unsigned*)(lds + LDS_BYTES - 128);
    if (F.tid < 32) MISC[F.tid] = 0u;
    __syncthreads();
    XcdBarrier xbar = xcd_barrier_post((unsigned*)(ws + WS_CTL) + 4096, MISC + 8);
#define IN(k) (lo <= (k) && (k) < hi)
#define REP(k) ((MK_REP_PHASE == (k)) ? 2 : 1)
#define SEAM(k) do { if (IN(k) && IN((k) + 1)) { if ((k) < MK_CG_SEAMS) grid.sync(); else xcd_barrier(xbar); } } while (0)

    if (IN(0)) for (int rep = 0; rep < REP(0); ++rep) ph0_mod(F);
    SEAM(0);
    if (IN(1)) for (int rep = 0; rep < REP(1); ++rep) ph1_rows(F);
    SEAM(1);
    if (IN(2)) for (int rep = 0; rep < REP(2); ++rep) {
        pg8::Gemm g1{F.H, F.WMAIN, MTOT, LDP, DM}, g2{F.WV, F.H, 1024, MTOT, DM};
        pg8::DualOrder S; S.o1.init(g1, F.G, (int)blockIdx.x); S.o2.init(g2, F.G, (int)blockIdx.x); S.G = F.G; S.c = (int)blockIdx.x;
        pg8::EpiDual E{pg8::EpiStore{F.P1, MTOT}, pg8::EpiStoreBlk{F.VT, 1024}};
        pg8::gemm_phase<pg8::EpiDual, pg8::DualOrder, true, true>(glds, g1, S, E);
    }
    SEAM(2);
    if (IN(3)) { for (int rep = 0; rep < REP(3); ++rep) ph3_gla_kv(F); for (int rep = 0; rep < REP(11); ++rep) ph5_na(F); }
    SEAM(3);
    if (IN(4)) ph4_gla_scan(F);
    if (MK_REP_PHASE == 4) { xcd_barrier(xbar); ph3_gla_kv(F); xcd_barrier(xbar); ph4_gla_scan(F); }
    SEAM(4);
    if (IN(5)) { for (int rep = 0; rep < REP(5); ++rep) ph5_gla_out(F); }
    SEAM(5);
    if (IN(6)) for (int rep = 0; rep < REP(6); ++rep) { pg8::Gemm g{F.MIX, F.WOUT, MLAT, DM, DM}; pg8::StaticOrder S; S.init(g, F.G, (int)blockIdx.x, 1); pg8::EpiStoreSsq E{F.Y, DM, F.SSQ1};
        pg8::gemm_phase<pg8::EpiStoreSsq, pg8::StaticOrder, true, true>(glds, g, S, E); }
    SEAM(6);
    if (IN(7)) for (int rep = 0; rep < REP(7); ++rep) ph7_mid(F);
    SEAM(7);
    if (IN(8)) for (int rep = 0; rep < REP(8); ++rep) { pg8::Gemm g{F.H, F.WGU, MLAT, 2 * FFN, DM}; pg8::StaticOrder S; S.init(g, F.G, (int)blockIdx.x); pg8::EpiSwiglu E{F.ACT, FFN};
        pg8::gemm_phase<pg8::EpiSwiglu, pg8::StaticOrder, true, true>(glds, g, S, E); }
    SEAM(8);
    if (IN(9)) for (int rep = 0; rep < REP(9); ++rep) { pg8::Gemm g{F.ACT, F.WDOWN, MLAT, DM, FFN}; pg8::StaticOrder S; S.init(g, F.G, (int)blockIdx.x, 1); pg8::EpiStoreSsq E{F.DOWN, DM, F.SSQ2};
        pg8::gemm_phase<pg8::EpiStoreSsq, pg8::StaticOrder, true, true>(glds, g, S, E); }
    SEAM(9);
    if (IN(10)) for (int rep = 0; rep < REP(10); ++rep) ph10_final(F);
#undef IN
#undef SEAM
#undef REP
}

extern "C" void kernel_launch(void* const* d_in, const int* in_sizes, int n_in, void* d_out, int out_size, void* d_ws, size_t ws_size, hipStream_t stream) {
    static int grid = 0;
    if (grid == 0) {
        if (n_in != 20 || in_sizes[0] != MLAT * DM || out_size != MLAT * DM || ws_size < WS_END) { fprintf(stderr, "kernel_launch: unexpected shapes (n_in %d, in0 %d, out %d, ws %zu)\n", n_in, n_in > 0 ? in_sizes[0] : -1, out_size, ws_size); grid = -1; return; }
        int dev = 0, cus = 0, per_cu = 0;
        if (hipGetDevice(&dev) != hipSuccess || hipDeviceGetAttribute(&cus, hipDeviceAttributeMultiprocessorCount, dev) != hipSuccess) { fprintf(stderr, "kernel_launch: device query failed\n"); grid = -1; return; }
        if (hipFuncSetAttribute((const void*)mk_fwd, hipFuncAttributeMaxDynamicSharedMemorySize, LDS_BYTES) != hipSuccess) { fprintf(stderr, "kernel_launch: hipFuncSetAttribute failed\n"); grid = -1; return; }
        if (hipOccupancyMaxActiveBlocksPerMultiprocessor(&per_cu, (const void*)mk_fwd, NTHREADS, LDS_BYTES) != hipSuccess || per_cu < 1) { fprintf(stderr, "kernel_launch: occupancy query says %d blocks per CU\n", per_cu); (void)hipGetLastError(); grid = -1; return; }
        grid = cus;
    }
    if (grid < 0) return;
    if (hipMemsetAsync((char*)d_ws + WS_CTL, 0, CTL_ZERO_BYTES, stream) != hipSuccess) { fprintf(stderr, "kernel_launch: hipMemsetAsync failed\n"); return; }
    Args a{};
    for (int i = 0; i < 20; ++i) a.in[i] = (const float*)d_in[i];
    a.out = (float*)d_out; a.ws = (unsigned char*)d_ws;
#if MK_PER_PHASE
    for (int p = 0; p < NPHASES; ++p) { a.ph_lo = p; a.ph_hi = p + 1; void* kargs[] = {&a};
        hipError_t e = hipLaunchCooperativeKernel((const void*)mk_fwd, dim3(grid), dim3(NTHREADS), kargs, LDS_BYTES, stream);
        if (e != hipSuccess) { fprintf(stderr, "kernel_launch: launch of phase %d failed: %s\n", p, hipGetErrorString(e)); break; } }
#else
    a.ph_lo = 0; a.ph_hi = NPHASES; void* kargs[] = {&a};
    hipError_t e = hipLaunchCooperativeKernel((const void*)mk_fwd, dim3(grid), dim3(NTHREADS), kargs, LDS_BYTES, stream);
    if (e != hipSuccess) fprintf(stderr, "kernel_launch: cooperative launch failed: %s (grid %d)\n", hipGetErrorString(e), grid);
#endif
}
```

```cpp
#include <hip/hip_runtime.h>
#include <hip/hip_cooperative_groups.h>
#include <cstdio>
#include <cstdint>
namespace cg = cooperative_groups;

#ifndef MK_PER_PHASE
#define MK_PER_PHASE 0
#endif
#ifndef MK_REP_PHASE
#define MK_REP_PHASE -1
#endif
#ifndef MK_CG_SEAMS
#define MK_CG_SEAMS 0
#endif

namespace pg8 {
#define PG8_LAS __attribute__((address_space(3)))
typedef unsigned short bf16_t;
typedef short bf16x8 __attribute__((ext_vector_type(8)));
typedef float f32x4 __attribute__((ext_vector_type(4)));
typedef unsigned u32x4 __attribute__((ext_vector_type(4)));
constexpr int BM = 256, BK = 64, HALF = 128, HTB = HALF * BK * 2, STAGE_BYTES = 8 * HTB, NXCD = 8, WGM = 8;

__host__ __device__ __forceinline__ int lds_byte(int r, int c) { const int st = (r >> 4) * 2 + (c >> 5), rr = r & 15, cc = c & 31, ob = rr * 64 + cc * 2; return st * 1024 + (ob ^ (((ob >> 9) & 1) << 5)); }
__host__ __device__ __forceinline__ void stage_rc(int b, int& R, int& C) { const int st = b / 1024, sb = b % 1024, swz = sb ^ (((sb >> 9) & 1) << 5); R = (st >> 1) * 16 + swz / 64; C = (st & 1) * 32 + (swz % 64) / 2; }
__host__ __device__ __forceinline__ int perm32(int rho) { const int n = rho >> 4, i = rho & 15; return 8 * (i >> 2) + 4 * n + (i & 3); }

struct Unit { int pm, pn, kind; const char* a; const char* b; };
struct Gemm { const bf16_t* A; const bf16_t* Bt; int M, N, K; };

struct StaticOrder {
    int nM, nN, nwg, G, c, rev; const char* A; const char* Bt; size_t tstep;
    __host__ __device__ void init(const Gemm& g, int G_, int c_, int rev_ = 0) { nM = g.M / BM; nN = g.N / BM; nwg = nM * nN; G = G_; c = c_; rev = rev_; A = (const char*)g.A; Bt = (const char*)g.Bt; tstep = (size_t)BM * g.K * 2; }
    __host__ __device__ void map(int wgid, Unit& u) const {
        { const int q = nwg / NXCD, r = nwg % NXCD, xcd = wgid % NXCD, off = wgid / NXCD; wgid = (xcd < r ? xcd * (q + 1) : r * (q + 1) + (xcd - r) * q) + off; }
        const int nig = WGM * nN, gid = wgid / nig, fm = gid * WGM, gsz = (nM - fm) < WGM ? (nM - fm) : WGM;
        u.pm = fm + ((wgid % nig) % gsz); if (rev) u.pm = nM - 1 - u.pm; u.pn = (wgid % nig) / gsz; u.kind = 0; u.a = A + (size_t)u.pm * tstep; u.b = Bt + (size_t)u.pn * tstep;
    }
    __host__ __device__ bool next(int i, Unit& u) const { const long L = (long)i * G + c; if (L >= nwg) return false; map((int)L, u); return true; }
    __device__ __forceinline__ void a_ready(const Unit&) const {}
    __device__ __forceinline__ void done(const Unit&) const {}
};
struct DualOrder {
    StaticOrder o1, o2; int G, c;
    __host__ __device__ bool next(int i, Unit& u) const { const long L = (long)i * G + c; if (L >= o1.nwg + o2.nwg) return false;
        if (L < o1.nwg) o1.map((int)L, u); else { o2.map((int)(L - o1.nwg), u); u.kind = 1; } return true; }
    __device__ __forceinline__ void a_ready(const Unit&) const {}
    __device__ __forceinline__ void done(const Unit&) const {}
};

__device__ __forceinline__ unsigned cvt_pk_bf16(float lo, float hi) { unsigned r; asm volatile("v_cvt_pk_bf16_f32 %0, %1, %2" : "=v"(r) : "v"(lo), "v"(hi)); return r; }

struct EpiStore {
    static constexpr bool PERM = true, AFTER_DRAIN = false;
    bf16_t* O; int nrows;
    __device__ __forceinline__ void operator()(const f32x4 (&acc)[2][2][4][2], const Unit& u, int wr, int wc, int fr, int fq) const {
        const int row0 = u.pm * BM + wr * 64 + fr, col0 = wc * 32 + 8 * fq; bf16_t* blk = O + (size_t)u.pn * nrows * 256;
#pragma unroll
        for (int ai = 0; ai < 2; ++ai)
#pragma unroll
            for (int m = 0; m < 4; ++m) { bf16_t* rowp = blk + (size_t)(row0 + ai * HALF + m * 16) * 256 + col0;
#pragma unroll
                for (int bj = 0; bj < 2; ++bj) { const f32x4 v0 = acc[ai][bj][m][0], v1 = acc[ai][bj][m][1];
                    u32x4 w; w.x = cvt_pk_bf16(v0[0], v0[1]); w.y = cvt_pk_bf16(v0[2], v0[3]); w.z = cvt_pk_bf16(v1[0], v1[1]); w.w = cvt_pk_bf16(v1[2], v1[3]);
                    *(u32x4*)(rowp + bj * HALF) = w; } }
    }
};
struct EpiStoreBlk {
    static constexpr bool PERM = true, AFTER_DRAIN = false;
    bf16_t* O; int nrows;
    __device__ __forceinline__ void operator()(const f32x4 (&acc)[2][2][4][2], const Unit& u, int wr, int wc, int fr, int fq) const {
        const int row0 = u.pm * BM + wr * 64 + fr;
#pragma unroll
        for (int ai = 0; ai < 2; ++ai)
#pragma unroll
            for (int m = 0; m < 4; ++m) { const int r = row0 + ai * HALF + m * 16;
#pragma unroll
                for (int bj = 0; bj < 2; ++bj) { const f32x4 v0 = acc[ai][bj][m][0], v1 = acc[ai][bj][m][1];
                    u32x4 w; w.x = cvt_pk_bf16(v0[0], v0[1]); w.y = cvt_pk_bf16(v0[2], v0[3]); w.z = cvt_pk_bf16(v1[0], v1[1]); w.w = cvt_pk_bf16(v1[2], v1[3]);
                    const int g32 = u.pn * 8 + bj * 4 + wc;
                    *(u32x4*)(O + ((size_t)g32 * (nrows >> 4) + (r >> 4)) * 512 + fq * 128 + (r & 15) * 8) = w; } }
    }
};
struct EpiDual {
    static constexpr bool PERM = true, AFTER_DRAIN = false;
    EpiStore e0; EpiStoreBlk e1;
    __device__ __forceinline__ void operator()(const f32x4 (&acc)[2][2][4][2], const Unit& u, int wr, int wc, int fr, int fq) const { if (u.kind == 0) e0(acc, u, wr, wc, fr, fq); else e1(acc, u, wr, wc, fr, fq); }
};
struct EpiStoreSsq {
    static constexpr bool PERM = true, AFTER_DRAIN = false;
    bf16_t* O; int ldc; float* ssq;
    __device__ __forceinline__ void operator()(const f32x4 (&acc)[2][2][4][2], const Unit& u, int wr, int wc, int fr, int fq) const {
        const int row0 = u.pm * BM + wr * 64 + fr, col0 = u.pn * BM + wc * 32 + 8 * fq;
#pragma unroll
        for (int ai = 0; ai < 2; ++ai)
#pragma unroll
            for (int m = 0; m < 4; ++m) { const int row = row0 + ai * HALF + m * 16; bf16_t* rowp = O + (size_t)row * ldc + col0; float s = 0.f;
#pragma unroll
                for (int bj = 0; bj < 2; ++bj) { const f32x4 v0 = acc[ai][bj][m][0], v1 = acc[ai][bj][m][1];
                    s += (v0[0] * v0[0] + v0[1] * v0[1]) + (v0[2] * v0[2] + v0[3] * v0[3]) + (v1[0] * v1[0] + v1[1] * v1[1]) + (v1[2] * v1[2] + v1[3] * v1[3]);
                    u32x4 w; w.x = cvt_pk_bf16(v0[0], v0[1]); w.y = cvt_pk_bf16(v0[2], v0[3]); w.z = cvt_pk_bf16(v1[0], v1[1]); w.w = cvt_pk_bf16(v1[2], v1[3]);
                    *(u32x4*)(rowp + bj * HALF) = w; }
                s += __shfl_xor(s, 16); s += __shfl_xor(s, 32);
                if (fq == 0) ssq[(size_t)row * 16 + u.pn * 4 + wc] = s; }
    }
};
struct EpiSwiglu {
    static constexpr bool PERM = true, AFTER_DRAIN = false;
    bf16_t* O; int ldc;
    __device__ __forceinline__ void operator()(const f32x4 (&acc)[2][2][4][2], const Unit& u, int wr, int wc, int fr, int fq) const {
        const int row0 = u.pm * BM + wr * 64 + fr, col0 = u.pn * HALF + wc * 32 + 8 * fq;
#pragma unroll
        for (int ai = 0; ai < 2; ++ai)
#pragma unroll
            for (int m = 0; m < 4; ++m) { bf16_t* rowp = O + (size_t)(row0 + ai * HALF + m * 16) * ldc + col0; float a[8];
#pragma unroll
                for (int n = 0; n < 2; ++n)
#pragma unroll
                    for (int i = 0; i < 4; ++i) { const float g = acc[ai][0][m][n][i], uu = acc[ai][1][m][n][i]; a[n * 4 + i] = g * __builtin_amdgcn_rcpf(1.0f + __expf(-g)) * uu; }
                u32x4 w; w.x = cvt_pk_bf16(a[0], a[1]); w.y = cvt_pk_bf16(a[2], a[3]); w.z = cvt_pk_bf16(a[4], a[5]); w.w = cvt_pk_bf16(a[6], a[7]);
                *(u32x4*)rowp = w; }
    }
};

template <class Epi, class Sched, bool ALIGN_EPI = false, bool SP2 = false>
__device__ __forceinline__ void gemm_phase(PG8_LAS unsigned char* lds, const Gemm g, const Sched& S, const Epi& E) {
    const int tid = threadIdx.x, wid = __builtin_amdgcn_readfirstlane(tid >> 6), lane = tid & 63, wr = wid >> 2, wc = wid & 3, fr = lane & 15, fq = lane >> 4;
    const int K = g.K, nt = K / BK;
    unsigned voffA[2], voffB[2];
#pragma unroll
    for (int i = 0; i < 2; ++i) { int R, C; stage_rc(tid * 16 + i * 8192, R, C); const int Rb = Epi::PERM ? ((R & ~31) + perm32(R & 31)) : R;
        voffA[i] = (unsigned)(R * K + C) * 2u; voffB[i] = (unsigned)(Rb * K + C) * 2u; }
    const size_t kstep = (size_t)(BK * 2);
    const size_t hstep = (size_t)HALF * K * 2;
    const unsigned ldsw = (unsigned)wid * 1024u;
    const int aoff = lds_byte(wr * 64 + fr, fq * 8), boff = lds_byte(wc * 32 + fr, fq * 8);
#define PG8_SA(b, h) (((b) * 2 + (h)) * HTB)
#define PG8_SB(b, h) ((4 + (b) * 2 + (h)) * HTB)
#define PG8_STAGE(bufoff, gbase, voff) do { _Pragma("unroll") for (int _i = 0; _i < 2; ++_i) \
        __builtin_amdgcn_global_load_lds((const unsigned*)((const char*)(gbase) + (voff)[_i]), (PG8_LAS unsigned*)(lds + (bufoff) + ldsw + _i * 8192), 16, 0, 0); } while (0)
#define PG8_LDA(dst, b, h) do { _Pragma("unroll") for (int m = 0; m < 4; ++m) _Pragma("unroll") for (int k = 0; k < 2; ++k) dst[m][k] = *(const PG8_LAS bf16x8*)(lds + PG8_SA(b, h) + aoff + m * 2048 + k * 1024); } while (0)
#define PG8_LDB(dst, b, h) do { _Pragma("unroll") for (int n = 0; n < 2; ++n) _Pragma("unroll") for (int k = 0; k < 2; ++k) dst[n][k] = *(const PG8_LAS bf16x8*)(lds + PG8_SB(b, h) + boff + n * 2048 + k * 1024); } while (0)
#define PG8_MMA(ai, bj, At, Bt) do { __builtin_amdgcn_s_setprio(1); _Pragma("unroll") for (int m = 0; m < 4; ++m) _Pragma("unroll") for (int n = 0; n < 2; ++n) _Pragma("unroll") for (int k = 0; k < 2; ++k) \
        acc[ai][bj][m][n] = __builtin_amdgcn_mfma_f32_16x16x32_bf16(Bt[n][k], At[m][k], acc[ai][bj][m][n], 0, 0, 0); __builtin_amdgcn_s_setprio(0); } while (0)
#define PG8_WAIT_V(n) asm volatile("s_waitcnt vmcnt(" #n ")" ::: "memory")
#define PG8_WAIT_L(n) asm volatile("s_waitcnt lgkmcnt(" #n ")" ::: "memory")
#define PG8_BAR __builtin_amdgcn_s_barrier()
#define PG8_SCHED __builtin_amdgcn_sched_barrier(0)
    Unit cur, nxt; int ui = 0;
    if (!S.next(0, cur)) return;
    f32x4 acc[2][2][4][2];
#pragma unroll
    for (int a = 0; a < 2; ++a)
#pragma unroll
        for (int b = 0; b < 2; ++b)
#pragma unroll
            for (int m = 0; m < 4; ++m)
#pragma unroll
                for (int n = 0; n < 2; ++n) acc[a][b][m][n] = (f32x4){0.f, 0.f, 0.f, 0.f};
    bf16x8 At[4][2], B0[2][2], B1[2][2];
    const char* cA = cur.a; const char* cB = cur.b;
    S.a_ready(cur);
    if constexpr (SP2) {
        PG8_STAGE(PG8_SB(0, 0), cB, voffB); PG8_STAGE(PG8_SB(0, 1), cB + hstep, voffB); PG8_STAGE(PG8_SA(0, 0), cA, voffA); PG8_STAGE(PG8_SA(0, 1), cA + hstep, voffA);
        if (wr == 1) PG8_BAR;
        PG8_WAIT_V(2); PG8_BAR;
        PG8_STAGE(PG8_SB(1, 0), cB + kstep, voffB); PG8_STAGE(PG8_SA(1, 0), cA + kstep, voffA); PG8_STAGE(PG8_SB(1, 1), cB + hstep + kstep, voffB);
        PG8_WAIT_V(6); PG8_BAR;
    } else {
        PG8_STAGE(PG8_SB(0, 0), cB, voffB); PG8_STAGE(PG8_SA(0, 0), cA, voffA); PG8_STAGE(PG8_SB(0, 1), cB + hstep, voffB); PG8_STAGE(PG8_SA(0, 1), cA + hstep, voffA);
        if (wr == 1) PG8_BAR;
        PG8_WAIT_V(4); PG8_BAR;
        PG8_STAGE(PG8_SB(1, 0), cB + kstep, voffB); PG8_STAGE(PG8_SA(1, 0), cA + kstep, voffA); PG8_STAGE(PG8_SB(1, 1), cB + hstep + kstep, voffB);
        PG8_WAIT_V(6); PG8_BAR;
    }
    for (;;) {
        const bool has_next = S.next(ui + 1, nxt);
        const char* nA = has_next ? nxt.a : cA; const char* nB = has_next ? nxt.b : cB;
        for (int t = 0; t < nt; t += 2) {
            const bool last = (t == nt - 2);
            const char* a1 = cA + (size_t)(t + 1) * kstep;
            const char* a2 = last ? nA : cA + (size_t)(t + 2) * kstep; const char* b2 = last ? nB : cB + (size_t)(t + 2) * kstep;
            const char* a3 = a2 + kstep; const char* b3 = b2 + kstep;
            if (last && has_next) S.a_ready(nxt);
            if constexpr (SP2) {
            PG8_LDB(B0, 0, 0); PG8_LDB(B1, 0, 1); PG8_SCHED; PG8_LDA(At, 0, 0); PG8_STAGE(PG8_SA(1, 1), a1 + hstep, voffA);
            PG8_WAIT_V(8); PG8_WAIT_L(0); PG8_BAR; PG8_MMA(0, 0, At, B0); PG8_MMA(0, 1, At, B1); PG8_BAR; PG8_SCHED;
            PG8_LDA(At, 0, 1); PG8_STAGE(PG8_SB(0, 0), b2, voffB); PG8_STAGE(PG8_SB(0, 1), b2 + hstep, voffB); PG8_STAGE(PG8_SA(0, 0), a2, voffA);
            PG8_WAIT_V(8); PG8_WAIT_L(0); PG8_BAR; PG8_MMA(1, 0, At, B0); PG8_MMA(1, 1, At, B1); PG8_BAR; PG8_SCHED;
            PG8_LDB(B0, 1, 0); PG8_LDB(B1, 1, 1); PG8_SCHED; PG8_LDA(At, 1, 0); PG8_STAGE(PG8_SA(0, 1), a2 + hstep, voffA);
            PG8_WAIT_V(8); PG8_WAIT_L(0); PG8_BAR; PG8_MMA(0, 0, At, B0); PG8_MMA(0, 1, At, B1); PG8_BAR; PG8_SCHED;
            PG8_LDA(At, 1, 1); PG8_STAGE(PG8_SB(1, 0), b3, voffB); PG8_STAGE(PG8_SB(1, 1), b3 + hstep, voffB); PG8_STAGE(PG8_SA(1, 0), a3, voffA);
            PG8_WAIT_V(8); PG8_WAIT_L(0); PG8_BAR; PG8_MMA(1, 0, At, B0); PG8_MMA(1, 1, At, B1); PG8_BAR; PG8_SCHED;
            } else {
            PG8_LDB(B0, 0, 0); PG8_SCHED; PG8_LDA(At, 0, 0); PG8_STAGE(PG8_SA(1, 1), a1 + hstep, voffA);
            PG8_WAIT_L(8); PG8_BAR; PG8_WAIT_L(0); PG8_MMA(0, 0, At, B0); PG8_BAR; PG8_SCHED;
            PG8_LDB(B1, 0, 1); PG8_STAGE(PG8_SB(0, 0), b2, voffB);
            PG8_BAR; PG8_WAIT_L(0); PG8_MMA(0, 1, At, B1); PG8_BAR;
            PG8_LDA(At, 0, 1); PG8_STAGE(PG8_SA(0, 0), a2, voffA);
            PG8_BAR; PG8_WAIT_L(0); PG8_MMA(1, 0, At, B0); PG8_BAR; PG8_SCHED;
            PG8_STAGE(PG8_SB(0, 1), b2 + hstep, voffB);
            PG8_WAIT_V(6); PG8_BAR; PG8_MMA(1, 1, At, B1); PG8_BAR;
            PG8_LDB(B0, 1, 0); PG8_SCHED; PG8_LDA(At, 1, 0); PG8_STAGE(PG8_SA(0, 1), a2 + hstep, voffA);
            PG8_WAIT_L(8); PG8_BAR; PG8_WAIT_L(0); PG8_MMA(0, 0, At, B0); PG8_BAR; PG8_SCHED;
            PG8_LDB(B1, 1, 1); PG8_STAGE(PG8_SB(1, 0), b3, voffB);
            PG8_BAR; PG8_WAIT_L(0); PG8_MMA(0, 1, At, B1); PG8_BAR;
            PG8_LDA(At, 1, 1); PG8_STAGE(PG8_SA(1, 0), a3, voffA);
            PG8_BAR; PG8_WAIT_L(0); PG8_MMA(1, 0, At, B0); PG8_BAR; PG8_SCHED;
            PG8_STAGE(PG8_SB(1, 1), b3 + hstep, voffB);
            PG8_WAIT_V(6); PG8_BAR; PG8_MMA(1, 1, At, B1); PG8_BAR;
            }
        }
        if constexpr (ALIGN_EPI) { if (wr == 0) PG8_BAR; }
        if constexpr (!Epi::AFTER_DRAIN) { E(acc, cur, wr, wc, fr, fq); S.done(cur); }
        if (!has_next) break;
#pragma unroll
        for (int a = 0; a < 2; ++a)
#pragma unroll
            for (int b = 0; b < 2; ++b)
#pragma unroll
                for (int m = 0; m < 4; ++m)
#pragma unroll
                    for (int n = 0; n < 2; ++n) acc[a][b][m][n] = (f32x4){0.f, 0.f, 0.f, 0.f};
        cur = nxt; cA = nA; cB = nB; ++ui;
        if constexpr (ALIGN_EPI) { if (wr == 1) PG8_BAR; }
    }
    PG8_WAIT_V(0);
    if constexpr (!ALIGN_EPI) { if (wr == 0) PG8_BAR; }
    PG8_BAR;
#undef PG8_SA
#undef PG8_SB
#undef PG8_STAGE
#undef PG8_LDA
#undef PG8_LDB
#undef PG8_MMA
#undef PG8_WAIT_V
#undef PG8_WAIT_L
#undef PG8_BAR
#undef PG8_SCHED
}
}

typedef unsigned short bf16;
typedef short bf16x8 __attribute__((ext_vector_type(8)));
typedef float f32x4 __attribute__((ext_vector_type(4)));
typedef unsigned u32x4 __attribute__((ext_vector_type(4)));
typedef unsigned u32x2 __attribute__((ext_vector_type(2)));
#define LAS __attribute__((address_space(3)))

constexpr int NB = 8, SEQ = 8192, DM = 1024, CTXL = 256;
constexpr int MLAT = NB * SEQ, MCTX = NB * CTXL, MTOT = MLAT + MCTX;
constexpr int LDP = 2304;
constexpr int CQ = 0, CK = 512, CGQ = 1024, CGK = 1280, CGR = 1536, CAF = 2048, CAB = 2064;
__device__ __forceinline__ size_t vt_off(int row, int tok) { return ((size_t)(tok >> 5) * 64 + (row >> 4)) * 512 + ((tok >> 3) & 3) * 128 + (row & 15) * 8; }
__device__ __forceinline__ size_t p1_off(int row, int col) { return ((size_t)(col >> 8) * MTOT + row) * 256 + (col & 255); }
constexpr int FFN = 2816, NMOD = 6 * DM;
constexpr int NCH = 132;
constexpr float EPS = 1e-6f;

constexpr size_t MiB = 1u << 20;
constexpr size_t WS_CTL = 0, CTL_ZERO_BYTES = 1 * MiB;
constexpr size_t WS_MOD = 1 * MiB;
constexpr size_t WS_ROPE = 1 * MiB + 512 * 1024;
constexpr size_t WS_WMAIN = 2 * MiB;
constexpr size_t WS_WV = 7 * MiB;
constexpr size_t WS_WOUT = 9 * MiB;
constexpr size_t WS_WGU = 11 * MiB;
constexpr size_t WS_WDOWN = 22 * MiB;
constexpr size_t WS_H = 32 * MiB;
constexpr size_t WS_P1 = 164 * MiB;
constexpr size_t WS_VT = 461 * MiB;
constexpr size_t WS_KV = 593 * MiB;
constexpr size_t WS_DEC = 725 * MiB;
constexpr size_t WS_SSQ1 = 728 * MiB;
constexpr size_t WS_SSQ2 = 732 * MiB;
constexpr size_t WS_MIX = 736 * MiB;
constexpr size_t WS_Y = WS_KV;
constexpr size_t WS_ACT = WS_P1;
constexpr size_t WS_DOWN = WS_MIX;
constexpr size_t WS_X1B = 864 * MiB;
constexpr size_t WS_END = 992 * MiB;
static_assert(WS_P1 + (size_t)MTOT * LDP * 2 <= WS_VT && WS_VT + (size_t)1024 * MTOT * 2 <= WS_KV && WS_KV + (size_t)64 * NCH * 128 * 64 * 2 <= WS_DEC, "ws map");
static_assert(WS_ACT + (size_t)MLAT * FFN * 2 <= WS_KV && WS_H + (size_t)MTOT * DM * 2 <= WS_P1 && WS_MIX + (size_t)MLAT * DM * 2 <= WS_END, "ws map 2");

constexpr int LDS_BYTES = 147456;
constexpr int NTHREADS = 512;

__device__ __forceinline__ unsigned f2bf(float f) { unsigned u = __builtin_bit_cast(unsigned, f); return (u + 0x7fffu + ((u >> 16) & 1u)) >> 16; }
typedef float f32x2_t __attribute__((ext_vector_type(2)));
typedef __bf16 bf16x2_t __attribute__((ext_vector_type(2)));
__device__ __forceinline__ unsigned pk2(float lo, float hi) { const f32x2_t v = {lo, hi}; return __builtin_bit_cast(unsigned, __builtin_convertvector(v, bf16x2_t)); }
__device__ __forceinline__ float bflo(unsigned w) { return __builtin_bit_cast(float, w << 16); }
__device__ __forceinline__ float bfhi(unsigned w) { return __builtin_bit_cast(float, w & 0xffff0000u); }
__device__ __forceinline__ float wave_sum(float v) {
#pragma unroll
    for (int o = 1; o < 64; o <<= 1) v += __shfl_xor(v, o);
    return v;
}
__device__ __forceinline__ void unpack8(const u32x4 w, float (&o)[8]) { o[0] = bflo(w.x); o[1] = bfhi(w.x); o[2] = bflo(w.y); o[3] = bfhi(w.y); o[4] = bflo(w.z); o[5] = bfhi(w.z); o[6] = bflo(w.w); o[7] = bfhi(w.w); }
__device__ __forceinline__ float logsig16(float z) { return (fminf(z, 0.f) - __logf(1.0f + __expf(-fabsf(z)))) * (1.0f / 16.0f); }

#define XB_TMO      128
#define XB_XCNT(j)  (256  + 64 * (j))
#define XB_XSUB(j)  (1280 + 64 * (j))
#define XB_XGEN(j)  (2304 + 64 * (j))
#define XB_TOP      3328
#define XB_TOPGEN   3392
#define XCD_BAR_WORDS 3456
#define XB_SPIN_CAP (1u << 18)
__device__ __forceinline__ unsigned xb_ld(unsigned* p)              { return __hip_atomic_load(p, __ATOMIC_RELAXED, __HIP_MEMORY_SCOPE_AGENT); }
__device__ __forceinline__ unsigned xb_add(unsigned* p, unsigned v) { return __hip_atomic_fetch_add(p, v, __ATOMIC_RELAXED, __HIP_MEMORY_SCOPE_AGENT); }
__device__ __forceinline__ unsigned xb_xcc_id() { return (unsigned)__builtin_amdgcn_s_getreg((3 << 11) | 20) & 0xFu; }
#define XB_SPIN(cond, bar) do { unsigned _sp = 0; while (cond) { __builtin_amdgcn_s_sleep(1); \
    if ((++_sp & 255u) == 0u) { if (xb_ld(&(bar)[XB_TMO])) break; if (_sp > XB_SPIN_CAP) { atomicAdd(&(bar)[XB_TMO], 1u); break; } } } } while (0)
struct XcdBarrier { unsigned* bar; unsigned x; volatile unsigned* st; };
__device__ __forceinline__ XcdBarrier xcd_barrier_post(unsigned* bar, volatile unsigned* st) {
    XcdBarrier b; b.bar = bar; b.x = xb_xcc_id(); b.st = st;
    if (threadIdx.x == 0) (void)xb_add(&bar[XB_XCNT(b.x)], 1u);
    return b;
}
__device__ __forceinline__ void xcd_barrier_complete(unsigned* bar, unsigned x, unsigned& nloc, unsigned& nx) {
    const unsigned G = gridDim.x * gridDim.y * gridDim.z;
    unsigned sum, cnt, mine, sp = 0u;
    for (;;) {
        sum = 0u; cnt = 0u; mine = 0u;
#pragma unroll
        for (unsigned j = 0; j < 16; ++j) { const unsigned c = xb_ld(&bar[XB_XCNT(j)]); sum += c; cnt += (c > 0u) ? 1u : 0u; mine = (j == x) ? c : mine; }
        if (sum == G) break;
        __builtin_amdgcn_s_sleep(1);
        if ((++sp & 255u) == 0u) { if (xb_ld(&bar[XB_TMO])) break; if (sp > XB_SPIN_CAP) { atomicAdd(&bar[XB_TMO], 1u); break; } }
    }
    nloc = mine > 0u ? mine : 1u; nx = cnt > 0u ? cnt : 1u;
}
__device__ __forceinline__ void xcd_barrier(const XcdBarrier& b) {
    asm volatile("s_waitcnt vmcnt(0)" ::: "memory");
    __syncthreads();
    if (threadIdx.x == 0) {
        unsigned* bar = b.bar;
        __builtin_amdgcn_s_waitcnt(0);
        unsigned nloc = b.st[0], nx = b.st[1];
        if (nloc == 0u) { xcd_barrier_complete(bar, b.x, nloc, nx); b.st[0] = nloc; b.st[1] = nx; }
        const unsigned old = xb_add(&bar[XB_XSUB(b.x)], 1u);
        const unsigned gen = old / nloc;
        if (old + 1u == (gen + 1u) * nloc) {
            __builtin_amdgcn_fence(__ATOMIC_RELEASE, "agent");
            asm volatile("s_waitcnt vmcnt(0)" ::: "memory");
            const unsigned og = xb_add(&bar[XB_TOP], 1u);
            const unsigned tg = og / nx;
            if (og + 1u == (tg + 1u) * nx) xb_add(&bar[XB_TOPGEN], 1u);
            else XB_SPIN(xb_ld(&bar[XB_TOPGEN]) == tg, bar);
            __builtin_amdgcn_fence(__ATOMIC_ACQUIRE, "agent");
            xb_add(&bar[XB_XGEN(b.x)], 1u);
            asm volatile("s_waitcnt vmcnt(0)" ::: "memory");
        } else {
            XB_SPIN(xb_ld(&bar[XB_XGEN(b.x)]) == gen, bar);
            __builtin_amdgcn_fence(__ATOMIC_ACQUIRE, "agent");
            asm volatile("s_waitcnt vmcnt(0)" ::: "memory");
        }
    }
    __syncthreads();
}

struct Frame {
    unsigned char* lds;
    int tid, lane, wave, G;
    const float *x, *c, *ctx, *c_ctx, *w_mod, *b_mod, *g_pre_mix, *g_post_mix, *g_pre_ffn, *g_post_ffn, *w_in, *rpb, *wa2_f, *ba_f, *wa2_b, *ba_b, *gla_norm, *w_out, *w_gu, *w_down;
    float* out;
    float *MOD, *ROPE, *DEC, *SSQ1, *SSQ2;
    bf16 *WMAIN, *WV, *WOUT, *WGU, *WDOWN, *H, *P1, *VT, *KV, *MIX, *Y, *ACT, *DOWN, *X1B;
};

__device__ __forceinline__ void ph0_mod(const Frame& F) {
    float* S = (float*)F.lds;
    float* PART = S + 9 * 1024;
    for (int i = F.tid; i < 9 * 1024; i += NTHREADS) { const int r = i >> 10, k = i & 1023; const float v = r < 8 ? F.c[r * 1024 + k] : F.c_ctx[k]; S[i] = v / (1.0f + expf(-v)); }
    __syncthreads();
    for (int cgp = blockIdx.x; cgp < 256; cgp += F.G) {
        const int n0 = cgp * 24, cgi = F.tid % 6, ks = F.tid / 6;
        float acc[9][4];
#pragma unroll
        for (int r = 0; r < 9; ++r)
#pragma unroll
            for (int j = 0; j < 4; ++j) acc[r][j] = 0.f;
        if (ks < 85) {
            for (int k = ks; k < 1024; k += 85) { const f32x4 w = *(const f32x4*)(F.w_mod + (size_t)k * NMOD + n0 + 4 * cgi);
#pragma unroll
                for (int r = 0; r < 9; ++r) { const float s = S[r * 1024 + k]; acc[r][0] += s * w[0]; acc[r][1] += s * w[1]; acc[r][2] += s * w[2]; acc[r][3] += s * w[3]; } }
#pragma unroll
            for (int r = 0; r < 9; ++r)
#pragma unroll
                for (int j = 0; j < 4; ++j) PART[(ks * 9 + r) * 24 + cgi * 4 + j] = acc[r][j];
        }
        __syncthreads();
        if (F.tid < 216) { const int r = F.tid / 24, col = F.tid % 24; float s = 0.f; for (int k2 = 0; k2 < 85; ++k2) s += PART[(k2 * 9 + r) * 24 + col]; F.MOD[r * NMOD + n0 + col] = s + F.b_mod[n0 + col]; }
        __syncthreads();
    }
    for (int i = blockIdx.x * NTHREADS + F.tid; i < 128 * 16; i += F.G * NTHREADS) {
        const int pos = i >> 4, ii = i & 15; const float inv = (float)pow(10000.0, -(double)ii / 16.0); const float ang = (float)pos * inv;
        F.ROPE[i] = (float)cos((double)ang); F.ROPE[2048 + i] = (float)sin((double)ang);
    }
}

__device__ __forceinline__ void transpose_item(const float* W, int ldn, int k0, int nsrc0, bf16* WT, int ldk, int drow0, float* scr, int lane) {
#pragma unroll 8
    for (int i = 0; i < 32; ++i) { const int kk = 2 * i + (lane >> 5); scr[kk * 33 + (lane & 31)] = W[(size_t)(k0 + kk) * ldn + nsrc0 + (lane & 31)]; }
    __builtin_amdgcn_wave_barrier();
    const int c = lane & 7;
#pragma unroll
    for (int j = 0; j < 4; ++j) { const int n = (lane >> 3) + 8 * j; const float* s = scr + (8 * c) * 33 + n;
        u32x4 o; o.x = pk2(s[0 * 33], s[1 * 33]); o.y = pk2(s[2 * 33], s[3 * 33]); o.z = pk2(s[4 * 33], s[5 * 33]); o.w = pk2(s[6 * 33], s[7 * 33]);
        *(u32x4*)(WT + (size_t)(drow0 + n) * ldk + k0 + 8 * c) = o; }
    __builtin_amdgcn_wave_barrier();
}
__device__ __forceinline__ void ph1_rows(const Frame& F) {
    const int gw = blockIdx.x * 8 + F.wave, NGW = F.G * 8;
    int curb = -1; f32x4 cA[4], cB[4];
#pragma unroll
    for (int j = 0; j < 4; ++j) { cA[j] = (f32x4){0.f, 0.f, 0.f, 0.f}; cB[j] = cA[j]; }
    for (int row0 = gw; row0 < MTOT; row0 += 2 * NGW) {
        const int nr = (row0 + NGW < MTOT) ? 2 : 1;
        f32x4 v[2][4];
#pragma unroll
        for (int q = 0; q < 2; ++q) { const int row = (q < nr) ? row0 + q * NGW : row0; const float* src = row < MLAT ? F.x + (size_t)row * DM : F.ctx + (size_t)(row - MLAT) * DM;
#pragma unroll
            for (int j = 0; j < 4; ++j) v[q][j] = __builtin_nontemporal_load((const f32x4*)src + F.lane + 64 * j); }
#pragma unroll
        for (int q = 0; q < 2; ++q) { if (q < nr) { const int row = row0 + q * NGW; const int b = row < MLAT ? (row >> 13) : 8; float ss = 0.f;
#pragma unroll
            for (int j = 0; j < 4; ++j) ss += (v[q][j][0] * v[q][j][0] + v[q][j][1] * v[q][j][1]) + (v[q][j][2] * v[q][j][2] + v[q][j][3] * v[q][j][3]);
            if (b != curb) { curb = b;
#pragma unroll
                for (int j = 0; j < 4; ++j) { const int col = 4 * (F.lane + 64 * j); const f32x4 g = *(const f32x4*)(F.g_pre_mix + col), sh = *(const f32x4*)(F.MOD + b * NMOD + col), sc = *(const f32x4*)(F.MOD + b * NMOD + DM + col);
                    cA[j] = g * (sc + 1.0f); cB[j] = sh; } }
            const float rstd = 1.0f / sqrtf(wave_sum(ss) * (1.0f / DM) + EPS);
#pragma unroll
            for (int j = 0; j < 4; ++j) { const f32x4 o = v[q][j] * rstd * cA[j] + cB[j]; u32x2 w; w.x = pk2(o[0], o[1]); w.y = pk2(o[2], o[3]); *(u32x2*)(F.H + (size_t)row * DM + 4 * (F.lane + 64 * j)) = w; } } }
    }
    float* scr = (float*)(F.lds + F.wave * 16384);
    constexpr int I_MAIN = 16 * 65, I_V = 16 * 32, I_OUT = 16 * 32, I_GU = 16 * 176, I_DOWN = 44 * 32, NITEMS = I_MAIN + I_V + I_OUT + I_GU + I_DOWN;
    for (int it = gw; it < NITEMS; it += NGW) {
        int r = it;
        if (r < I_MAIN) { const int kb = r / 65, nb = r % 65, dr = nb * 32; const int sc = dr < 1024 ? dr : (dr < 1536 ? dr + 512 : dr + 1024); transpose_item(F.w_in, 3104, kb * 64, sc, F.WMAIN, DM, dr, scr, F.lane); continue; } r -= I_MAIN;
        if (r < I_V) { const int kb = r / 32, nb = r % 32, dr = nb * 32; const int sc = dr < 512 ? dr + 1024 : dr + 1536; transpose_item(F.w_in, 3104, kb * 64, sc, F.WV, DM, dr, scr, F.lane); continue; } r -= I_V;
        if (r < I_OUT) { const int kb = r / 32, nb = r % 32; transpose_item(F.w_out, DM, kb * 64, nb * 32, F.WOUT, DM, nb * 32, scr, F.lane); continue; } r -= I_OUT;
        if (r < I_GU) { const int kb = r / 176, nb = r % 176, dr = nb * 32, pn = dr >> 8, jj = dr & 255; const int sc = jj < 128 ? 128 * pn + jj : FFN + 128 * pn + (jj - 128); transpose_item(F.w_gu, 2 * FFN, kb * 64, sc, F.WGU, DM, dr, scr, F.lane); continue; } r -= I_GU;
        { const int kb = r / 32, nb = r % 32; transpose_item(F.w_down, DM, kb * 64, nb * 32, F.WDOWN, FFN, nb * 32, scr, F.lane); }
    }
    for (int i = blockIdx.x * NTHREADS + F.tid; i < 224 * 1024 / 8; i += F.G * NTHREADS) *((u32x4*)(F.WMAIN + (size_t)2080 * DM) + i) = (u32x4){0u, 0u, 0u, 0u};
}

struct RopeCS { f32x4 c0, c1, s0, s1; };
__device__ __forceinline__ void rope_cs_issue(const float* rope, int dc, int posr, int posc, RopeCS& R) {
    const int pos = (dc >> 2) ? posc : posr, i0 = 8 * (dc & 1);
    R.c0 = *(const f32x4*)(rope + pos * 16 + i0); R.c1 = *(const f32x4*)(rope + pos * 16 + i0 + 4); R.s0 = *(const f32x4*)(rope + 2048 + pos * 16 + i0); R.s1 = *(const f32x4*)(rope + 2048 + pos * 16 + i0 + 4);
}
__device__ __forceinline__ int rope_partner(int dc) { return ((dc & 3) < 2) ? dc + 2 : dc - 2; }
__device__ __forceinline__ void rope_apply(const u32x4 mine, const u32x4 part, const RopeCS& R, int dc, bool do_rope, float (&o)[8]) {
    float a[8]; unpack8(mine, a);
    if (!do_rope) {
#pragma unroll
        for (int j = 0; j < 8; ++j) o[j] = a[j];
        return; }
    float p[8]; unpack8(part, p);
    const bool first = (dc & 3) < 2;
    const float cs[8] = {R.c0[0], R.c0[1], R.c0[2], R.c0[3], R.c1[0], R.c1[1], R.c1[2], R.c1[3]}, sn[8] = {R.s0[0], R.s0[1], R.s0[2], R.s0[3], R.s1[0], R.s1[1], R.s1[2], R.s1[3]};
#pragma unroll
    for (int j = 0; j < 8; ++j) o[j] = first ? (a[j] * cs[j] - p[j] * sn[j]) : (p[j] * sn[j] + a[j] * cs[j]);
}
__device__ __forceinline__ void stage_gate_weights(const Frame& F, u32x4* WB, float* BAS) {
    for (int e = F.tid; e < 2048; e += NTHREADS) { const int ln = e & 63, dt = (e >> 6) & 3, dirh = e >> 8, fq = ln >> 4, dd = ln & 15; const float* wa = (dirh >> 2) ? F.wa2_b : F.wa2_f; const int hh = dirh & 3;
        u32x4 v = (u32x4){0u, 0u, 0u, 0u};
        if (fq < 2) { float t[8];
#pragma unroll
            for (int jj = 0; jj < 8; ++jj) t[jj] = wa[(8 * fq + jj) * 256 + hh * 64 + 16 * dt + dd];
            v.x = pk2(t[0], t[1]); v.y = pk2(t[2], t[3]); v.z = pk2(t[4], t[5]); v.w = pk2(t[6], t[7]); }
        WB[e] = v; }
    { const int dh = F.tid >> 6, dd = F.tid & 63; BAS[F.tid] = ((dh >> 2) ? F.ba_b : F.ba_f)[(dh & 3) * 64 + dd]; }
}

__device__ __forceinline__ void gate_cum16(const bf16x8 (&a)[2][2], const bf16x8 wb, float ba, int dir, int lane, float (&r)[2][8], float& bend) {
    const int fq = lane >> 4, dl = lane & 15;
#pragma unroll
    for (int h2 = 0; h2 < 2; ++h2)
#pragma unroll
        for (int t = 0; t < 2; ++t) { const f32x4 z = __builtin_amdgcn_mfma_f32_16x16x32_bf16(a[h2][t], wb, (f32x4){0.f, 0.f, 0.f, 0.f}, 0, 0, 0);
#pragma unroll
            for (int q = 0; q < 4; ++q) r[h2][4 * t + q] = logsig16(z[q] + ba); }
    if (dir == 0) {
#pragma unroll
        for (int h2 = 0; h2 < 2; ++h2)
#pragma unroll
            for (int i = 1; i < 8; ++i) r[h2][i] += r[h2][i - 1];
    } else {
#pragma unroll
        for (int h2 = 0; h2 < 2; ++h2)
#pragma unroll
            for (int i = 6; i >= 0; --i) r[h2][i] += r[h2][i + 1];
    }
    const float T0 = dir ? r[0][0] : r[0][7], T1 = dir ? r[1][0] : r[1][7];
    float t0[4], t1[4];
#pragma unroll
    for (int k = 0; k < 4; ++k) { t0[k] = __shfl(T0, dl + 16 * k); t1[k] = __shfl(T1, dl + 16 * k); }
    const float s0 = (t0[0] + t0[1]) + (t0[2] + t0[3]), s1 = (t1[0] + t1[1]) + (t1[2] + t1[3]);
    float o0 = 0.f, o1 = 0.f;
#pragma unroll
    for (int k = 0; k < 4; ++k) { const bool in = dir ? (k > fq) : (k < fq); o0 += in ? t0[k] : 0.f; o1 += in ? t1[k] : 0.f; }
    if (dir == 0) o1 += s0; else o0 += s1;
    bend = s0 + s1;
#pragma unroll
    for (int i = 0; i < 8; ++i) { r[0][i] += o0; r[1][i] += o1; }
}

__device__ __forceinline__ void ph3_gla_kv(const Frame& F) {
    float* KF = (float*)F.lds;
    bf16* KETF = (bf16*)(KF + 64 * 68);
    bf16* KETB = KETF + 64 * 72;
    u32x4* WB = (u32x4*)(KETB + 64 * 72);
    float* BAS = (float*)(WB + 2048);
    const int tid = F.tid, lane = F.lane, w = F.wave;
    stage_gate_weights(F, WB, BAS);
    __syncthreads();
    const int c = tid >> 3, dc = tid & 7, pdc = rope_partner(dc), fr = lane & 15, fq = lane >> 4;
    auto geom = [&](int it, int& h, int& ch, int& tok0, bool& isctx, size_t& itf, size_t& itb) {
        const int n = it % NCH, bh = it / NCH; h = bh & 3; const int b = bh >> 2;
        isctx = n < 4; ch = isctx ? n : n - 4;
        tok0 = isctx ? MLAT + b * CTXL + 64 * ch : b * SEQ + 64 * ch;
        const int nb = isctx ? 3 - n : 4 + (127 - ch);
        itf = (size_t)(bh * 2) * NCH + n; itb = (size_t)(bh * 2 + 1) * NCH + nb;
    };
    const int gdir = w >> 2, gdt = w & 3, gd = 16 * gdt + fr, gkap = 8 * (fr >> 2) + (fr & 3);
    u32x4 pkm, pkp; RopeCS pcs; bf16x8 pbv[2], pga[2][2];
    auto issue_a = [&](int it) { int h, ch, tok0; bool isctx; size_t itf, itb; geom(it, h, ch, tok0, isctx, itf, itb);
        pkm = *(const u32x4*)(F.P1 + p1_off(tok0 + c, CGK + h * 64 + 8 * dc)); pkp = *(const u32x4*)(F.P1 + p1_off(tok0 + c, CGK + h * 64 + 8 * pdc));
#pragma unroll
        for (int h2 = 0; h2 < 2; ++h2)
#pragma unroll
            for (int t = 0; t < 2; ++t) pga[h2][t] = *(const bf16x8*)(F.P1 + p1_off(tok0 + 32 * h2 + gkap + 4 * t, CAF + 16 * gdir + 8 * (fq & 1)));
        rope_cs_issue(F.ROPE, dc, ch, c, pcs); };
    auto issue_c = [&](int it) { int h, ch, tok0; bool isctx; size_t itf, itb; geom(it, h, ch, tok0, isctx, itf, itb);
        pbv[0] = *(const bf16x8*)(F.VT + vt_off(512 + h * 128 + 16 * w + fr, tok0 + 8 * fq)); pbv[1] = *(const bf16x8*)(F.VT + vt_off(512 + h * 128 + 16 * w + fr, tok0 + 32 + 8 * fq)); };
    const int NIT = 32 * NCH;
    if ((int)blockIdx.x < NIT) { issue_a(blockIdx.x); issue_c(blockIdx.x); }
    for (int it = blockIdx.x; it < NIT; it += F.G) {
        int h, ch, tok0; bool isctx; size_t itf, itb; geom(it, h, ch, tok0, isctx, itf, itb);
        const int itn = (it + F.G < NIT) ? it + F.G : it;
        float gr_[2][8], bend;
        {
            float k8[8];
            rope_apply(pkm, pkp, pcs, dc, !isctx, k8);
            *(f32x4*)(KF + c * 68 + 8 * dc) = (f32x4){k8[0], k8[1], k8[2], k8[3]}; *(f32x4*)(KF + c * 68 + 8 * dc + 4) = (f32x4){k8[4], k8[5], k8[6], k8[7]};
            const bf16x8 zero = (bf16x8){0, 0, 0, 0, 0, 0, 0, 0};
            bf16x8 ga[2][2];
#pragma unroll
            for (int h2 = 0; h2 < 2; ++h2)
#pragma unroll
                for (int t = 0; t < 2; ++t) ga[h2][t] = (fq < 2) ? pga[h2][t] : zero;
            issue_a(itn);
            const bf16x8 wb = __builtin_bit_cast(bf16x8, WB[((gdir * 4 + h) * 4 + gdt) * 64 + lane]); const float ba = BAS[(gdir * 4 + h) * 64 + gd];
            gate_cum16(ga, wb, ba, gdir, lane, gr_, bend);
        }
        __syncthreads();
        {
            bf16* KET = gdir ? KETB : KETF;
#pragma unroll
            for (int h2 = 0; h2 < 2; ++h2) { float ke[8];
#pragma unroll
                for (int i = 0; i < 8; ++i) ke[i] = KF[(32 * h2 + 8 * fq + i) * 68 + gd] * __expf(bend - gr_[h2][i]);
                u32x4 o; o.x = pk2(ke[0], ke[1]); o.y = pk2(ke[2], ke[3]); o.z = pk2(ke[4], ke[5]); o.w = pk2(ke[6], ke[7]);
                *(u32x4*)(KET + gd * 72 + 32 * h2 + 8 * fq) = o; }
            if (fq == 0) F.DEC[(gdir ? itb : itf) * 64 + gd] = __expf(bend);
        }
        __syncthreads();
        {
            const bf16x8 bv0 = pbv[0], bv1 = pbv[1];
            bf16* dstf = F.KV + (itf * 128 + 16 * w + fr) * 64 + 8 * fq; bf16* dstb = F.KV + (itb * 128 + 16 * w + fr) * 64 + 8 * fq;
            const int kapr = 8 * (fr >> 2) + (fr & 3);
#pragma unroll
            for (int p = 0; p < 2; ++p) { f32x4 af_[2], ab_[2];
#pragma unroll
                for (int t = 0; t < 2; ++t) { const int row = 32 * p + kapr + 4 * t; f32x4 accf = (f32x4){0.f, 0.f, 0.f, 0.f}, accb = accf;
                    const bf16x8 af0 = *(const bf16x8*)(KETF + row * 72 + 8 * fq), af1 = *(const bf16x8*)(KETF + row * 72 + 32 + 8 * fq);
                    const bf16x8 ab0 = *(const bf16x8*)(KETB + row * 72 + 8 * fq), ab1 = *(const bf16x8*)(KETB + row * 72 + 32 + 8 * fq);
                    accf = __builtin_amdgcn_mfma_f32_16x16x32_bf16(af0, bv0, accf, 0, 0, 0); accb = __builtin_amdgcn_mfma_f32_16x16x32_bf16(ab0, bv0, accb, 0, 0, 0);
                    accf = __builtin_amdgcn_mfma_f32_16x16x32_bf16(af1, bv1, accf, 0, 0, 0); accb = __builtin_amdgcn_mfma_f32_16x16x32_bf16(ab1, bv1, accb, 0, 0, 0);
                    af_[t] = accf; ab_[t] = accb; }
                u32x4 o; o.x = pk2(af_[0][0], af_[0][1]); o.y = pk2(af_[0][2], af_[0][3]); o.z = pk2(af_[1][0], af_[1][1]); o.w = pk2(af_[1][2], af_[1][3]); *(u32x4*)(dstf + 32 * p) = o;
                o.x = pk2(ab_[0][0], ab_[0][1]); o.y = pk2(ab_[0][2], ab_[0][3]); o.z = pk2(ab_[1][0], ab_[1][1]); o.w = pk2(ab_[1][2], ab_[1][3]); *(u32x4*)(dstb + 32 * p) = o; }
            issue_c(itn);
        }
    }
    __syncthreads();
}

__device__ __forceinline__ void ph4_gla_scan(const Frame& F) {
    constexpr int UB = 12;
    for (int idx = blockIdx.x * NTHREADS + F.tid; idx < 64 * 2048; idx += F.G * NTHREADS) {
        const int seq = idx >> 11, within = idx & 2047, e = within >> 4, d = 4 * (within & 15);
        bf16* p = F.KV + ((size_t)seq * NCH * 128 + e) * 64 + d; const float* dp = F.DEC + (size_t)seq * NCH * 64 + d;
        float s0 = 0.f, s1 = 0.f, s2 = 0.f, s3 = 0.f;
        for (int n0 = 0; n0 < NCH; n0 += UB) {
            u32x2 kv[UB]; f32x4 dc[UB];
#pragma unroll
            for (int u = 0; u < UB; ++u) { kv[u] = *(const u32x2*)(p + (size_t)(n0 + u) * 128 * 64); dc[u] = *(const f32x4*)(dp + (n0 + u) * 64); }
#pragma unroll
            for (int u = 0; u < UB; ++u) {
                u32x2 o; o.x = pk2(s0, s1); o.y = pk2(s2, s3); *(u32x2*)(p + (size_t)(n0 + u) * 128 * 64) = o;
                s0 = dc[u][0] * s0 + bflo(kv[u].x); s1 = dc[u][1] * s1 + bfhi(kv[u].x); s2 = dc[u][2] * s2 + bflo(kv[u].y); s3 = dc[u][3] * s3 + bfhi(kv[u].y); }
        }
    }
}

__device__ __forceinline__ void ph5_gla_out(const Frame& F) {
    float* BCF = (float*)F.lds;
    float* BCB = BCF + 64 * 68;
    float* SS = BCB + 64 * 68;
    bf16* QDF = (bf16*)(SS + 512);
    bf16* KIF = QDF + 64 * 72;
    bf16* QDB = KIF + 64 * 72;
    bf16* KIB = QDB + 64 * 72;
    bf16* AT = KIB + 64 * 72;
    u32x4* WB = (u32x4*)(AT + 64 * 72);
    float* BAS = (float*)(WB + 2048);
    const int tid = F.tid, lane = F.lane, w = F.wave, fr = lane & 15, fq = lane >> 4;
    stage_gate_weights(F, WB, BAS);
    __syncthreads();
    const int c = tid >> 3, dc = tid & 7, pdc = rope_partner(dc);
    const int gdir = w >> 2, gdt = w & 3, gd = 16 * gdt + fr, gkap = 8 * (fr >> 2) + (fr & 3);
    u32x4 pqm, pqp, pkm, pkp; RopeCS pcs; u32x2 pgr[4]; bf16x8 pav[2], pasf[2], pasb[2], pga[2][2];
    auto issue_a = [&](int it) { const int j = it & 127, h = (it >> 7) & 3, b = it >> 9; const int tok0 = b * SEQ + 64 * j;
        pqm = *(const u32x4*)(F.P1 + p1_off(tok0 + c, CGQ + h * 64 + 8 * dc)); pqp = *(const u32x4*)(F.P1 + p1_off(tok0 + c, CGQ + h * 64 + 8 * pdc));
        pkm = *(const u32x4*)(F.P1 + p1_off(tok0 + c, CGK + h * 64 + 8 * dc)); pkp = *(const u32x4*)(F.P1 + p1_off(tok0 + c, CGK + h * 64 + 8 * pdc));
#pragma unroll
        for (int h2 = 0; h2 < 2; ++h2)
#pragma unroll
            for (int t = 0; t < 2; ++t) pga[h2][t] = *(const bf16x8*)(F.P1 + p1_off(tok0 + 32 * h2 + gkap + 4 * t, CAF + 16 * gdir + 8 * (fq & 1)));
        rope_cs_issue(F.ROPE, dc, j, c, pcs);
#pragma unroll
        for (int ct = 0; ct < 4; ++ct) pgr[ct] = *(const u32x2*)(F.P1 + p1_off(tok0 + 16 * ct + fr, CGR + h * 128 + 16 * w + 4 * fq)); };
    auto issue_e = [&](int it) { const int j = it & 127, h = (it >> 7) & 3, b = it >> 9; const int tok0 = b * SEQ + 64 * j;
        const int seqf = (b * 4 + h) * 2, seqb = seqf + 1;
        const bf16* vrow = F.VT + vt_off(512 + h * 128 + 16 * w + fr, tok0 + 8 * fq); const bf16* vrow1 = F.VT + vt_off(512 + h * 128 + 16 * w + fr, tok0 + 32 + 8 * fq);
        const bf16* sfp = F.KV + (((size_t)seqf * NCH + 4 + j) * 128 + 16 * w + fr) * 64 + 8 * fq;
        const bf16* sbp = F.KV + (((size_t)seqb * NCH + 4 + (127 - j)) * 128 + 16 * w + fr) * 64 + 8 * fq;
        pav[0] = *(const bf16x8*)vrow; pav[1] = *(const bf16x8*)vrow1; pasf[0] = *(const bf16x8*)sfp; pasf[1] = *(const bf16x8*)(sfp + 32); pasb[0] = *(const bf16x8*)sbp; pasb[1] = *(const bf16x8*)(sbp + 32); };
    const int NIT = NB * 4 * 128;
    if ((int)blockIdx.x < NIT) { issue_a(blockIdx.x); issue_e(blockIdx.x); }
    for (int it = blockIdx.x; it < NIT; it += F.G) {
        const int j = it & 127, h = (it >> 7) & 3, b = it >> 9;
        const int tok0 = b * SEQ + 64 * j;
        const int itn = (it + F.G < NIT) ? it + F.G : it;
        float q8[8], k8[8]; u32x2 gr[4];
        {
            rope_apply(pqm, pqp, pcs, dc, true, q8);
            rope_apply(pkm, pkp, pcs, dc, true, k8);
#pragma unroll
            for (int ct = 0; ct < 4; ++ct) gr[ct] = pgr[ct];
            const bf16x8 zero = (bf16x8){0, 0, 0, 0, 0, 0, 0, 0};
            bf16x8 ga[2][2];
#pragma unroll
            for (int h2 = 0; h2 < 2; ++h2)
#pragma unroll
                for (int t = 0; t < 2; ++t) ga[h2][t] = (fq < 2) ? pga[h2][t] : zero;
            issue_a(itn);
            const bf16x8 wb = __builtin_bit_cast(bf16x8, WB[((gdir * 4 + h) * 4 + gdt) * 64 + lane]); const float ba = BAS[(gdir * 4 + h) * 64 + gd];
            float r[2][8], bend; gate_cum16(ga, wb, ba, gdir, lane, r, bend);
            float* BC = gdir ? BCB : BCF;
#pragma unroll
            for (int h2 = 0; h2 < 2; ++h2)
#pragma unroll
                for (int i = 0; i < 8; ++i) BC[(32 * h2 + 8 * fq + i) * 68 + gd] = r[h2][i];
        }
        __syncthreads();
        {
            const f32x4 f0 = *(const f32x4*)(BCF + c * 68 + 8 * dc), f1 = *(const f32x4*)(BCF + c * 68 + 8 * dc + 4), b0 = *(const f32x4*)(BCB + c * 68 + 8 * dc), b1 = *(const f32x4*)(BCB + c * 68 + 8 * dc + 4);
            const float bf[8] = {f0[0], f0[1], f0[2], f0[3], f1[0], f1[1], f1[2], f1[3]}, bb[8] = {b0[0], b0[1], b0[2], b0[3], b1[0], b1[1], b1[2], b1[3]};
            float qf[8], kf[8], qb[8], kb[8];
#pragma unroll
            for (int i = 0; i < 8; ++i) { qf[i] = q8[i] * __expf(bf[i]) * 0.125f; kf[i] = k8[i] * __expf(-bf[i]); qb[i] = q8[i] * __expf(bb[i]) * 0.125f; kb[i] = k8[i] * __expf(-bb[i]); }
            u32x4 o;
            o.x = pk2(qf[0], qf[1]); o.y = pk2(qf[2], qf[3]); o.z = pk2(qf[4], qf[5]); o.w = pk2(qf[6], qf[7]); *(u32x4*)(QDF + c * 72 + 8 * dc) = o;
            o.x = pk2(kf[0], kf[1]); o.y = pk2(kf[2], kf[3]); o.z = pk2(kf[4], kf[5]); o.w = pk2(kf[6], kf[7]); *(u32x4*)(KIF + c * 72 + 8 * dc) = o;
            o.x = pk2(qb[0], qb[1]); o.y = pk2(qb[2], qb[3]); o.z = pk2(qb[4], qb[5]); o.w = pk2(qb[6], qb[7]); *(u32x4*)(QDB + c * 72 + 8 * dc) = o;
            o.x = pk2(kb[0], kb[1]); o.y = pk2(kb[2], kb[3]); o.z = pk2(kb[4], kb[5]); o.w = pk2(kb[6], kb[7]); *(u32x4*)(KIB + c * 72 + 8 * dc) = o;
        }
        __syncthreads();
        {
            const int ct = w & 3, sp = w >> 2;
            const bf16x8 bqf0 = *(const bf16x8*)(QDF + (16 * ct + fr) * 72 + 8 * fq), bqf1 = *(const bf16x8*)(QDF + (16 * ct + fr) * 72 + 32 + 8 * fq);
            const bf16x8 bqb0 = *(const bf16x8*)(QDB + (16 * ct + fr) * 72 + 8 * fq), bqb1 = *(const bf16x8*)(QDB + (16 * ct + fr) * 72 + 32 + 8 * fq);
#pragma unroll
            for (int t = 0; t < 2; ++t) { const int st = 2 * sp + t;
                f32x4 af = (f32x4){0.f, 0.f, 0.f, 0.f}, ab = af;
                af = __builtin_amdgcn_mfma_f32_16x16x32_bf16(*(const bf16x8*)(KIF + (16 * st + fr) * 72 + 8 * fq), bqf0, af, 0, 0, 0);
                af = __builtin_amdgcn_mfma_f32_16x16x32_bf16(*(const bf16x8*)(KIF + (16 * st + fr) * 72 + 32 + 8 * fq), bqf1, af, 0, 0, 0);
                ab = __builtin_amdgcn_mfma_f32_16x16x32_bf16(*(const bf16x8*)(KIB + (16 * st + fr) * 72 + 8 * fq), bqb0, ab, 0, 0, 0);
                ab = __builtin_amdgcn_mfma_f32_16x16x32_bf16(*(const bf16x8*)(KIB + (16 * st + fr) * 72 + 32 + 8 * fq), bqb1, ab, 0, 0, 0);
                const int cc = 16 * ct + fr, s0 = 16 * st + 4 * fq; float tt[4];
#pragma unroll
                for (int r = 0; r < 4; ++r) { const int s = s0 + r; tt[r] = (s <= cc ? af[r] : 0.f) + (s >= cc ? ab[r] : 0.f); }
                u32x2 o; o.x = pk2(tt[0], tt[1]); o.y = pk2(tt[2], tt[3]); *(u32x2*)(AT + cc * 72 + s0) = o; }
        }
        __syncthreads();
        f32x4 o4[4];
        {
#pragma unroll
            for (int ct = 0; ct < 4; ++ct) { f32x4 acc = (f32x4){0.f, 0.f, 0.f, 0.f};
#pragma unroll
                for (int ks = 0; ks < 2; ++ks) {
                    acc = __builtin_amdgcn_mfma_f32_16x16x32_bf16(pav[ks], *(const bf16x8*)(AT + (16 * ct + fr) * 72 + 32 * ks + 8 * fq), acc, 0, 0, 0);
                    acc = __builtin_amdgcn_mfma_f32_16x16x32_bf16(pasf[ks], *(const bf16x8*)(QDF + (16 * ct + fr) * 72 + 32 * ks + 8 * fq), acc, 0, 0, 0);
                    acc = __builtin_amdgcn_mfma_f32_16x16x32_bf16(pasb[ks], *(const bf16x8*)(QDB + (16 * ct + fr) * 72 + 32 * ks + 8 * fq), acc, 0, 0, 0); }
                o4[ct] = acc;
                float p = (acc[0] * acc[0] + acc[1] * acc[1]) + (acc[2] * acc[2] + acc[3] * acc[3]); p += __shfl_xor(p, 16); p += __shfl_xor(p, 32);
                if (fq == 0) SS[w * 64 + 16 * ct + fr] = p; }
            issue_e(itn);
        }
        __syncthreads();
        {
            const f32x4 gn = *(const f32x4*)(F.gla_norm + h * 128 + 16 * w + 4 * fq);
#pragma unroll
            for (int ct = 0; ct < 4; ++ct) { const int cc = 16 * ct + fr; float tot = 0.f;
#pragma unroll
                for (int w2 = 0; w2 < 8; ++w2) tot += SS[w2 * 64 + cc];
                const float rs = 1.0f / sqrtf(tot * (1.0f / 128.0f) + EPS);
                const float g[4] = {bflo(gr[ct].x), bfhi(gr[ct].x), bflo(gr[ct].y), bfhi(gr[ct].y)}; float y[4];
#pragma unroll
                for (int r = 0; r < 4; ++r) y[r] = o4[ct][r] * rs * gn[r] * (g[r] * __builtin_amdgcn_rcpf(1.0f + __expf(-g[r])));
                u32x2 o; o.x = pk2(y[0], y[1]); o.y = pk2(y[2], y[3]); *(u32x2*)(F.MIX + (size_t)(tok0 + cc) * DM + 512 + h * 128 + 16 * w + 4 * fq) = o; }
        }
        __syncthreads();
    }
}

__device__ __forceinline__ void ph5_na(const Frame& F) {
    constexpr int NT = 4;
    constexpr float LOG2E = 1.4426950408889634f, QS = 0.125f * LOG2E;
    bf16* CKs = (bf16*)F.lds;
    bf16* CVs = CKs + 256 * 72;
    float* RPB = (float*)(CVs + 64 * 264);
    bf16* QSw = (bf16*)(RPB + 468) + F.wave * (4 * 16 * 64);
    const int tid = F.tid, lane = F.lane, w = F.wave, qi = lane & 15, fq = lane >> 4;
    const int j = w & 3, sub = w >> 2;
    const int c = 16 * j + qi;
    const int kc0 = (j == 0) ? 0 : (j == 1) ? 8 : (j == 2) ? 24 : 32;
    const int cs = (c - 8 < 0) ? 0 : (c - 8 > 48 ? 48 : c - 8);
    const int kap = 8 * (qi >> 2) + (qi & 3);
    unsigned cmask = 0;
#pragma unroll
    for (int e = 0; e < 8; ++e) { const int kc = kc0 + 8 * fq + e; if (kc >= cs && kc < cs + 16) cmask |= 1u << e; }
    const int dc0 = kc0 + 8 * fq - c + 15;
    int dcc[8];
#pragma unroll
    for (int e = 0; e < 8; ++e) { const int t = dc0 + e; dcc[e] = t < 0 ? 0 : (t > 30 ? 30 : t); }
    const float NEG_INF = -__builtin_inff();
    const int ipw = (1024 + F.G - 1) / F.G;
    int cur_bh = -1;
    for (int it = blockIdx.x * ipw; it < (blockIdx.x + 1) * ipw && it < 1024; ++it) {
        const int rg = it & 15, bh = it >> 4, head = bh & 7, b = bh >> 3;
        if (bh != cur_bh) {
            cur_bh = bh;
            __syncthreads();
            { const int row = tid >> 1, hf = tid & 1; const bf16* src = F.P1 + p1_off(MLAT + b * CTXL + row, CK + head * 64 + 32 * hf);
              u32x4 v0 = *(const u32x4*)src, v1 = *(const u32x4*)(src + 8), v2 = *(const u32x4*)(src + 16), v3 = *(const u32x4*)(src + 24);
              bf16* dst = CKs + row * 72 + 32 * hf; *(u32x4*)dst = v0; *(u32x4*)(dst + 8) = v1; *(u32x4*)(dst + 16) = v2; *(u32x4*)(dst + 24) = v3; }
            { const int row = tid >> 3, sg = tid & 7; const int t0 = MLAT + b * CTXL + 32 * sg;
              u32x4 v0 = *(const u32x4*)(F.VT + vt_off(head * 64 + row, t0)), v1 = *(const u32x4*)(F.VT + vt_off(head * 64 + row, t0 + 8)), v2 = *(const u32x4*)(F.VT + vt_off(head * 64 + row, t0 + 16)), v3 = *(const u32x4*)(F.VT + vt_off(head * 64 + row, t0 + 24));
              bf16* dst = CVs + row * 264 + 32 * sg; *(u32x4*)dst = v0; *(u32x4*)(dst + 8) = v1; *(u32x4*)(dst + 16) = v2; *(u32x4*)(dst + 24) = v3; }
            if (tid < 465) RPB[tid] = F.rpb[head * 465 + tid] * LOG2E;
            __syncthreads();
        }
        const int rA = 8 * rg + 4 * sub;
        {
            bf16x8 qt[NT][2];
#pragma unroll
            for (int nt = 0; nt < NT; ++nt) { const bf16* qp = F.P1 + p1_off(b * SEQ + (rA + nt) * 64 + c, CQ + head * 64 + 8 * fq); qt[nt][0] = *(const bf16x8*)qp; qt[nt][1] = *(const bf16x8*)(qp + 32); }
#pragma unroll
            for (int nt = 0; nt < NT; ++nt)
#pragma unroll
                for (int ks = 0; ks < 2; ++ks) *(bf16x8*)(QSw + (nt * 16 + qi) * 64 + 8 * ((4 * ks + fq) ^ (qi & 7))) = qt[nt][ks];
        }
        float m[NT], l[NT]; f32x4 O[4][NT];
#pragma unroll
        for (int nt = 0; nt < NT; ++nt) { m[nt] = NEG_INF; l[nt] = 0.f;
#pragma unroll
            for (int dt = 0; dt < 4; ++dt) O[dt][nt] = (f32x4){0.f, 0.f, 0.f, 0.f}; }
        auto na_tile = [&](int nt, bool local, int kr, const bf16x8 (&kf)[2][2], const bf16x8 (&vf)[4]) {
            const int r = rA + nt;
            const bf16x8 q0 = *(const bf16x8*)(QSw + (nt * 16 + qi) * 64 + 8 * (fq ^ (qi & 7))), q1 = *(const bf16x8*)(QSw + (nt * 16 + qi) * 64 + 8 * ((4 + fq) ^ (qi & 7)));
            f32x4 s0 = (f32x4){0.f, 0.f, 0.f, 0.f}, s1 = s0;
            s0 = __builtin_amdgcn_mfma_f32_16x16x32_bf16(kf[0][0], q0, s0, 0, 0, 0); s0 = __builtin_amdgcn_mfma_f32_16x16x32_bf16(kf[0][1], q1, s0, 0, 0, 0);
            s1 = __builtin_amdgcn_mfma_f32_16x16x32_bf16(kf[1][0], q0, s1, 0, 0, 0); s1 = __builtin_amdgcn_mfma_f32_16x16x32_bf16(kf[1][1], q1, s1, 0, 0, 0);
            float sc[8];
            if (local) { const float* rp = RPB + (kr - r + 7) * 31; float bias[8];
#pragma unroll
                for (int e = 0; e < 8; ++e) bias[e] = rp[dcc[e]];
#pragma unroll
                for (int e = 0; e < 8; ++e) { const float a = (e < 4) ? s0[e & 3] : s1[e & 3]; sc[e] = ((cmask >> e) & 1u) ? a * QS + bias[e] : NEG_INF; }
            } else {
#pragma unroll
                for (int e = 0; e < 8; ++e) { const float a = (e < 4) ? s0[e & 3] : s1[e & 3]; sc[e] = a * QS; }
            }
            const float lmax = fmaxf(fmaxf(fmaxf(sc[0], sc[1]), fmaxf(sc[2], sc[3])), fmaxf(fmaxf(sc[4], sc[5]), fmaxf(sc[6], sc[7])));
            if (!__all(lmax <= m[nt] + 11.0f)) {
                float mx = fmaxf(lmax, __shfl_xor(lmax, 16)); mx = fmaxf(mx, __shfl_xor(mx, 32));
                const float mn = fmaxf(m[nt], mx), alpha = __builtin_amdgcn_exp2f(m[nt] - mn); m[nt] = mn; l[nt] *= alpha;
#pragma unroll
                for (int dt = 0; dt < 4; ++dt) O[dt][nt] = O[dt][nt] * alpha; }
            const float mn = m[nt];
            float p[8], ps = 0.f;
#pragma unroll
            for (int e = 0; e < 8; ++e) { p[e] = __builtin_amdgcn_exp2f(sc[e] - mn); ps += p[e]; }
            l[nt] += ps;
            u32x4 pw; pw.x = pk2(p[0], p[1]); pw.y = pk2(p[2], p[3]); pw.z = pk2(p[4], p[5]); pw.w = pk2(p[6], p[7]);
            const bf16x8 pf = __builtin_bit_cast(bf16x8, pw);
#pragma unroll
            for (int dt = 0; dt < 4; ++dt) O[dt][nt] = __builtin_amdgcn_mfma_f32_16x16x32_bf16(vf[dt], pf, O[dt][nt], 0, 0, 0);
            __builtin_amdgcn_sched_barrier(0);
        };
#pragma unroll 1
        for (int s = 0; s < 8; ++s) {
            bf16x8 kf[2][2], vf[4];
#pragma unroll
            for (int t = 0; t < 2; ++t) { const bf16* kp = CKs + (32 * s + kap + 4 * t) * 72 + 8 * fq; kf[t][0] = *(const bf16x8*)kp; kf[t][1] = *(const bf16x8*)(kp + 32); }
#pragma unroll
            for (int dt = 0; dt < 4; ++dt) vf[dt] = *(const bf16x8*)(CVs + (dt * 16 + qi) * 264 + 32 * s + 8 * fq);
#pragma unroll
            for (int nt = 0; nt < NT; ++nt) na_tile(nt, false, 0, kf, vf);
        }
        const int rsA = (rA - 4 < 0) ? 0 : (rA - 4 > 120 ? 120 : rA - 4);
        const int rlast = rA + NT - 1; const int rsB = (rlast - 4 < 0) ? 0 : (rlast - 4 > 120 ? 120 : rlast - 4);
        const int nloc = rsB + 8 - rsA, slast = nloc - 1;
        auto na_loadk = [&](int s, bf16x8 (&kf)[2][2]) {
            const int base_tok = b * SEQ + (rsA + s) * 64 + kc0;
#pragma unroll
            for (int t = 0; t < 2; ++t) { const bf16* kp = F.P1 + p1_off(base_tok + kap + 4 * t, CK + head * 64 + 8 * fq); kf[t][0] = *(const bf16x8*)kp; kf[t][1] = *(const bf16x8*)(kp + 32); }
        };
        auto na_step = [&](int s, const bf16x8 (&kf)[2][2]) {
            const int kr = rsA + s; const int base_tok = b * SEQ + kr * 64 + kc0;
            bf16x8 vf[4];
#pragma unroll
            for (int dt = 0; dt < 4; ++dt) vf[dt] = *(const bf16x8*)(F.VT + vt_off(head * 64 + dt * 16 + qi, base_tok + 8 * fq));
#pragma unroll
            for (int nt = 0; nt < NT; ++nt) {
                const int r = rA + nt; const int rs = (r - 4 < 0) ? 0 : (r - 4 > 120 ? 120 : r - 4);
                if (kr < rs || kr >= rs + 8) continue;
                na_tile(nt, true, kr, kf, vf);
            }
        };
        bf16x8 kfA[2][2], kfB[2][2];
        na_loadk(0, kfA);
        for (int s = 0; s < slast; s += 2) {
            na_loadk(s + 1, kfB);
            na_step(s, kfA);
            na_loadk((s + 2 < slast) ? s + 2 : slast, kfA);
            na_step(s + 1, kfB);
        }
        if (nloc & 1) na_step(slast, kfA);
#pragma unroll
        for (int nt = 0; nt < NT; ++nt) { float lt = l[nt]; lt += __shfl_xor(lt, 16); lt += __shfl_xor(lt, 32); const float inv = 1.0f / lt;
            bf16* op = F.MIX + (size_t)(b * SEQ + (rA + nt) * 64 + c) * DM + head * 64 + 4 * fq;
#pragma unroll
            for (int dt = 0; dt < 4; ++dt) { const f32x4 o = O[dt][nt] * inv; u32x2 ow; ow.x = pk2(o[0], o[1]); ow.y = pk2(o[2], o[3]); *(u32x2*)(op + 16 * dt) = ow; } }
    }
    __syncthreads();
}

__device__ __forceinline__ void ph7_mid(const Frame& F) {
    const int gw = blockIdx.x * 8 + F.wave, NGW = F.G * 8;
    int curb = -1; f32x4 c1[4], cA[4], cB[4];
#pragma unroll
    for (int j = 0; j < 4; ++j) { c1[j] = (f32x4){0.f, 0.f, 0.f, 0.f}; cA[j] = c1[j]; cB[j] = c1[j]; }
    for (int row0 = gw; row0 < MLAT; row0 += 2 * NGW) {
        const int nr = (row0 + NGW < MLAT) ? 2 : 1;
        f32x4 v[2][4]; u32x2 yw[2][4]; float sqp[2];
#pragma unroll
        for (int q = 0; q < 2; ++q) { const int row = (q < nr) ? row0 + q * NGW : row0;
#pragma unroll
            for (int j = 0; j < 4; ++j) { v[q][j] = __builtin_nontemporal_load((const f32x4*)(F.x + (size_t)row * DM) + F.lane + 64 * j); yw[q][j] = *((const u32x2*)(F.Y + (size_t)row * DM) + F.lane + 64 * j); }
            sqp[q] = F.lane < 16 ? F.SSQ1[(size_t)row * 16 + F.lane] : 0.f; }
#pragma unroll
        for (int q = 0; q < 2; ++q) { if (q < nr) { const int row = row0 + q * NGW; const int b = row >> 13;
            const float sq1 = wave_sum(sqp[q]);
            if (b != curb) { curb = b;
#pragma unroll
                for (int j = 0; j < 4; ++j) { const int col = 4 * (F.lane + 64 * j); const float* mb = F.MOD + b * NMOD;
                    c1[j] = *(const f32x4*)(mb + 2 * DM + col) * *(const f32x4*)(F.g_post_mix + col);
                    cA[j] = *(const f32x4*)(F.g_pre_ffn + col) * (*(const f32x4*)(mb + 4 * DM + col) + 1.0f); cB[j] = *(const f32x4*)(mb + 3 * DM + col); } }
            const float rstd1 = 1.0f / sqrtf(sq1 * (1.0f / DM) + EPS);
            float ss = 0.f;
#pragma unroll
            for (int j = 0; j < 4; ++j) { const f32x4 y = (f32x4){bflo(yw[q][j].x), bfhi(yw[q][j].x), bflo(yw[q][j].y), bfhi(yw[q][j].y)}; v[q][j] = v[q][j] + c1[j] * (y * rstd1);
                ss += (v[q][j][0] * v[q][j][0] + v[q][j][1] * v[q][j][1]) + (v[q][j][2] * v[q][j][2] + v[q][j][3] * v[q][j][3]);
                u32x2 xw; xw.x = pk2(v[q][j][0], v[q][j][1]); xw.y = pk2(v[q][j][2], v[q][j][3]); *(u32x2*)(F.X1B + (size_t)row * DM + 4 * (F.lane + 64 * j)) = xw; }
            const float rstd2 = 1.0f / sqrtf(wave_sum(ss) * (1.0f / DM) + EPS);
#pragma unroll
            for (int j = 0; j < 4; ++j) { const f32x4 o = v[q][j] * rstd2 * cA[j] + cB[j]; u32x2 wv; wv.x = pk2(o[0], o[1]); wv.y = pk2(o[2], o[3]); *(u32x2*)(F.H + (size_t)row * DM + 4 * (F.lane + 64 * j)) = wv; } } }
    }
}
__device__ __forceinline__ void ph10_final(const Frame& F) {
    const int gw = blockIdx.x * 8 + F.wave, NGW = F.G * 8;
    int curb = -1; f32x4 c2[4];
#pragma unroll
    for (int j = 0; j < 4; ++j) c2[j] = (f32x4){0.f, 0.f, 0.f, 0.f};
    for (int row0 = gw; row0 < MLAT; row0 += 2 * NGW) {
        const int nr = (row0 + NGW < MLAT) ? 2 : 1;
        u32x2 xw[2][4], dw[2][4]; float sp2[2];
#pragma unroll
        for (int q = 0; q < 2; ++q) { const int row = (q < nr) ? row0 + q * NGW : row0;
#pragma unroll
            for (int j = 0; j < 4; ++j) { xw[q][j] = *((const u32x2*)(F.X1B + (size_t)row * DM) + F.lane + 64 * j); dw[q][j] = *((const u32x2*)(F.DOWN + (size_t)row * DM) + F.lane + 64 * j); }
            sp2[q] = F.lane < 16 ? F.SSQ2[(size_t)row * 16 + F.lane] : 0.f; }
#pragma unroll
        for (int q = 0; q < 2; ++q) { if (q < nr) { const int row = row0 + q * NGW; const int b = row >> 13;
            const float sq2 = wave_sum(sp2[q]);
            if (b != curb) { curb = b;
#pragma unroll
                for (int j = 0; j < 4; ++j) { const int col = 4 * (F.lane + 64 * j); const float* mb = F.MOD + b * NMOD; c2[j] = *(const f32x4*)(mb + 5 * DM + col) * *(const f32x4*)(F.g_post_ffn + col); } }
            const float rstd2 = 1.0f / sqrtf(sq2 * (1.0f / DM) + EPS);
#pragma unroll
            for (int j = 0; j < 4; ++j) { const f32x4 x1 = (f32x4){bflo(xw[q][j].x), bfhi(xw[q][j].x), bflo(xw[q][j].y), bfhi(xw[q][j].y)}, d = (f32x4){bflo(dw[q][j].x), bfhi(dw[q][j].x), bflo(dw[q][j].y), bfhi(dw[q][j].y)};
                const f32x4 o = x1 + c2[j] * (d * rstd2); *((f32x4*)(F.out + (size_t)row * DM) + F.lane + 64 * j) = o; } } }
    }
}

struct Args { const float* in[20]; float* out; unsigned char* ws; int ph_lo, ph_hi; };
constexpr int NPHASES = 11;

__global__ void __launch_bounds__(NTHREADS, 2) mk_fwd(Args args) {
    extern __shared__ __attribute__((aligned(16))) unsigned char lds[];
    cg::grid_group grid = cg::this_grid();
    Frame F;
    F.lds = lds; F.tid = threadIdx.x; F.lane = F.tid & 63; F.wave = __builtin_amdgcn_readfirstlane(F.tid >> 6); F.G = gridDim.x;
    F.x = args.in[0]; F.c = args.in[1]; F.ctx = args.in[2]; F.c_ctx = args.in[3]; F.w_mod = args.in[4]; F.b_mod = args.in[5]; F.g_pre_mix = args.in[6]; F.g_post_mix = args.in[7];
    F.g_pre_ffn = args.in[8]; F.g_post_ffn = args.in[9]; F.w_in = args.in[10]; F.rpb = args.in[11]; F.wa2_f = args.in[12]; F.ba_f = args.in[13]; F.wa2_b = args.in[14]; F.ba_b = args.in[15];
    F.gla_norm = args.in[16]; F.w_out = args.in[17]; F.w_gu = args.in[18]; F.w_down = args.in[19]; F.out = args.out;
    unsigned char* ws = args.ws;
    F.MOD = (float*)(ws + WS_MOD); F.ROPE = (float*)(ws + WS_ROPE); F.DEC = (float*)(ws + WS_DEC); F.SSQ1 = (float*)(ws + WS_SSQ1); F.SSQ2 = (float*)(ws + WS_SSQ2);
    F.WMAIN = (bf16*)(ws + WS_WMAIN); F.WV = (bf16*)(ws + WS_WV); F.WOUT = (bf16*)(ws + WS_WOUT); F.WGU = (bf16*)(ws + WS_WGU); F.WDOWN = (bf16*)(ws + WS_WDOWN);
    F.H = (bf16*)(ws + WS_H); F.P1 = (bf16*)(ws + WS_P1); F.VT = (bf16*)(ws + WS_VT); F.KV = (bf16*)(ws + WS_KV); F.MIX = (bf16*)(ws + WS_MIX); F.Y = (bf16*)(ws + WS_Y); F.ACT = (bf16*)(ws + WS_ACT); F.DOWN = (bf16*)(ws + WS_DOWN); F.X1B = (bf16*)(ws + WS_X1B);
    PG8_LAS unsigned char* glds = (PG8_LAS unsigned char*)lds;
    const int lo = args.ph_lo, hi = args.ph_hi;
    volatile unsigned* MISC = (volatile unsigned*)(lds + LDS_BYTES - 128);
    if (F.tid < 32) MISC[F.tid] = 0u;
    __syncthreads();
    XcdBarrier xbar = xcd_barrier_post((unsigned*)(ws + WS_CTL) + 4096, MISC + 8);
#define IN(k) (lo <= (k) && (k) < hi)
#define REP(k) ((MK_REP_PHASE == (k)) ? 2 : 1)
#define SEAM(k) do { if (IN(k) && IN((k) + 1)) { if ((k) < MK_CG_SEAMS) grid.sync(); else xcd_barrier(xbar); } } while (0)

    if (IN(0)) for (int rep = 0; rep < REP(0); ++rep) ph0_mod(F);
    SEAM(0);
    if (IN(1)) for (int rep = 0; rep < REP(1); ++rep) ph1_rows(F);
    SEAM(1);
    if (IN(2)) for (int rep = 0; rep < REP(2); ++rep) {
        pg8::Gemm g1{F.H, F.WMAIN, MTOT, LDP, DM}, g2{F.WV, F.H, 1024, MTOT, DM};
        pg8::DualOrder S; S.o1.init(g1, F.G, (int)blockIdx.x); S.o2.init(g2, F.G, (int)blockIdx.x); S.G = F.G; S.c = (int)blockIdx.x;
        pg8::EpiDual E{pg8::EpiStore{F.P1, MTOT}, pg8::EpiStoreBlk{F.VT, 1024}};
        pg8::gemm_phase<pg8::EpiDual, pg8::DualOrder, true, true>(glds, g1, S, E);
    }
    SEAM(2);
    if (IN(3)) { for (int rep = 0; rep < REP(3); ++rep) ph3_gla_kv(F); for (int rep = 0; rep < REP(11); ++rep) ph5_na(F); }
    SEAM(3);
    if (IN(4)) ph4_gla_scan(F);
    if (MK_REP_PHASE == 4) { xcd_barrier(xbar); ph3_gla_kv(F); xcd_barrier(xbar); ph4_gla_scan(F); }
    SEAM(4);
    if (IN(5)) { for (int rep = 0; rep < REP(5); ++rep) ph5_gla_out(F); }
    SEAM(5);
    if (IN(6)) for (int rep = 0; rep < REP(6); ++rep) { pg8::Gemm g{F.MIX, F.WOUT, MLAT, DM, DM}; pg8::StaticOrder S; S.init(g, F.G, (int)blockIdx.x); pg8::EpiStoreSsq E{F.Y, DM, F.SSQ1};
        pg8::gemm_phase<pg8::EpiStoreSsq, pg8::StaticOrder, true, true>(glds, g, S, E); }
    SEAM(6);
    if (IN(7)) for (int rep = 0; rep < REP(7); ++rep) ph7_mid(F);
    SEAM(7);
    if (IN(8)) for (int rep = 0; rep < REP(8); ++rep) { pg8::Gemm g{F.H, F.WGU, MLAT, 2 * FFN, DM}; pg8::StaticOrder S; S.init(g, F.G, (int)blockIdx.x); pg8::EpiSwiglu E{F.ACT, FFN};
        pg8::gemm_phase<pg8::EpiSwiglu, pg8::StaticOrder, true, true>(glds, g, S, E); }
    SEAM(8);
    if (IN(9)) for (int rep = 0; rep < REP(9); ++rep) { pg8::Gemm g{F.ACT, F.WDOWN, MLAT, DM, FFN}; pg8::StaticOrder S; S.init(g, F.G, (int)blockIdx.x, 1); pg8::EpiStoreSsq E{F.DOWN, DM, F.SSQ2};
        pg8::gemm_phase<pg8::EpiStoreSsq, pg8::StaticOrder, true, true>(glds, g, S, E); }
    SEAM(9);
    if (IN(10)) for (int rep = 0; rep < REP(10); ++rep) ph10_final(F);
#undef IN
#undef SEAM
#undef REP
}

extern "C" void kernel_launch(void* const* d_in, const int* in_sizes, int n_in, void* d_out, int out_size, void* d_ws, size_t ws_size, hipStream_t stream) {
    static int grid = 0;
    if (grid == 0) {
        if (n_in != 20 || in_sizes[0] != MLAT * DM || out_size != MLAT * DM || ws_size < WS_END) { fprintf(stderr, "kernel_launch: unexpected shapes (n_in %d, in0 %d, out %d, ws %zu)\n", n_in, n_in > 0 ? in_sizes[0] : -1, out_size, ws_size); grid = -1; return; }
        int dev = 0, cus = 0, per_cu = 0;
        if (hipGetDevice(&dev) != hipSuccess || hipDeviceGetAttribute(&cus, hipDeviceAttributeMultiprocessorCount, dev) != hipSuccess) { fprintf(stderr, "kernel_launch: device query failed\n"); grid = -1; return; }
        if (hipFuncSetAttribute((const void*)mk_fwd, hipFuncAttributeMaxDynamicSharedMemorySize, LDS_BYTES) != hipSuccess) { fprintf(stderr, "kernel_launch: hipFuncSetAttribute failed\n"); grid = -1; return; }
        if (hipOccupancyMaxActiveBlocksPerMultiprocessor(&per_cu, (const void*)mk_fwd, NTHREADS, LDS_BYTES) != hipSuccess || per_cu < 1) { fprintf(stderr, "kernel_launch: occupancy query says %d blocks per CU\n", per_cu); (void)hipGetLastError(); grid = -1; return; }
        grid = cus;
    }
    if (grid < 0) return;
    if (hipMemsetAsync((char*)d_ws + WS_CTL, 0, CTL_ZERO_BYTES, stream) != hipSuccess) { fprintf(stderr, "kernel_launch: hipMemsetAsync failed\n"); return; }
    Args a{};
    for (int i = 0; i < 20; ++i) a.in[i] = (const float*)d_in[i];
    a.out = (float*)d_out; a.ws = (unsigned char*)d_ws;
#if MK_PER_PHASE
    for (int p = 0; p < NPHASES; ++p) { a.ph_lo = p; a.ph_hi = p + 1; void* kargs[] = {&a};
        hipError_t e = hipLaunchCooperativeKernel((const void*)mk_fwd, dim3(grid), dim3(NTHREADS), kargs, LDS_BYTES, stream);
        if (e != hipSuccess) { fprintf(stderr, "kernel_launch: launch of phase %d failed: %s\n", p, hipGetErrorString(e)); break; } }
#else
    a.ph_lo = 0; a.ph_hi = NPHASES; void* kargs[] = {&a};
    hipError_t e = hipLaunchCooperativeKernel((const void*)mk_fwd, dim3(grid), dim3(NTHREADS), kargs, LDS_BYTES, stream);
    if (e != hipSuccess) fprintf(stderr, "kernel_launch: cooperative launch failed: %s (grid %d)\n", hipGetErrorString(e), grid);
#endif
}
```

```cpp
#include <hip/hip_runtime.h>
#include <hip/hip_cooperative_groups.h>
#include <cstdio>
#include <cstdint>
namespace cg = cooperative_groups;

#ifndef MK_PER_PHASE
#define MK_PER_PHASE 0
#endif
#ifndef MK_REP_PHASE
#define MK_REP_PHASE -1
#endif
#ifndef MK_CG_SEAMS
#define MK_CG_SEAMS 0
#endif

namespace pg8 {
#define PG8_LAS __attribute__((address_space(3)))
typedef unsigned short bf16_t;
typedef short bf16x8 __attribute__((ext_vector_type(8)));
typedef float f32x4 __attribute__((ext_vector_type(4)));
typedef unsigned u32x4 __attribute__((ext_vector_type(4)));
constexpr int BM = 256, BK = 64, HALF = 128, HTB = HALF * BK * 2, STAGE_BYTES = 8 * HTB, NXCD = 8, WGM = 8;

__host__ __device__ __forceinline__ int lds_byte(int r, int c) { const int st = (r >> 4) * 2 + (c >> 5), rr = r & 15, cc = c & 31, ob = rr * 64 + cc * 2; return st * 1024 + (ob ^ (((ob >> 9) & 1) << 5)); }
__host__ __device__ __forceinline__ void stage_rc(int b, int& R, int& C) { const int st = b / 1024, sb = b % 1024, swz = sb ^ (((sb >> 9) & 1) << 5); R = (st >> 1) * 16 + swz / 64; C = (st & 1) * 32 + (swz % 64) / 2; }
__host__ __device__ __forceinline__ int perm32(int rho) { const int n = rho >> 4, i = rho & 15; return 8 * (i >> 2) + 4 * n + (i & 3); }

struct Unit { int pm, pn, kind; const char* a; const char* b; };
struct Gemm { const bf16_t* A; const bf16_t* Bt; int M, N, K; };

struct StaticOrder {
    int nM, nN, nwg, G, c, rev; const char* A; const char* Bt; size_t tstep;
    __host__ __device__ void init(const Gemm& g, int G_, int c_, int rev_ = 0) { nM = g.M / BM; nN = g.N / BM; nwg = nM * nN; G = G_; c = c_; rev = rev_; A = (const char*)g.A; Bt = (const char*)g.Bt; tstep = (size_t)BM * g.K * 2; }
    __host__ __device__ void map(int wgid, Unit& u) const {
        { const int q = nwg / NXCD, r = nwg % NXCD, xcd = wgid % NXCD, off = wgid / NXCD; wgid = (xcd < r ? xcd * (q + 1) : r * (q + 1) + (xcd - r) * q) + off; }
        const int nig = WGM * nN, gid = wgid / nig, fm = gid * WGM, gsz = (nM - fm) < WGM ? (nM - fm) : WGM;
        u.pm = fm + ((wgid % nig) % gsz); if (rev) u.pm = nM - 1 - u.pm; u.pn = (wgid % nig) / gsz; u.kind = 0; u.a = A + (size_t)u.pm * tstep; u.b = Bt + (size_t)u.pn * tstep;
    }
    __host__ __device__ bool next(int i, Unit& u) const { const long L = (long)i * G + c; if (L >= nwg) return false; map((int)L, u); return true; }
    __device__ __forceinline__ void a_ready(const Unit&) const {}
    __device__ __forceinline__ void done(const Unit&) const {}
};
struct DualOrder {
    StaticOrder o1, o2; int G, c;
    __host__ __device__ bool next(int i, Unit& u) const { const long L = (long)i * G + c; if (L >= o1.nwg + o2.nwg) return false;
        if (L < o1.nwg) o1.map((int)L, u); else { o2.map((int)(L - o1.nwg), u); u.kind = 1; } return true; }
    __device__ __forceinline__ void a_ready(const Unit&) const {}
    __device__ __forceinline__ void done(const Unit&) const {}
};

__device__ __forceinline__ unsigned cvt_pk_bf16(float lo, float hi) { unsigned r; asm volatile("v_cvt_pk_bf16_f32 %0, %1, %2" : "=v"(r) : "v"(lo), "v"(hi)); return r; }

struct EpiStore {
    static constexpr bool PERM = true, AFTER_DRAIN = false;
    bf16_t* O; int nrows;
    __device__ __forceinline__ void operator()(const f32x4 (&acc)[2][2][4][2], const Unit& u, int wr, int wc, int fr, int fq) const {
        const int row0 = u.pm * BM + wr * 64 + fr, col0 = wc * 32 + 8 * fq; bf16_t* blk = O + (size_t)u.pn * nrows * 256;
#pragma unroll
        for (int ai = 0; ai < 2; ++ai)
#pragma unroll
            for (int m = 0; m < 4; ++m) { bf16_t* rowp = blk + (size_t)(row0 + ai * HALF + m * 16) * 256 + col0;
#pragma unroll
                for (int bj = 0; bj < 2; ++bj) { const f32x4 v0 = acc[ai][bj][m][0], v1 = acc[ai][bj][m][1];
                    u32x4 w; w.x = cvt_pk_bf16(v0[0], v0[1]); w.y = cvt_pk_bf16(v0[2], v0[3]); w.z = cvt_pk_bf16(v1[0], v1[1]); w.w = cvt_pk_bf16(v1[2], v1[3]);
                    *(u32x4*)(rowp + bj * HALF) = w; } }
    }
};
struct EpiStoreBlk {
    static constexpr bool PERM = true, AFTER_DRAIN = false;
    bf16_t* O; int nrows;
    __device__ __forceinline__ void operator()(const f32x4 (&acc)[2][2][4][2], const Unit& u, int wr, int wc, int fr, int fq) const {
        const int row0 = u.pm * BM + wr * 64 + fr;
#pragma unroll
        for (int ai = 0; ai < 2; ++ai)
#pragma unroll
            for (int m = 0; m < 4; ++m) { const int r = row0 + ai * HALF + m * 16;
#pragma unroll
                for (int bj = 0; bj < 2; ++bj) { const f32x4 v0 = acc[ai][bj][m][0], v1 = acc[ai][bj][m][1];
                    u32x4 w; w.x = cvt_pk_bf16(v0[0], v0[1]); w.y = cvt_pk_bf16(v0[2], v0[3]); w.z = cvt_pk_bf16(v1[0], v1[1]); w.w = cvt_pk_bf16(v1[2], v1[3]);
                    const int g32 = u.pn * 8 + bj * 4 + wc;
                    *(u32x4*)(O + ((size_t)g32 * (nrows >> 4) + (r >> 4)) * 512 + fq * 128 + (r & 15) * 8) = w; } }
    }
};
struct EpiDual {
    static constexpr bool PERM = true, AFTER_DRAIN = false;
    EpiStore e0; EpiStoreBlk e1;
    __device__ __forceinline__ void operator()(const f32x4 (&acc)[2][2][4][2], const Unit& u, int wr, int wc, int fr, int fq) const { if (u.kind == 0) e0(acc, u, wr, wc, fr, fq); else e1(acc, u, wr, wc, fr, fq); }
};
struct EpiStoreSsq {
    static constexpr bool PERM = true, AFTER_DRAIN = false;
    bf16_t* O; int ldc; float* ssq;
    __device__ __forceinline__ void operator()(const f32x4 (&acc)[2][2][4][2], const Unit& u, int wr, int wc, int fr, int fq) const {
        const int row0 = u.pm * BM + wr * 64 + fr, col0 = u.pn * BM + wc * 32 + 8 * fq;
#pragma unroll
        for (int ai = 0; ai < 2; ++ai)
#pragma unroll
            for (int m = 0; m < 4; ++m) { const int row = row0 + ai * HALF + m * 16; bf16_t* rowp = O + (size_t)row * ldc + col0; float s = 0.f;
#pragma unroll
                for (int bj = 0; bj < 2; ++bj) { const f32x4 v0 = acc[ai][bj][m][0], v1 = acc[ai][bj][m][1];
                    s += (v0[0] * v0[0] + v0[1] * v0[1]) + (v0[2] * v0[2] + v0[3] * v0[3]) + (v1[0] * v1[0] + v1[1] * v1[1]) + (v1[2] * v1[2] + v1[3] * v1[3]);
                    u32x4 w; w.x = cvt_pk_bf16(v0[0], v0[1]); w.y = cvt_pk_bf16(v0[2], v0[3]); w.z = cvt_pk_bf16(v1[0], v1[1]); w.w = cvt_pk_bf16(v1[2], v1[3]);
                    *(u32x4*)(rowp + bj * HALF) = w; }
                s += __shfl_xor(s, 16); s += __shfl_xor(s, 32);
                if (fq == 0) ssq[(size_t)row * 16 + u.pn * 4 + wc] = s; }
    }
};
struct EpiSwiglu {
    static constexpr bool PERM = true, AFTER_DRAIN = false;
    bf16_t* O; int ldc;
    __device__ __forceinline__ void operator()(const f32x4 (&acc)[2][2][4][2], const Unit& u, int wr, int wc, int fr, int fq) const {
        const int row0 = u.pm * BM + wr * 64 + fr, col0 = u.pn * HALF + wc * 32 + 8 * fq;
#pragma unroll
        for (int ai = 0; ai < 2; ++ai)
#pragma unroll
            for (int m = 0; m < 4; ++m) { bf16_t* rowp = O + (size_t)(row0 + ai * HALF + m * 16) * ldc + col0; float a[8];
#pragma unroll
                for (int n = 0; n < 2; ++n)
#pragma unroll
                    for (int i = 0; i < 4; ++i) { const float g = acc[ai][0][m][n][i], uu = acc[ai][1][m][n][i]; a[n * 4 + i] = g * __builtin_amdgcn_rcpf(1.0f + __expf(-g)) * uu; }
                u32x4 w; w.x = cvt_pk_bf16(a[0], a[1]); w.y = cvt_pk_bf16(a[2], a[3]); w.z = cvt_pk_bf16(a[4], a[5]); w.w = cvt_pk_bf16(a[6], a[7]);
                *(u32x4*)rowp = w; }
    }
};

template <class Epi, class Sched, bool ALIGN_EPI = false, bool SP2 = false>
__device__ __forceinline__ void gemm_phase(PG8_LAS unsigned char* lds, const Gemm g, const Sched& S, const Epi& E) {
    const int tid = threadIdx.x, wid = __builtin_amdgcn_readfirstlane(tid >> 6), lane = tid & 63, wr = wid >> 2, wc = wid & 3, fr = lane & 15, fq = lane >> 4;
    const int K = g.K, nt = K / BK;
    unsigned voffA[2], voffB[2];
#pragma unroll
    for (int i = 0; i < 2; ++i) { int R, C; stage_rc(tid * 16 + i * 8192, R, C); const int Rb = Epi::PERM ? ((R & ~31) + perm32(R & 31)) : R;
        voffA[i] = (unsigned)(R * K + C) * 2u; voffB[i] = (unsigned)(Rb * K + C) * 2u; }
    const size_t kstep = (size_t)(BK * 2);
    const size_t hstep = (size_t)HALF * K * 2;
    const unsigned ldsw = (unsigned)wid * 1024u;
    const int aoff = lds_byte(wr * 64 + fr, fq * 8), boff = lds_byte(wc * 32 + fr, fq * 8);
#define PG8_SA(b, h) (((b) * 2 + (h)) * HTB)
#define PG8_SB(b, h) ((4 + (b) * 2 + (h)) * HTB)
#define PG8_STAGE(bufoff, gbase, voff) do { _Pragma("unroll") for (int _i = 0; _i < 2; ++_i) \
        __builtin_amdgcn_global_load_lds((const unsigned*)((const char*)(gbase) + (voff)[_i]), (PG8_LAS unsigned*)(lds + (bufoff) + ldsw + _i * 8192), 16, 0, 0); } while (0)
#define PG8_LDA(dst, b, h) do { _Pragma("unroll") for (int m = 0; m < 4; ++m) _Pragma("unroll") for (int k = 0; k < 2; ++k) dst[m][k] = *(const PG8_LAS bf16x8*)(lds + PG8_SA(b, h) + aoff + m * 2048 + k * 1024); } while (0)
#define PG8_LDB(dst, b, h) do { _Pragma("unroll") for (int n = 0; n < 2; ++n) _Pragma("unroll") for (int k = 0; k < 2; ++k) dst[n][k] = *(const PG8_LAS bf16x8*)(lds + PG8_SB(b, h) + boff + n * 2048 + k * 1024); } while (0)
#define PG8_MMA(ai, bj, At, Bt) do { __builtin_amdgcn_s_setprio(1); _Pragma("unroll") for (int m = 0; m < 4; ++m) _Pragma("unroll") for (int n = 0; n < 2; ++n) _Pragma("unroll") for (int k = 0; k < 2; ++k) \
        acc[ai][bj][m][n] = __builtin_amdgcn_mfma_f32_16x16x32_bf16(Bt[n][k], At[m][k], acc[ai][bj][m][n], 0, 0, 0); __builtin_amdgcn_s_setprio(0); } while (0)
#define PG8_WAIT_V(n) asm volatile("s_waitcnt vmcnt(" #n ")" ::: "memory")
#define PG8_WAIT_L(n) asm volatile("s_waitcnt lgkmcnt(" #n ")" ::: "memory")
#define PG8_BAR __builtin_amdgcn_s_barrier()
#define PG8_SCHED __builtin_amdgcn_sched_barrier(0)
    Unit cur, nxt; int ui = 0;
    if (!S.next(0, cur)) return;
    f32x4 acc[2][2][4][2];
#pragma unroll
    for (int a = 0; a < 2; ++a)
#pragma unroll
        for (int b = 0; b < 2; ++b)
#pragma unroll
            for (int m = 0; m < 4; ++m)
#pragma unroll
                for (int n = 0; n < 2; ++n) acc[a][b][m][n] = (f32x4){0.f, 0.f, 0.f, 0.f};
    bf16x8 At[4][2], B0[2][2], B1[2][2];
    const char* cA = cur.a; const char* cB = cur.b;
    S.a_ready(cur);
    if constexpr (SP2) {
        PG8_STAGE(PG8_SB(0, 0), cB, voffB); PG8_STAGE(PG8_SB(0, 1), cB + hstep, voffB); PG8_STAGE(PG8_SA(0, 0), cA, voffA); PG8_STAGE(PG8_SA(0, 1), cA + hstep, voffA);
        if (wr == 1) PG8_BAR;
        PG8_WAIT_V(2); PG8_BAR;
        PG8_STAGE(PG8_SB(1, 0), cB + kstep, voffB); PG8_STAGE(PG8_SA(1, 0), cA + kstep, voffA); PG8_STAGE(PG8_SB(1, 1), cB + hstep + kstep, voffB);
        PG8_WAIT_V(6); PG8_BAR;
    } else {
        PG8_STAGE(PG8_SB(0, 0), cB, voffB); PG8_STAGE(PG8_SA(0, 0), cA, voffA); PG8_STAGE(PG8_SB(0, 1), cB + hstep, voffB); PG8_STAGE(PG8_SA(0, 1), cA + hstep, voffA);
        if (wr == 1) PG8_BAR;
        PG8_WAIT_V(4); PG8_BAR;
        PG8_STAGE(PG8_SB(1, 0), cB + kstep, voffB); PG8_STAGE(PG8_SA(1, 0), cA + kstep, voffA); PG8_STAGE(PG8_SB(1, 1), cB + hstep + kstep, voffB);
        PG8_WAIT_V(6); PG8_BAR;
    }
    for (;;) {
        const bool has_next = S.next(ui + 1, nxt);
        const char* nA = has_next ? nxt.a : cA; const char* nB = has_next ? nxt.b : cB;
        for (int t = 0; t < nt; t += 2) {
            const bool last = (t == nt - 2);
            const char* a1 = cA + (size_t)(t + 1) * kstep;
            const char* a2 = last ? nA : cA + (size_t)(t + 2) * kstep; const char* b2 = last ? nB : cB + (size_t)(t + 2) * kstep;
            const char* a3 = a2 + kstep; const char* b3 = b2 + kstep;
            if (last && has_next) S.a_ready(nxt);
            if constexpr (SP2) {
            PG8_LDB(B0, 0, 0); PG8_LDB(B1, 0, 1); PG8_SCHED; PG8_LDA(At, 0, 0); PG8_STAGE(PG8_SA(1, 1), a1 + hstep, voffA);
            PG8_WAIT_V(8); PG8_WAIT_L(0); PG8_BAR; PG8_MMA(0, 0, At, B0); PG8_MMA(0, 1, At, B1); PG8_BAR; PG8_SCHED;
            PG8_LDA(At, 0, 1); PG8_STAGE(PG8_SB(0, 0), b2, voffB); PG8_STAGE(PG8_SB(0, 1), b2 + hstep, voffB); PG8_STAGE(PG8_SA(0, 0), a2, voffA);
            PG8_WAIT_V(8); PG8_WAIT_L(0); PG8_BAR; PG8_MMA(1, 0, At, B0); PG8_MMA(1, 1, At, B1); PG8_BAR; PG8_SCHED;
            PG8_LDB(B0, 1, 0); PG8_LDB(B1, 1, 1); PG8_SCHED; PG8_LDA(At, 1, 0); PG8_STAGE(PG8_SA(0, 1), a2 + hstep, voffA);
            PG8_WAIT_V(8); PG8_WAIT_L(0); PG8_BAR; PG8_MMA(0, 0, At, B0); PG8_MMA(0, 1, At, B1); PG8_BAR; PG8_SCHED;
            PG8_LDA(At, 1, 1); PG8_STAGE(PG8_SB(1, 0), b3, voffB); PG8_STAGE(PG8_SB(1, 1), b3 + hstep, voffB); PG8_STAGE(PG8_SA(1, 0), a3, voffA);
            PG8_WAIT_V(8); PG8_WAIT_L(0); PG8_BAR; PG8_MMA(1, 0, At, B0); PG8_MMA(1, 1, At, B1); PG8_BAR; PG8_SCHED;
            } else {
            PG8_LDB(B0, 0, 0); PG8_SCHED; PG8_LDA(At, 0, 0); PG8_STAGE(PG8_SA(1, 1), a1 + hstep, voffA);
            PG8_WAIT_L(8); PG8_BAR; PG8_WAIT_L(0); PG8_MMA(0, 0, At, B0); PG8_BAR; PG8_SCHED;
            PG8_LDB(B1, 0, 1); PG8_STAGE(PG8_SB(0, 0), b2, voffB);
            PG8_BAR; PG8_WAIT_L(0); PG8_MMA(0, 1, At, B1); PG8_BAR;
            PG8_LDA(At, 0, 1); PG8_STAGE(PG8_SA(0, 0), a2, voffA);
            PG8_BAR; PG8_WAIT_L(0); PG8_MMA(1, 0, At, B0); PG8_BAR; PG8_SCHED;
            PG8_STAGE(PG8_SB(0, 1), b2 + hstep, voffB);
            PG8_WAIT_V(6); PG8_BAR; PG8_MMA(1, 1, At, B1); PG8_BAR;
            PG8_LDB(B0, 1, 0); PG8_SCHED; PG8_LDA(At, 1, 0); PG8_STAGE(PG8_SA(0, 1), a2 + hstep, voffA);
            PG8_WAIT_L(8); PG8_BAR; PG8_WAIT_L(0); PG8_MMA(0, 0, At, B0); PG8_BAR; PG8_SCHED;
            PG8_LDB(B1, 1, 1); PG8_STAGE(PG8_SB(1, 0), b3, voffB);
            PG8_BAR; PG8_WAIT_L(0); PG8_MMA(0, 1, At, B1); PG8_BAR;
            PG8_LDA(At, 1, 1); PG8_STAGE(PG8_SA(1, 0), a3, voffA);
            PG8_BAR; PG8_WAIT_L(0); PG8_MMA(1, 0, At, B0); PG8_BAR; PG8_SCHED;
            PG8_STAGE(PG8_SB(1, 1), b3 + hstep, voffB);
            PG8_WAIT_V(6); PG8_BAR; PG8_MMA(1, 1, At, B1); PG8_BAR;
            }
        }
        if constexpr (ALIGN_EPI) { if (wr == 0) PG8_BAR; }
        if constexpr (!Epi::AFTER_DRAIN) { E(acc, cur, wr, wc, fr, fq); S.done(cur); }
        if (!has_next) break;
#pragma unroll
        for (int a = 0; a < 2; ++a)
#pragma unroll
            for (int b = 0; b < 2; ++b)
#pragma unroll
                for (int m = 0; m < 4; ++m)
#pragma unroll
                    for (int n = 0; n < 2; ++n) acc[a][b][m][n] = (f32x4){0.f, 0.f, 0.f, 0.f};
        cur = nxt; cA = nA; cB = nB; ++ui;
        if constexpr (ALIGN_EPI) { if (wr == 1) PG8_BAR; }
    }
    PG8_WAIT_V(0);
    if constexpr (!ALIGN_EPI) { if (wr == 0) PG8_BAR; }
    PG8_BAR;
#undef PG8_SA
#undef PG8_SB
#undef PG8_STAGE
#undef PG8_LDA
#undef PG8_LDB
#undef PG8_MMA
#undef PG8_WAIT_V
#undef PG8_WAIT_L
#undef PG8_BAR
#undef PG8_SCHED
}
}

typedef unsigned short bf16;
typedef short bf16x8 __attribute__((ext_vector_type(8)));
typedef float f32x4 __attribute__((ext_vector_type(4)));
typedef unsigned u32x4 __attribute__((ext_vector_type(4)));
typedef unsigned u32x2 __attribute__((ext_vector_type(2)));
#define LAS __attribute__((address_space(3)))

constexpr int NB = 8, SEQ = 8192, DM = 1024, CTXL = 256;
constexpr int MLAT = NB * SEQ, MCTX = NB * CTXL, MTOT = MLAT + MCTX;
constexpr int LDP = 2304;
constexpr int CQ = 0, CK = 512, CGQ = 1024, CGK = 1280, CGR = 1536, CAF = 2048, CAB = 2064;
__device__ __forceinline__ size_t vt_off(int row, int tok) { return ((size_t)(tok >> 5) * 64 + (row >> 4)) * 512 + ((tok >> 3) & 3) * 128 + (row & 15) * 8; }
__device__ __forceinline__ size_t p1_off(int row, int col) { return ((size_t)(col >> 8) * MTOT + row) * 256 + (col & 255); }
constexpr int FFN = 2816, NMOD = 6 * DM;
constexpr int NCH = 132;
constexpr float EPS = 1e-6f;

constexpr size_t MiB = 1u << 20;
constexpr size_t WS_CTL = 0, CTL_ZERO_BYTES = 1 * MiB;
constexpr size_t WS_MOD = 1 * MiB;
constexpr size_t WS_ROPE = 1 * MiB + 512 * 1024;
constexpr size_t WS_WMAIN = 2 * MiB;
constexpr size_t WS_WV = 7 * MiB;
constexpr size_t WS_WOUT = 9 * MiB;
constexpr size_t WS_WGU = 11 * MiB;
constexpr size_t WS_WDOWN = 22 * MiB;
constexpr size_t WS_H = 32 * MiB;
constexpr size_t WS_P1 = 164 * MiB;
constexpr size_t WS_VT = 461 * MiB;
constexpr size_t WS_KV = 593 * MiB;
constexpr size_t WS_DEC = 725 * MiB;
constexpr size_t WS_SSQ1 = 728 * MiB;
constexpr size_t WS_SSQ2 = 732 * MiB;
constexpr size_t WS_MIX = 736 * MiB;
constexpr size_t WS_Y = WS_KV;
constexpr size_t WS_ACT = WS_P1;
constexpr size_t WS_DOWN = WS_MIX;
constexpr size_t WS_X1B = 864 * MiB;
constexpr size_t WS_END = 992 * MiB;
static_assert(WS_P1 + (size_t)MTOT * LDP * 2 <= WS_VT && WS_VT + (size_t)1024 * MTOT * 2 <= WS_KV && WS_KV + (size_t)64 * NCH * 128 * 64 * 2 <= WS_DEC, "ws map");
static_assert(WS_ACT + (size_t)MLAT * FFN * 2 <= WS_KV && WS_H + (size_t)MTOT * DM * 2 <= WS_P1 && WS_MIX + (size_t)MLAT * DM * 2 <= WS_END, "ws map 2");

constexpr int LDS_BYTES = 147456;
constexpr int NTHREADS = 512;

__device__ __forceinline__ unsigned f2bf(float f) { unsigned u = __builtin_bit_cast(unsigned, f); return (u + 0x7fffu + ((u >> 16) & 1u)) >> 16; }
typedef float f32x2_t __attribute__((ext_vector_type(2)));
typedef __bf16 bf16x2_t __attribute__((ext_vector_type(2)));
__device__ __forceinline__ unsigned pk2(float lo, float hi) { const f32x2_t v = {lo, hi}; return __builtin_bit_cast(unsigned, __builtin_convertvector(v, bf16x2_t)); }
__device__ __forceinline__ float bflo(unsigned w) { return __builtin_bit_cast(float, w << 16); }
__device__ __forceinline__ float bfhi(unsigned w) { return __builtin_bit_cast(float, w & 0xffff0000u); }
__device__ __forceinline__ float wave_sum(float v) {
#pragma unroll
    for (int o = 1; o < 64; o <<= 1) v += __shfl_xor(v, o);
    return v;
}
__device__ __forceinline__ void unpack8(const u32x4 w, float (&o)[8]) { o[0] = bflo(w.x); o[1] = bfhi(w.x); o[2] = bflo(w.y); o[3] = bfhi(w.y); o[4] = bflo(w.z); o[5] = bfhi(w.z); o[6] = bflo(w.w); o[7] = bfhi(w.w); }
__device__ __forceinline__ float logsig16(float z) { return (fminf(z, 0.f) - __logf(1.0f + __expf(-fabsf(z)))) * (1.0f / 16.0f); }

#define XB_TMO      128
#define XB_XCNT(j)  (256  + 64 * (j))
#define XB_XSUB(j)  (1280 + 64 * (j))
#define XB_XGEN(j)  (2304 + 64 * (j))
#define XB_TOP      3328
#define XB_TOPGEN   3392
#define XCD_BAR_WORDS 3456
#define XB_SPIN_CAP (1u << 18)
__device__ __forceinline__ unsigned xb_ld(unsigned* p)              { return __hip_atomic_load(p, __ATOMIC_RELAXED, __HIP_MEMORY_SCOPE_AGENT); }
__device__ __forceinline__ unsigned xb_add(unsigned* p, unsigned v) { return __hip_atomic_fetch_add(p, v, __ATOMIC_RELAXED, __HIP_MEMORY_SCOPE_AGENT); }
__device__ __forceinline__ unsigned xb_xcc_id() { return (unsigned)__builtin_amdgcn_s_getreg((3 << 11) | 20) & 0xFu; }
#define XB_SPIN(cond, bar) do { unsigned _sp = 0; while (cond) { __builtin_amdgcn_s_sleep(1); \
    if ((++_sp & 255u) == 0u) { if (xb_ld(&(bar)[XB_TMO])) break; if (_sp > XB_SPIN_CAP) { atomicAdd(&(bar)[XB_TMO], 1u); break; } } } } while (0)
struct XcdBarrier { unsigned* bar; unsigned x; volatile unsigned* st; };
__device__ __forceinline__ XcdBarrier xcd_barrier_post(unsigned* bar, volatile unsigned* st) {
    XcdBarrier b; b.bar = bar; b.x = xb_xcc_id(); b.st = st;
    if (threadIdx.x == 0) (void)xb_add(&bar[XB_XCNT(b.x)], 1u);
    return b;
}
__device__ __forceinline__ void xcd_barrier_complete(unsigned* bar, unsigned x, unsigned& nloc, unsigned& nx) {
    const unsigned G = gridDim.x * gridDim.y * gridDim.z;
    unsigned sum, cnt, mine, sp = 0u;
    for (;;) {
        sum = 0u; cnt = 0u; mine = 0u;
#pragma unroll
        for (unsigned j = 0; j < 16; ++j) { const unsigned c = xb_ld(&bar[XB_XCNT(j)]); sum += c; cnt += (c > 0u) ? 1u : 0u; mine = (j == x) ? c : mine; }
        if (sum == G) break;
        __builtin_amdgcn_s_sleep(1);
        if ((++sp & 255u) == 0u) { if (xb_ld(&bar[XB_TMO])) break; if (sp > XB_SPIN_CAP) { atomicAdd(&bar[XB_TMO], 1u); break; } }
    }
    nloc = mine > 0u ? mine : 1u; nx = cnt > 0u ? cnt : 1u;
}
__device__ __forceinline__ void xcd_barrier(const XcdBarrier& b) {
    asm volatile("s_waitcnt vmcnt(0)" ::: "memory");
    __syncthreads();
    if (threadIdx.x == 0) {
        unsigned* bar = b.bar;
        __builtin_amdgcn_s_waitcnt(0);
        unsigned nloc = b.st[0], nx = b.st[1];
        if (nloc == 0u) { xcd_barrier_complete(bar, b.x, nloc, nx); b.st[0] = nloc; b.st[1] = nx; }
        const unsigned old = xb_add(&bar[XB_XSUB(b.x)], 1u);
        const unsigned gen = old / nloc;
        if (old + 1u == (gen + 1u) * nloc) {
            __builtin_amdgcn_fence(__ATOMIC_RELEASE, "agent");
            asm volatile("s_waitcnt vmcnt(0)" ::: "memory");
            const unsigned og = xb_add(&bar[XB_TOP], 1u);
            const unsigned tg = og / nx;
            if (og + 1u == (tg + 1u) * nx) xb_add(&bar[XB_TOPGEN], 1u);
            else XB_SPIN(xb_ld(&bar[XB_TOPGEN]) == tg, bar);
            __builtin_amdgcn_fence(__ATOMIC_ACQUIRE, "agent");
            xb_add(&bar[XB_XGEN(b.x)], 1u);
            asm volatile("s_waitcnt vmcnt(0)" ::: "memory");
        } else {
            XB_SPIN(xb_ld(&bar[XB_XGEN(b.x)]) == gen, bar);
            __builtin_amdgcn_fence(__ATOMIC_ACQUIRE, "agent");
            asm volatile("s_waitcnt vmcnt(0)" ::: "memory");
        }
    }
    __syncthreads();
}

struct Frame {
    unsigned char* lds;
    int tid, lane, wave, G;
    const float *x, *c, *ctx, *c_ctx, *w_mod, *b_mod, *g_pre_mix, *g_post_mix, *g_pre_ffn, *g_post_ffn, *w_in, *rpb, *wa2_f, *ba_f, *wa2_b, *ba_b, *gla_norm, *w_out, *w_gu, *w_down;
    float* out;
    float *MOD, *ROPE, *DEC, *SSQ1, *SSQ2;
    bf16 *WMAIN, *WV, *WOUT, *WGU, *WDOWN, *H, *P1, *VT, *KV, *MIX, *Y, *ACT, *DOWN, *X1B;
};

__device__ __forceinline__ void ph0_mod(const Frame& F) {
    float* S = (float*)F.lds;
    float* PART = S + 9 * 1024;
    for (int i = F.tid; i < 9 * 1024; i += NTHREADS) { const int r = i >> 10, k = i & 1023; const float v = r < 8 ? F.c[r * 1024 + k] : F.c_ctx[k]; S[i] = v / (1.0f + expf(-v)); }
    __syncthreads();
    for (int cgp = blockIdx.x; cgp < 256; cgp += F.G) {
        const int n0 = cgp * 24, cgi = F.tid % 6, ks = F.tid / 6;
        float acc[9][4];
#pragma unroll
        for (int r = 0; r < 9; ++r)
#pragma unroll
            for (int j = 0; j < 4; ++j) acc[r][j] = 0.f;
        if (ks < 85) {
            for (int k = ks; k < 1024; k += 85) { const f32x4 w = *(const f32x4*)(F.w_mod + (size_t)k * NMOD + n0 + 4 * cgi);
#pragma unroll
                for (int r = 0; r < 9; ++r) { const float s = S[r * 1024 + k]; acc[r][0] += s * w[0]; acc[r][1] += s * w[1]; acc[r][2] += s * w[2]; acc[r][3] += s * w[3]; } }
#pragma unroll
            for (int r = 0; r < 9; ++r)
#pragma unroll
                for (int j = 0; j < 4; ++j) PART[(ks * 9 + r) * 24 + cgi * 4 + j] = acc[r][j];
        }
        __syncthreads();
        if (F.tid < 216) { const int r = F.tid / 24, col = F.tid % 24; float s = 0.f; for (int k2 = 0; k2 < 85; ++k2) s += PART[(k2 * 9 + r) * 24 + col]; F.MOD[r * NMOD + n0 + col] = s + F.b_mod[n0 + col]; }
        __syncthreads();
    }
    for (int i = blockIdx.x * NTHREADS + F.tid; i < 128 * 16; i += F.G * NTHREADS) {
        const int pos = i >> 4, ii = i & 15; const float inv = (float)pow(10000.0, -(double)ii / 16.0); const float ang = (float)pos * inv;
        F.ROPE[i] = (float)cos((double)ang); F.ROPE[2048 + i] = (float)sin((double)ang);
    }
}

__device__ __forceinline__ void transpose_item(const float* W, int ldn, int k0, int nsrc0, bf16* WT, int ldk, int drow0, float* scr, int lane) {
#pragma unroll 8
    for (int i = 0; i < 32; ++i) { const int kk = 2 * i + (lane >> 5); scr[kk * 33 + (lane & 31)] = W[(size_t)(k0 + kk) * ldn + nsrc0 + (lane & 31)]; }
    __builtin_amdgcn_wave_barrier();
    const int c = lane & 7;
#pragma unroll
    for (int j = 0; j < 4; ++j) { const int n = (lane >> 3) + 8 * j; const float* s = scr + (8 * c) * 33 + n;
        u32x4 o; o.x = pk2(s[0 * 33], s[1 * 33]); o.y = pk2(s[2 * 33], s[3 * 33]); o.z = pk2(s[4 * 33], s[5 * 33]); o.w = pk2(s[6 * 33], s[7 * 33]);
        *(u32x4*)(WT + (size_t)(drow0 + n) * ldk + k0 + 8 * c) = o; }
    __builtin_amdgcn_wave_barrier();
}
__device__ __forceinline__ void ph1_rows(const Frame& F) {
    const int gw = blockIdx.x * 8 + F.wave, NGW = F.G * 8;
    int curb = -1; f32x4 cA[4], cB[4];
#pragma unroll
    for (int j = 0; j < 4; ++j) { cA[j] = (f32x4){0.f, 0.f, 0.f, 0.f}; cB[j] = cA[j]; }
    for (int row0 = gw; row0 < MTOT; row0 += 2 * NGW) {
        const int nr = (row0 + NGW < MTOT) ? 2 : 1;
        f32x4 v[2][4];
#pragma unroll
        for (int q = 0; q < 2; ++q) { const int row = (q < nr) ? row0 + q * NGW : row0; const float* src = row < MLAT ? F.x + (size_t)row * DM : F.ctx + (size_t)(row - MLAT) * DM;
#pragma unroll
            for (int j = 0; j < 4; ++j) v[q][j] = __builtin_nontemporal_load((const f32x4*)src + F.lane + 64 * j); }
#pragma unroll
        for (int q = 0; q < 2; ++q) { if (q < nr) { const int row = row0 + q * NGW; const int b = row < MLAT ? (row >> 13) : 8; float ss = 0.f;
#pragma unroll
            for (int j = 0; j < 4; ++j) ss += (v[q][j][0] * v[q][j][0] + v[q][j][1] * v[q][j][1]) + (v[q][j][2] * v[q][j][2] + v[q][j][3] * v[q][j][3]);
            if (b != curb) { curb = b;
#pragma unroll
                for (int j = 0; j < 4; ++j) { const int col = 4 * (F.lane + 64 * j); const f32x4 g = *(const f32x4*)(F.g_pre_mix + col), sh = *(const f32x4*)(F.MOD + b * NMOD + col), sc = *(const f32x4*)(F.MOD + b * NMOD + DM + col);
                    cA[j] = g * (sc + 1.0f); cB[j] = sh; } }
            const float rstd = 1.0f / sqrtf(wave_sum(ss) * (1.0f / DM) + EPS);
#pragma unroll
            for (int j = 0; j < 4; ++j) { const f32x4 o = v[q][j] * rstd * cA[j] + cB[j]; u32x2 w; w.x = pk2(o[0], o[1]); w.y = pk2(o[2], o[3]); *(u32x2*)(F.H + (size_t)row * DM + 4 * (F.lane + 64 * j)) = w; } } }
    }
    float* scr = (float*)(F.lds + F.wave * 16384);
    constexpr int I_MAIN = 16 * 65, I_V = 16 * 32, I_OUT = 16 * 32, I_GU = 16 * 176, I_DOWN = 44 * 32, NITEMS = I_MAIN + I_V + I_OUT + I_GU + I_DOWN;
    for (int it = gw; it < NITEMS; it += NGW) {
        int r = it;
        if (r < I_MAIN) { const int kb = r / 65, nb = r % 65, dr = nb * 32; const int sc = dr < 1024 ? dr : (dr < 1536 ? dr + 512 : dr + 1024); transpose_item(F.w_in, 3104, kb * 64, sc, F.WMAIN, DM, dr, scr, F.lane); continue; } r -= I_MAIN;
        if (r < I_V) { const int kb = r / 32, nb = r % 32, dr = nb * 32; const int sc = dr < 512 ? dr + 1024 : dr + 1536; transpose_item(F.w_in, 3104, kb * 64, sc, F.WV, DM, dr, scr, F.lane); continue; } r -= I_V;
        if (r < I_OUT) { const int kb = r / 32, nb = r % 32; transpose_item(F.w_out, DM, kb * 64, nb * 32, F.WOUT, DM, nb * 32, scr, F.lane); continue; } r -= I_OUT;
        if (r < I_GU) { const int kb = r / 176, nb = r % 176, dr = nb * 32, pn = dr >> 8, jj = dr & 255; const int sc = jj < 128 ? 128 * pn + jj : FFN + 128 * pn + (jj - 128); transpose_item(F.w_gu, 2 * FFN, kb * 64, sc, F.WGU, DM, dr, scr, F.lane); continue; } r -= I_GU;
        { const int kb = r / 32, nb = r % 32; transpose_item(F.w_down, DM, kb * 64, nb * 32, F.WDOWN, FFN, nb * 32, scr, F.lane); }
    }
    for (int i = blockIdx.x * NTHREADS + F.tid; i < 224 * 1024 / 8; i += F.G * NTHREADS) *((u32x4*)(F.WMAIN + (size_t)2080 * DM) + i) = (u32x4){0u, 0u, 0u, 0u};
}

struct RopeCS { f32x4 c0, c1, s0, s1; };
__device__ __forceinline__ void rope_cs_issue(const float* rope, int dc, int posr, int posc, RopeCS& R) {
    const int pos = (dc >> 2) ? posc : posr, i0 = 8 * (dc & 1);
    R.c0 = *(const f32x4*)(rope + pos * 16 + i0); R.c1 = *(const f32x4*)(rope + pos * 16 + i0 + 4); R.s0 = *(const f32x4*)(rope + 2048 + pos * 16 + i0); R.s1 = *(const f32x4*)(rope + 2048 + pos * 16 + i0 + 4);
}
__device__ __forceinline__ int rope_partner(int dc) { return ((dc & 3) < 2) ? dc + 2 : dc - 2; }
__device__ __forceinline__ void rope_apply(const u32x4 mine, const u32x4 part, const RopeCS& R, int dc, bool do_rope, float (&o)[8]) {
    float a[8]; unpack8(mine, a);
    if (!do_rope) {
#pragma unroll
        for (int j = 0; j < 8; ++j) o[j] = a[j];
        return; }
    float p[8]; unpack8(part, p);
    const bool first = (dc & 3) < 2;
    const float cs[8] = {R.c0[0], R.c0[1], R.c0[2], R.c0[3], R.c1[0], R.c1[1], R.c1[2], R.c1[3]}, sn[8] = {R.s0[0], R.s0[1], R.s0[2], R.s0[3], R.s1[0], R.s1[1], R.s1[2], R.s1[3]};
#pragma unroll
    for (int j = 0; j < 8; ++j) o[j] = first ? (a[j] * cs[j] - p[j] * sn[j]) : (p[j] * sn[j] + a[j] * cs[j]);
}
__device__ __forceinline__ void stage_gate_weights(const Frame& F, u32x4* WB, float* BAS) {
    for (int e = F.tid; e < 2048; e += NTHREADS) { const int ln = e & 63, dt = (e >> 6) & 3, dirh = e >> 8, fq = ln >> 4, dd = ln & 15; const float* wa = (dirh >> 2) ? F.wa2_b : F.wa2_f; const int hh = dirh & 3;
        u32x4 v = (u32x4){0u, 0u, 0u, 0u};
        if (fq < 2) { float t[8];
#pragma unroll
            for (int jj = 0; jj < 8; ++jj) t[jj] = wa[(8 * fq + jj) * 256 + hh * 64 + 16 * dt + dd];
            v.x = pk2(t[0], t[1]); v.y = pk2(t[2], t[3]); v.z = pk2(t[4], t[5]); v.w = pk2(t[6], t[7]); }
        WB[e] = v; }
    { const int dh = F.tid >> 6, dd = F.tid & 63; BAS[F.tid] = ((dh >> 2) ? F.ba_b : F.ba_f)[(dh & 3) * 64 + dd]; }
}

__device__ __forceinline__ void gate_cum16(const bf16x8 (&a)[2][2], const bf16x8 wb, float ba, int dir, int lane, float (&r)[2][8], float& bend) {
    const int fq = lane >> 4, dl = lane & 15;
#pragma unroll
    for (int h2 = 0; h2 < 2; ++h2)
#pragma unroll
        for (int t = 0; t < 2; ++t) { const f32x4 z = __builtin_amdgcn_mfma_f32_16x16x32_bf16(a[h2][t], wb, (f32x4){0.f, 0.f, 0.f, 0.f}, 0, 0, 0);
#pragma unroll
            for (int q = 0; q < 4; ++q) r[h2][4 * t + q] = logsig16(z[q] + ba); }
    if (dir == 0) {
#pragma unroll
        for (int h2 = 0; h2 < 2; ++h2)
#pragma unroll
            for (int i = 1; i < 8; ++i) r[h2][i] += r[h2][i - 1];
    } else {
#pragma unroll
        for (int h2 = 0; h2 < 2; ++h2)
#pragma unroll
            for (int i = 6; i >= 0; --i) r[h2][i] += r[h2][i + 1];
    }
    const float T0 = dir ? r[0][0] : r[0][7], T1 = dir ? r[1][0] : r[1][7];
    float t0[4], t1[4];
#pragma unroll
    for (int k = 0; k < 4; ++k) { t0[k] = __shfl(T0, dl + 16 * k); t1[k] = __shfl(T1, dl + 16 * k); }
    const float s0 = (t0[0] + t0[1]) + (t0[2] + t0[3]), s1 = (t1[0] + t1[1]) + (t1[2] + t1[3]);
    float o0 = 0.f, o1 = 0.f;
#pragma unroll
    for (int k = 0; k < 4; ++k) { const bool in = dir ? (k > fq) : (k < fq); o0 += in ? t0[k] : 0.f; o1 += in ? t1[k] : 0.f; }
    if (dir == 0) o1 += s0; else o0 += s1;
    bend = s0 + s1;
#pragma unroll
    for (int i = 0; i < 8; ++i) { r[0][i] += o0; r[1][i] += o1; }
}

__device__ __forceinline__ void ph3_gla_kv(const Frame& F) {
    float* KF = (float*)F.lds;
    bf16* KETF = (bf16*)(KF + 64 * 68);
    bf16* KETB = KETF + 64 * 72;
    u32x4* WB = (u32x4*)(KETB + 64 * 72);
    float* BAS = (float*)(WB + 2048);
    const int tid = F.tid, lane = F.lane, w = F.wave;
    stage_gate_weights(F, WB, BAS);
    __syncthreads();
    const int c = tid >> 3, dc = tid & 7, pdc = rope_partner(dc), fr = lane & 15, fq = lane >> 4;
    auto geom = [&](int it, int& h, int& ch, int& tok0, bool& isctx, size_t& itf, size_t& itb) {
        const int n = it % NCH, bh = it / NCH; h = bh & 3; const int b = bh >> 2;
        isctx = n < 4; ch = isctx ? n : n - 4;
        tok0 = isctx ? MLAT + b * CTXL + 64 * ch : b * SEQ + 64 * ch;
        const int nb = isctx ? 3 - n : 4 + (127 - ch);
        itf = (size_t)(bh * 2) * NCH + n; itb = (size_t)(bh * 2 + 1) * NCH + nb;
    };
    const int gdir = w >> 2, gdt = w & 3, gd = 16 * gdt + fr, gkap = 8 * (fr >> 2) + (fr & 3);
    u32x4 pkm, pkp; RopeCS pcs; bf16x8 pbv[2], pga[2][2];
    auto issue_a = [&](int it) { int h, ch, tok0; bool isctx; size_t itf, itb; geom(it, h, ch, tok0, isctx, itf, itb);
        pkm = *(const u32x4*)(F.P1 + p1_off(tok0 + c, CGK + h * 64 + 8 * dc)); pkp = *(const u32x4*)(F.P1 + p1_off(tok0 + c, CGK + h * 64 + 8 * pdc));
#pragma unroll
        for (int h2 = 0; h2 < 2; ++h2)
#pragma unroll
            for (int t = 0; t < 2; ++t) pga[h2][t] = *(const bf16x8*)(F.P1 + p1_off(tok0 + 32 * h2 + gkap + 4 * t, CAF + 16 * gdir + 8 * (fq & 1)));
        rope_cs_issue(F.ROPE, dc, ch, c, pcs); };
    auto issue_c = [&](int it) { int h, ch, tok0; bool isctx; size_t itf, itb; geom(it, h, ch, tok0, isctx, itf, itb);
        pbv[0] = *(const bf16x8*)(F.VT + vt_off(512 + h * 128 + 16 * w + fr, tok0 + 8 * fq)); pbv[1] = *(const bf16x8*)(F.VT + vt_off(512 + h * 128 + 16 * w + fr, tok0 + 32 + 8 * fq)); };
    const int NIT = 32 * NCH;
    if ((int)blockIdx.x < NIT) { issue_a(blockIdx.x); issue_c(blockIdx.x); }
    for (int it = blockIdx.x; it < NIT; it += F.G) {
        int h, ch, tok0; bool isctx; size_t itf, itb; geom(it, h, ch, tok0, isctx, itf, itb);
        const int itn = (it + F.G < NIT) ? it + F.G : it;
        float gr_[2][8], bend;
        {
            float k8[8];
            rope_apply(pkm, pkp, pcs, dc, !isctx, k8);
            *(f32x4*)(KF + c * 68 + 8 * dc) = (f32x4){k8[0], k8[1], k8[2], k8[3]}; *(f32x4*)(KF + c * 68 + 8 * dc + 4) = (f32x4){k8[4], k8[5], k8[6], k8[7]};
            const bf16x8 zero = (bf16x8){0, 0, 0, 0, 0, 0, 0, 0};
            bf16x8 ga[2][2];
#pragma unroll
            for (int h2 = 0; h2 < 2; ++h2)
#pragma unroll
                for (int t = 0; t < 2; ++t) ga[h2][t] = (fq < 2) ? pga[h2][t] : zero;
            issue_a(itn);
            const bf16x8 wb = __builtin_bit_cast(bf16x8, WB[((gdir * 4 + h) * 4 + gdt) * 64 + lane]); const float ba = BAS[(gdir * 4 + h) * 64 + gd];
            gate_cum16(ga, wb, ba, gdir, lane, gr_, bend);
        }
        __syncthreads();
        {
            bf16* KET = gdir ? KETB : KETF;
#pragma unroll
            for (int h2 = 0; h2 < 2; ++h2) { float ke[8];
#pragma unroll
                for (int i = 0; i < 8; ++i) ke[i] = KF[(32 * h2 + 8 * fq + i) * 68 + gd] * __expf(bend - gr_[h2][i]);
                u32x4 o; o.x = pk2(ke[0], ke[1]); o.y = pk2(ke[2], ke[3]); o.z = pk2(ke[4], ke[5]); o.w = pk2(ke[6], ke[7]);
                *(u32x4*)(KET + gd * 72 + 32 * h2 + 8 * fq) = o; }
            if (fq == 0) F.DEC[(gdir ? itb : itf) * 64 + gd] = __expf(bend);
        }
        __syncthreads();
        {
            const bf16x8 bv0 = pbv[0], bv1 = pbv[1];
            bf16* dstf = F.KV + (itf * 128 + 16 * w + fr) * 64 + 8 * fq; bf16* dstb = F.KV + (itb * 128 + 16 * w + fr) * 64 + 8 * fq;
            const int kapr = 8 * (fr >> 2) + (fr & 3);
#pragma unroll
            for (int p = 0; p < 2; ++p) { f32x4 af_[2], ab_[2];
#pragma unroll
                for (int t = 0; t < 2; ++t) { const int row = 32 * p + kapr + 4 * t; f32x4 accf = (f32x4){0.f, 0.f, 0.f, 0.f}, accb = accf;
                    const bf16x8 af0 = *(const bf16x8*)(KETF + row * 72 + 8 * fq), af1 = *(const bf16x8*)(KETF + row * 72 + 32 + 8 * fq);
                    const bf16x8 ab0 = *(const bf16x8*)(KETB + row * 72 + 8 * fq), ab1 = *(const bf16x8*)(KETB + row * 72 + 32 + 8 * fq);
                    accf = __builtin_amdgcn_mfma_f32_16x16x32_bf16(af0, bv0, accf, 0, 0, 0); accb = __builtin_amdgcn_mfma_f32_16x16x32_bf16(ab0, bv0, accb, 0, 0, 0);
                    accf = __builtin_amdgcn_mfma_f32_16x16x32_bf16(af1, bv1, accf, 0, 0, 0); accb = __builtin_amdgcn_mfma_f32_16x16x32_bf16(ab1, bv1, accb, 0, 0, 0);
                    af_[t] = accf; ab_[t] = accb; }
                u32x4 o; o.x = pk2(af_[0][0], af_[0][1]); o.y = pk2(af_[0][2], af_[0][3]); o.z = pk2(af_[1][0], af_[1][1]); o.w = pk2(af_[1][2], af_[1][3]); *(u32x4*)(dstf + 32 * p) = o;
                o.x = pk2(ab_[0][0], ab_[0][1]); o.y = pk2(ab_[0][2], ab_[0][3]); o.z = pk2(ab_[1][0], ab_[1][1]); o.w = pk2(ab_[1][2], ab_[1][3]); *(u32x4*)(dstb + 32 * p) = o; }
            issue_c(itn);
        }
    }
    __syncthreads();
}

__device__ __forceinline__ void ph4_gla_scan(const Frame& F) {
    constexpr int UB = 12;
    for (int idx = blockIdx.x * NTHREADS + F.tid; idx < 64 * 2048; idx += F.G * NTHREADS) {
        const int seq = idx >> 11, within = idx & 2047, e = within >> 4, d = 4 * (within & 15);
        bf16* p = F.KV + ((size_t)seq * NCH * 128 + e) * 64 + d; const float* dp = F.DEC + (size_t)seq * NCH * 64 + d;
        float s0 = 0.f, s1 = 0.f, s2 = 0.f, s3 = 0.f;
        for (int n0 = 0; n0 < NCH; n0 += UB) {
            u32x2 kv[UB]; f32x4 dc[UB];
#pragma unroll
            for (int u = 0; u < UB; ++u) { kv[u] = *(const u32x2*)(p + (size_t)(n0 + u) * 128 * 64); dc[u] = *(const f32x4*)(dp + (n0 + u) * 64); }
#pragma unroll
            for (int u = 0; u < UB; ++u) {
                u32x2 o; o.x = pk2(s0, s1); o.y = pk2(s2, s3); *(u32x2*)(p + (size_t)(n0 + u) * 128 * 64) = o;
                s0 = dc[u][0] * s0 + bflo(kv[u].x); s1 = dc[u][1] * s1 + bfhi(kv[u].x); s2 = dc[u][2] * s2 + bflo(kv[u].y); s3 = dc[u][3] * s3 + bfhi(kv[u].y); }
        }
    }
}

__device__ __forceinline__ void ph5_gla_out(const Frame& F) {
    float* BCF = (float*)F.lds;
    float* BCB = BCF + 64 * 68;
    float* SS = BCB + 64 * 68;
    bf16* QDF = (bf16*)(SS + 512);
    bf16* KIF = QDF + 64 * 72;
    bf16* QDB = KIF + 64 * 72;
    bf16* KIB = QDB + 64 * 72;
    bf16* AT = KIB + 64 * 72;
    u32x4* WB = (u32x4*)(AT + 64 * 72);
    float* BAS = (float*)(WB + 2048);
    float* GN = BAS + 512;
    const int tid = F.tid, lane = F.lane, w = F.wave, fr = lane & 15, fq = lane >> 4;
    stage_gate_weights(F, WB, BAS);
    GN[tid] = F.gla_norm[tid];
    __syncthreads();
    const int c = tid >> 3, dc = tid & 7, pdc = rope_partner(dc);
    const int gdir = w >> 2, gdt = w & 3, gd = 16 * gdt + fr, gkap = 8 * (fr >> 2) + (fr & 3);
    u32x4 pqm, pqp, pkm, pkp; RopeCS pcs; u32x2 pgr[4]; bf16x8 pav[2], pasf[2], pasb[2], pga[2][2];
    auto issue_a = [&](int it) { const int j = it & 127, h = (it >> 7) & 3, b = it >> 9; const int tok0 = b * SEQ + 64 * j;
        pqm = *(const u32x4*)(F.P1 + p1_off(tok0 + c, CGQ + h * 64 + 8 * dc)); pqp = *(const u32x4*)(F.P1 + p1_off(tok0 + c, CGQ + h * 64 + 8 * pdc));
        pkm = *(const u32x4*)(F.P1 + p1_off(tok0 + c, CGK + h * 64 + 8 * dc)); pkp = *(const u32x4*)(F.P1 + p1_off(tok0 + c, CGK + h * 64 + 8 * pdc));
#pragma unroll
        for (int h2 = 0; h2 < 2; ++h2)
#pragma unroll
            for (int t = 0; t < 2; ++t) pga[h2][t] = *(const bf16x8*)(F.P1 + p1_off(tok0 + 32 * h2 + gkap + 4 * t, CAF + 16 * gdir + 8 * (fq & 1)));
        rope_cs_issue(F.ROPE, dc, j, c, pcs);
#pragma unroll
        for (int ct = 0; ct < 4; ++ct) pgr[ct] = *(const u32x2*)(F.P1 + p1_off(tok0 + 16 * ct + fr, CGR + h * 128 + 16 * w + 4 * fq)); };
    auto issue_e = [&](int it) { const int j = it & 127, h = (it >> 7) & 3, b = it >> 9; const int tok0 = b * SEQ + 64 * j;
        const int seqf = (b * 4 + h) * 2, seqb = seqf + 1;
        const bf16* vrow = F.VT + vt_off(512 + h * 128 + 16 * w + fr, tok0 + 8 * fq); const bf16* vrow1 = F.VT + vt_off(512 + h * 128 + 16 * w + fr, tok0 + 32 + 8 * fq);
        const bf16* sfp = F.KV + (((size_t)seqf * NCH + 4 + j) * 128 + 16 * w + fr) * 64 + 8 * fq;
        const bf16* sbp = F.KV + (((size_t)seqb * NCH + 4 + (127 - j)) * 128 + 16 * w + fr) * 64 + 8 * fq;
        pav[0] = *(const bf16x8*)vrow; pav[1] = *(const bf16x8*)vrow1; pasf[0] = *(const bf16x8*)sfp; pasf[1] = *(const bf16x8*)(sfp + 32); pasb[0] = *(const bf16x8*)sbp; pasb[1] = *(const bf16x8*)(sbp + 32); };
    const int NIT = NB * 4 * 128;
    if ((int)blockIdx.x < NIT) { issue_a(blockIdx.x); issue_e(blockIdx.x); }
    for (int it = blockIdx.x; it < NIT; it += F.G) {
        const int j = it & 127, h = (it >> 7) & 3, b = it >> 9;
        const int tok0 = b * SEQ + 64 * j;
        const int itn = (it + F.G < NIT) ? it + F.G : it;
        float q8[8], k8[8]; u32x2 gr[4];
        {
            rope_apply(pqm, pqp, pcs, dc, true, q8);
            rope_apply(pkm, pkp, pcs, dc, true, k8);
#pragma unroll
            for (int ct = 0; ct < 4; ++ct) gr[ct] = pgr[ct];
            const bf16x8 zero = (bf16x8){0, 0, 0, 0, 0, 0, 0, 0};
            bf16x8 ga[2][2];
#pragma unroll
            for (int h2 = 0; h2 < 2; ++h2)
#pragma unroll
                for (int t = 0; t < 2; ++t) ga[h2][t] = (fq < 2) ? pga[h2][t] : zero;
            issue_a(itn);
            const bf16x8 wb = __builtin_bit_cast(bf16x8, WB[((gdir * 4 + h) * 4 + gdt) * 64 + lane]); const float ba = BAS[(gdir * 4 + h) * 64 + gd];
            float r[2][8], bend; gate_cum16(ga, wb, ba, gdir, lane, r, bend);
            float* BC = gdir ? BCB : BCF;
#pragma unroll
            for (int h2 = 0; h2 < 2; ++h2)
#pragma unroll
                for (int i = 0; i < 8; ++i) BC[(32 * h2 + 8 * fq + i) * 68 + gd] = r[h2][i];
        }
        __syncthreads();
        {
            const f32x4 f0 = *(const f32x4*)(BCF + c * 68 + 8 * dc), f1 = *(const f32x4*)(BCF + c * 68 + 8 * dc + 4), b0 = *(const f32x4*)(BCB + c * 68 + 8 * dc), b1 = *(const f32x4*)(BCB + c * 68 + 8 * dc + 4);
            const float bf[8] = {f0[0], f0[1], f0[2], f0[3], f1[0], f1[1], f1[2], f1[3]}, bb[8] = {b0[0], b0[1], b0[2], b0[3], b1[0], b1[1], b1[2], b1[3]};
            float qf[8], kf[8], qb[8], kb[8];
#pragma unroll
            for (int i = 0; i < 8; ++i) { qf[i] = q8[i] * __expf(bf[i]) * 0.125f; kf[i] = k8[i] * __expf(-bf[i]); qb[i] = q8[i] * __expf(bb[i]) * 0.125f; kb[i] = k8[i] * __expf(-bb[i]); }
            u32x4 o;
            o.x = pk2(qf[0], qf[1]); o.y = pk2(qf[2], qf[3]); o.z = pk2(qf[4], qf[5]); o.w = pk2(qf[6], qf[7]); *(u32x4*)(QDF + c * 72 + 8 * dc) = o;
            o.x = pk2(kf[0], kf[1]); o.y = pk2(kf[2], kf[3]); o.z = pk2(kf[4], kf[5]); o.w = pk2(kf[6], kf[7]); *(u32x4*)(KIF + c * 72 + 8 * dc) = o;
            o.x = pk2(qb[0], qb[1]); o.y = pk2(qb[2], qb[3]); o.z = pk2(qb[4], qb[5]); o.w = pk2(qb[6], qb[7]); *(u32x4*)(QDB + c * 72 + 8 * dc) = o;
            o.x = pk2(kb[0], kb[1]); o.y = pk2(kb[2], kb[3]); o.z = pk2(kb[4], kb[5]); o.w = pk2(kb[6], kb[7]); *(u32x4*)(KIB + c * 72 + 8 * dc) = o;
        }
        __syncthreads();
        {
            const int ct = w & 3, sp = w >> 2;
            const bf16x8 bqf0 = *(const bf16x8*)(QDF + (16 * ct + fr) * 72 + 8 * fq), bqf1 = *(const bf16x8*)(QDF + (16 * ct + fr) * 72 + 32 + 8 * fq);
            const bf16x8 bqb0 = *(const bf16x8*)(QDB + (16 * ct + fr) * 72 + 8 * fq), bqb1 = *(const bf16x8*)(QDB + (16 * ct + fr) * 72 + 32 + 8 * fq);
#pragma unroll
            for (int t = 0; t < 2; ++t) { const int st = 2 * sp + t;
                f32x4 af = (f32x4){0.f, 0.f, 0.f, 0.f}, ab = af;
                af = __builtin_amdgcn_mfma_f32_16x16x32_bf16(*(const bf16x8*)(KIF + (16 * st + fr) * 72 + 8 * fq), bqf0, af, 0, 0, 0);
                af = __builtin_amdgcn_mfma_f32_16x16x32_bf16(*(const bf16x8*)(KIF + (16 * st + fr) * 72 + 32 + 8 * fq), bqf1, af, 0, 0, 0);
                ab = __builtin_amdgcn_mfma_f32_16x16x32_bf16(*(const bf16x8*)(KIB + (16 * st + fr) * 72 + 8 * fq), bqb0, ab, 0, 0, 0);
                ab = __builtin_amdgcn_mfma_f32_16x16x32_bf16(*(const bf16x8*)(KIB + (16 * st + fr) * 72 + 32 + 8 * fq), bqb1, ab, 0, 0, 0);
                const int cc = 16 * ct + fr, s0 = 16 * st + 4 * fq; float tt[4];
#pragma unroll
                for (int r = 0; r < 4; ++r) { const int s = s0 + r; tt[r] = (s <= cc ? af[r] : 0.f) + (s >= cc ? ab[r] : 0.f); }
                u32x2 o; o.x = pk2(tt[0], tt[1]); o.y = pk2(tt[2], tt[3]); *(u32x2*)(AT + cc * 72 + s0) = o; }
        }
        __syncthreads();
        f32x4 o4[4];
        {
#pragma unroll
            for (int ct = 0; ct < 4; ++ct) { f32x4 acc = (f32x4){0.f, 0.f, 0.f, 0.f};
#pragma unroll
                for (int ks = 0; ks < 2; ++ks) {
                    acc = __builtin_amdgcn_mfma_f32_16x16x32_bf16(pav[ks], *(const bf16x8*)(AT + (16 * ct + fr) * 72 + 32 * ks + 8 * fq), acc, 0, 0, 0);
                    acc = __builtin_amdgcn_mfma_f32_16x16x32_bf16(pasf[ks], *(const bf16x8*)(QDF + (16 * ct + fr) * 72 + 32 * ks + 8 * fq), acc, 0, 0, 0);
                    acc = __builtin_amdgcn_mfma_f32_16x16x32_bf16(pasb[ks], *(const bf16x8*)(QDB + (16 * ct + fr) * 72 + 32 * ks + 8 * fq), acc, 0, 0, 0); }
                o4[ct] = acc;
                float p = (acc[0] * acc[0] + acc[1] * acc[1]) + (acc[2] * acc[2] + acc[3] * acc[3]); p += __shfl_xor(p, 16); p += __shfl_xor(p, 32);
                if (fq == 0) SS[w * 64 + 16 * ct + fr] = p; }
            issue_e(itn);
        }
        __syncthreads();
        {
            const f32x4 gn = *(const f32x4*)(GN + h * 128 + 16 * w + 4 * fq);
#pragma unroll
            for (int ct = 0; ct < 4; ++ct) { const int cc = 16 * ct + fr; float tot = 0.f;
#pragma unroll
                for (int w2 = 0; w2 < 8; ++w2) tot += SS[w2 * 64 + cc];
                const float rs = 1.0f / sqrtf(tot * (1.0f / 128.0f) + EPS);
                const float g[4] = {bflo(gr[ct].x), bfhi(gr[ct].x), bflo(gr[ct].y), bfhi(gr[ct].y)}; float y[4];
#pragma unroll
                for (int r = 0; r < 4; ++r) y[r] = o4[ct][r] * rs * gn[r] * (g[r] * __builtin_amdgcn_rcpf(1.0f + __expf(-g[r])));
                u32x2 o; o.x = pk2(y[0], y[1]); o.y = pk2(y[2], y[3]); *(u32x2*)(F.MIX + (size_t)(tok0 + cc) * DM + 512 + h * 128 + 16 * w + 4 * fq) = o; }
        }
        __syncthreads();
    }
}

__device__ __forceinline__ void ph5_na(const Frame& F) {
    constexpr int NT = 4;
    constexpr float LOG2E = 1.4426950408889634f, QS = 0.125f * LOG2E;
    bf16* CKs = (bf16*)F.lds;
    bf16* CVs = CKs + 256 * 72;
    float* RPB = (float*)(CVs + 64 * 264);
    bf16* QSw = (bf16*)(RPB + 468) + F.wave * (4 * 16 * 64);
    const int tid = F.tid, lane = F.lane, w = F.wave, qi = lane & 15, fq = lane >> 4;
    const int j = w & 3, sub = w >> 2;
    const int c = 16 * j + qi;
    const int kc0 = (j == 0) ? 0 : (j == 1) ? 8 : (j == 2) ? 24 : 32;
    const int cs = (c - 8 < 0) ? 0 : (c - 8 > 48 ? 48 : c - 8);
    const int kap = 8 * (qi >> 2) + (qi & 3);
    unsigned cmask = 0;
#pragma unroll
    for (int e = 0; e < 8; ++e) { const int kc = kc0 + 8 * fq + e; if (kc >= cs && kc < cs + 16) cmask |= 1u << e; }
    const int dc0 = kc0 + 8 * fq - c + 15;
    int dcc[8];
#pragma unroll
    for (int e = 0; e < 8; ++e) { const int t = dc0 + e; dcc[e] = t < 0 ? 0 : (t > 30 ? 30 : t); }
    const float NEG_INF = -__builtin_inff();
    const int ipw = (1024 + F.G - 1) / F.G;
    int cur_bh = -1;
    for (int it = blockIdx.x * ipw; it < (blockIdx.x + 1) * ipw && it < 1024; ++it) {
        const int rg = it & 15, bh = it >> 4, head = bh & 7, b = bh >> 3;
        if (bh != cur_bh) {
            cur_bh = bh;
            __syncthreads();
            { const int row = tid >> 1, hf = tid & 1; const bf16* src = F.P1 + p1_off(MLAT + b * CTXL + row, CK + head * 64 + 32 * hf);
              u32x4 v0 = *(const u32x4*)src, v1 = *(const u32x4*)(src + 8), v2 = *(const u32x4*)(src + 16), v3 = *(const u32x4*)(src + 24);
              bf16* dst = CKs + row * 72 + 32 * hf; *(u32x4*)dst = v0; *(u32x4*)(dst + 8) = v1; *(u32x4*)(dst + 16) = v2; *(u32x4*)(dst + 24) = v3; }
            { const int row = tid >> 3, sg = tid & 7; const int t0 = MLAT + b * CTXL + 32 * sg;
              u32x4 v0 = *(const u32x4*)(F.VT + vt_off(head * 64 + row, t0)), v1 = *(const u32x4*)(F.VT + vt_off(head * 64 + row, t0 + 8)), v2 = *(const u32x4*)(F.VT + vt_off(head * 64 + row, t0 + 16)), v3 = *(const u32x4*)(F.VT + vt_off(head * 64 + row, t0 + 24));
              bf16* dst = CVs + row * 264 + 32 * sg; *(u32x4*)dst = v0; *(u32x4*)(dst + 8) = v1; *(u32x4*)(dst + 16) = v2; *(u32x4*)(dst + 24) = v3; }
            if (tid < 465) RPB[tid] = F.rpb[head * 465 + tid] * LOG2E;
            __syncthreads();
        }
        const int rA = 8 * rg + 4 * sub;
        {
            bf16x8 qt[NT][2];
#pragma unroll
            for (int nt = 0; nt < NT; ++nt) { const bf16* qp = F.P1 + p1_off(b * SEQ + (rA + nt) * 64 + c, CQ + head * 64 + 8 * fq); qt[nt][0] = *(const bf16x8*)qp; qt[nt][1] = *(const bf16x8*)(qp + 32); }
#pragma unroll
            for (int nt = 0; nt < NT; ++nt)
#pragma unroll
                for (int ks = 0; ks < 2; ++ks) *(bf16x8*)(QSw + (nt * 16 + qi) * 64 + 8 * ((4 * ks + fq) ^ (qi & 7))) = qt[nt][ks];
        }
        float m[NT], l[NT]; f32x4 O[4][NT];
#pragma unroll
        for (int nt = 0; nt < NT; ++nt) { m[nt] = NEG_INF; l[nt] = 0.f;
#pragma unroll
            for (int dt = 0; dt < 4; ++dt) O[dt][nt] = (f32x4){0.f, 0.f, 0.f, 0.f}; }
        auto na_tile = [&](int nt, bool local, int kr, const bf16x8 (&kf)[2][2], const bf16x8 (&vf)[4]) {
            const int r = rA + nt;
            const bf16x8 q0 = *(const bf16x8*)(QSw + (nt * 16 + qi) * 64 + 8 * (fq ^ (qi & 7))), q1 = *(const bf16x8*)(QSw + (nt * 16 + qi) * 64 + 8 * ((4 + fq) ^ (qi & 7)));
            f32x4 s0 = (f32x4){0.f, 0.f, 0.f, 0.f}, s1 = s0;
            s0 = __builtin_amdgcn_mfma_f32_16x16x32_bf16(kf[0][0], q0, s0, 0, 0, 0); s0 = __builtin_amdgcn_mfma_f32_16x16x32_bf16(kf[0][1], q1, s0, 0, 0, 0);
            s1 = __builtin_amdgcn_mfma_f32_16x16x32_bf16(kf[1][0], q0, s1, 0, 0, 0); s1 = __builtin_amdgcn_mfma_f32_16x16x32_bf16(kf[1][1], q1, s1, 0, 0, 0);
            float sc[8];
            if (local) { const float* rp = RPB + (kr - r + 7) * 31; float bias[8];
#pragma unroll
                for (int e = 0; e < 8; ++e) bias[e] = rp[dcc[e]];
#pragma unroll
                for (int e = 0; e < 8; ++e) { const float a = (e < 4) ? s0[e & 3] : s1[e & 3]; sc[e] = ((cmask >> e) & 1u) ? a * QS + bias[e] : NEG_INF; }
            } else {
#pragma unroll
                for (int e = 0; e < 8; ++e) { const float a = (e < 4) ? s0[e & 3] : s1[e & 3]; sc[e] = a * QS; }
            }
            const float lmax = fmaxf(fmaxf(fmaxf(sc[0], sc[1]), fmaxf(sc[2], sc[3])), fmaxf(fmaxf(sc[4], sc[5]), fmaxf(sc[6], sc[7])));
            if (!__all(lmax <= m[nt] + 11.0f)) {
                float mx = fmaxf(lmax, __shfl_xor(lmax, 16)); mx = fmaxf(mx, __shfl_xor(mx, 32));
                const float mn = fmaxf(m[nt], mx), alpha = __builtin_amdgcn_exp2f(m[nt] - mn); m[nt] = mn; l[nt] *= alpha;
#pragma unroll
                for (int dt = 0; dt < 4; ++dt) O[dt][nt] = O[dt][nt] * alpha; }
            const float mn = m[nt];
            float p[8], ps = 0.f;
#pragma unroll
            for (int e = 0; e < 8; ++e) { p[e] = __builtin_amdgcn_exp2f(sc[e] - mn); ps += p[e]; }
            l[nt] += ps;
            u32x4 pw; pw.x = pk2(p[0], p[1]); pw.y = pk2(p[2], p[3]); pw.z = pk2(p[4], p[5]); pw.w = pk2(p[6], p[7]);
            const bf16x8 pf = __builtin_bit_cast(bf16x8, pw);
#pragma unroll
            for (int dt = 0; dt < 4; ++dt) O[dt][nt] = __builtin_amdgcn_mfma_f32_16x16x32_bf16(vf[dt], pf, O[dt][nt], 0, 0, 0);
            __builtin_amdgcn_sched_barrier(0);
        };
#pragma unroll 1
        for (int s = 0; s < 8; ++s) {
            bf16x8 kf[2][2], vf[4];
#pragma unroll
            for (int t = 0; t < 2; ++t) { const bf16* kp = CKs + (32 * s + kap + 4 * t) * 72 + 8 * fq; kf[t][0] = *(const bf16x8*)kp; kf[t][1] = *(const bf16x8*)(kp + 32); }
#pragma unroll
            for (int dt = 0; dt < 4; ++dt) vf[dt] = *(const bf16x8*)(CVs + (dt * 16 + qi) * 264 + 32 * s + 8 * fq);
#pragma unroll
            for (int nt = 0; nt < NT; ++nt) na_tile(nt, false, 0, kf, vf);
        }
        const int rsA = (rA - 4 < 0) ? 0 : (rA - 4 > 120 ? 120 : rA - 4);
        const int rlast = rA + NT - 1; const int rsB = (rlast - 4 < 0) ? 0 : (rlast - 4 > 120 ? 120 : rlast - 4);
        const int nloc = rsB + 8 - rsA, slast = nloc - 1;
        auto na_loadk = [&](int s, bf16x8 (&kf)[2][2]) {
            const int base_tok = b * SEQ + (rsA + s) * 64 + kc0;
#pragma unroll
            for (int t = 0; t < 2; ++t) { const bf16* kp = F.P1 + p1_off(base_tok + kap + 4 * t, CK + head * 64 + 8 * fq); kf[t][0] = *(const bf16x8*)kp; kf[t][1] = *(const bf16x8*)(kp + 32); }
        };
        auto na_step = [&](int s, const bf16x8 (&kf)[2][2]) {
            const int kr = rsA + s; const int base_tok = b * SEQ + kr * 64 + kc0;
            bf16x8 vf[4];
#pragma unroll
            for (int dt = 0; dt < 4; ++dt) vf[dt] = *(const bf16x8*)(F.VT + vt_off(head * 64 + dt * 16 + qi, base_tok + 8 * fq));
#pragma unroll
            for (int nt = 0; nt < NT; ++nt) {
                const int r = rA + nt; const int rs = (r - 4 < 0) ? 0 : (r - 4 > 120 ? 120 : r - 4);
                if (kr < rs || kr >= rs + 8) continue;
                na_tile(nt, true, kr, kf, vf);
            }
        };
        bf16x8 kfA[2][2], kfB[2][2];
        na_loadk(0, kfA);
        for (int s = 0; s < slast; s += 2) {
            na_loadk(s + 1, kfB);
            na_step(s, kfA);
            na_loadk((s + 2 < slast) ? s + 2 : slast, kfA);
            na_step(s + 1, kfB);
        }
        if (nloc & 1) na_step(slast, kfA);
#pragma unroll
        for (int nt = 0; nt < NT; ++nt) { float lt = l[nt]; lt += __shfl_xor(lt, 16); lt += __shfl_xor(lt, 32); const float inv = 1.0f / lt;
            bf16* op = F.MIX + (size_t)(b * SEQ + (rA + nt) * 64 + c) * DM + head * 64 + 4 * fq;
#pragma unroll
            for (int dt = 0; dt < 4; ++dt) { const f32x4 o = O[dt][nt] * inv; u32x2 ow; ow.x = pk2(o[0], o[1]); ow.y = pk2(o[2], o[3]); *(u32x2*)(op + 16 * dt) = ow; } }
    }
    __syncthreads();
}

__device__ __forceinline__ void ph7_mid(const Frame& F) {
    const int gw = blockIdx.x * 8 + F.wave, NGW = F.G * 8;
    int curb = -1; f32x4 c1[4], cA[4], cB[4];
#pragma unroll
    for (int j = 0; j < 4; ++j) { c1[j] = (f32x4){0.f, 0.f, 0.f, 0.f}; cA[j] = c1[j]; cB[j] = c1[j]; }
    for (int row0 = gw; row0 < MLAT; row0 += 2 * NGW) {
        const int nr = (row0 + NGW < MLAT) ? 2 : 1;
        f32x4 v[2][4]; u32x2 yw[2][4]; float sqp[2];
#pragma unroll
        for (int q = 0; q < 2; ++q) { const int row = (q < nr) ? row0 + q * NGW : row0;
#pragma unroll
            for (int j = 0; j < 4; ++j) { v[q][j] = __builtin_nontemporal_load((const f32x4*)(F.x + (size_t)row * DM) + F.lane + 64 * j); yw[q][j] = *((const u32x2*)(F.Y + (size_t)row * DM) + F.lane + 64 * j); }
            sqp[q] = F.lane < 16 ? F.SSQ1[(size_t)row * 16 + F.lane] : 0.f; }
#pragma unroll
        for (int q = 0; q < 2; ++q) { if (q < nr) { const int row = row0 + q * NGW; const int b = row >> 13;
            const float sq1 = wave_sum(sqp[q]);
            if (b != curb) { curb = b;
#pragma unroll
                for (int j = 0; j < 4; ++j) { const int col = 4 * (F.lane + 64 * j); const float* mb = F.MOD + b * NMOD;
                    c1[j] = *(const f32x4*)(mb + 2 * DM + col) * *(const f32x4*)(F.g_post_mix + col);
                    cA[j] = *(const f32x4*)(F.g_pre_ffn + col) * (*(const f32x4*)(mb + 4 * DM + col) + 1.0f); cB[j] = *(const f32x4*)(mb + 3 * DM + col); } }
            const float rstd1 = 1.0f / sqrtf(sq1 * (1.0f / DM) + EPS);
            float ss = 0.f;
#pragma unroll
            for (int j = 0; j < 4; ++j) { const f32x4 y = (f32x4){bflo(yw[q][j].x), bfhi(yw[q][j].x), bflo(yw[q][j].y), bfhi(yw[q][j].y)}; v[q][j] = v[q][j] + c1[j] * (y * rstd1);
                ss += (v[q][j][0] * v[q][j][0] + v[q][j][1] * v[q][j][1]) + (v[q][j][2] * v[q][j][2] + v[q][j][3] * v[q][j][3]);
                u32x2 xw; xw.x = pk2(v[q][j][0], v[q][j][1]); xw.y = pk2(v[q][j][2], v[q][j][3]); *(u32x2*)(F.X1B + (size_t)row * DM + 4 * (F.lane + 64 * j)) = xw; }
            const float rstd2 = 1.0f / sqrtf(wave_sum(ss) * (1.0f / DM) + EPS);
#pragma unroll
            for (int j = 0; j < 4; ++j) { const f32x4 o = v[q][j] * rstd2 * cA[j] + cB[j]; u32x2 wv; wv.x = pk2(o[0], o[1]); wv.y = pk2(o[2], o[3]); *(u32x2*)(F.H + (size_t)row * DM + 4 * (F.lane + 64 * j)) = wv; } } }
    }
}
__device__ __forceinline__ void ph10_final(const Frame& F) {
    const int gw = blockIdx.x * 8 + F.wave, NGW = F.G * 8;
    int curb = -1; f32x4 c2[4];
#pragma unroll
    for (int j = 0; j < 4; ++j) c2[j] = (f32x4){0.f, 0.f, 0.f, 0.f};
    for (int row0 = gw; row0 < MLAT; row0 += 2 * NGW) {
        const int nr = (row0 + NGW < MLAT) ? 2 : 1;
        u32x2 xw[2][4], dw[2][4]; float sp2[2];
#pragma unroll
        for (int q = 0; q < 2; ++q) { const int row = (q < nr) ? row0 + q * NGW : row0;
#pragma unroll
            for (int j = 0; j < 4; ++j) { xw[q][j] = *((const u32x2*)(F.X1B + (size_t)row * DM) + F.lane + 64 * j); dw[q][j] = *((const u32x2*)(F.DOWN + (size_t)row * DM) + F.lane + 64 * j); }
            sp2[q] = F.lane < 16 ? F.SSQ2[(size_t)row * 16 + F.lane] : 0.f; }
#pragma unroll
        for (int q = 0; q < 2; ++q) { if (q < nr) { const int row = row0 + q * NGW; const int b = row >> 13;
            const float sq2 = wave_sum(sp2[q]);
            if (b != curb) { curb = b;
#pragma unroll
                for (int j = 0; j < 4; ++j) { const int col = 4 * (F.lane + 64 * j); const float* mb = F.MOD + b * NMOD; c2[j] = *(const f32x4*)(mb + 5 * DM + col) * *(const f32x4*)(F.g_post_ffn + col); } }
            const float rstd2 = 1.0f / sqrtf(sq2 * (1.0f / DM) + EPS);
#pragma unroll
            for (int j = 0; j < 4; ++j) { const f32x4 x1 = (f32x4){bflo(xw[q][j].x), bfhi(xw[q][j].x), bflo(xw[q][j].y), bfhi(xw[q][j].y)}, d = (f32x4){bflo(dw[q][j].x), bfhi(dw[q][j].x), bflo(dw[q][j].y), bfhi(dw[q][j].y)};
                const f32x4 o = x1 + c2[j] * (d * rstd2); *((f32x4*)(F.out + (size_t)row * DM) + F.lane + 64 * j) = o; } } }
    }
}

struct Args { const float* in[20]; float* out; unsigned char* ws; int ph_lo, ph_hi; };
constexpr int NPHASES = 11;

__global__ void __launch_bounds__(NTHREADS, 2) mk_fwd(Args args) {
    extern __shared__ __attribute__((aligned(16))) unsigned char lds[];
    cg::grid_group grid = cg::this_grid();
    Frame F;
    F.lds = lds; F.tid = threadIdx.x; F.lane = F.tid & 63; F.wave = __builtin_amdgcn_readfirstlane(F.tid >> 6); F.G = gridDim.x;
    F.x = args.in[0]; F.c = args.in[1]; F.ctx = args.in[2]; F.c_ctx = args.in[3]; F.w_mod = args.in[4]; F.b_mod = args.in[5]; F.g_pre_mix = args.in[6]; F.g_post_mix = args.in[7];
    F.g_pre_ffn = args.in[8]; F.g_post_ffn = args.in[9]; F.w_in = args.in[10]; F.rpb = args.in[11]; F.wa2_f = args.in[12]; F.ba_f = args.in[13]; F.wa2_b = args.in[14]; F.ba_b = args.in[15];
    F.gla_norm = args.in[16]; F.w_out = args.in[17]; F.w_gu = args.in[18]; F.w_down = args.in[19]; F.out = args.out;
    unsigned char* ws = args.ws;
    F.MOD = (float*)(ws + WS_MOD); F.ROPE = (float*)(ws + WS_ROPE); F.DEC = (float*)(ws + WS_DEC); F.SSQ1 = (float*)(ws + WS_SSQ1); F.SSQ2 = (float*)(ws + WS_SSQ2);
    F.WMAIN = (bf16*)(ws + WS_WMAIN); F.WV = (bf16*)(ws + WS_WV); F.WOUT = (bf16*)(ws + WS_WOUT); F.WGU = (bf16*)(ws + WS_WGU); F.WDOWN = (bf16*)(ws + WS_WDOWN);
    F.H = (bf16*)(ws + WS_H); F.P1 = (bf16*)(ws + WS_P1); F.VT = (bf16*)(ws + WS_VT); F.KV = (bf16*)(ws + WS_KV); F.MIX = (bf16*)(ws + WS_MIX); F.Y = (bf16*)(ws + WS_Y); F.ACT = (bf16*)(ws + WS_ACT); F.DOWN = (bf16*)(ws + WS_DOWN); F.X1B = (bf16*)(ws + WS_X1B);
    PG8_LAS unsigned char* glds = (PG8_LAS unsigned char*)lds;
    const int lo = args.ph_lo, hi = args.ph_hi;
    volatile unsigned* MISC = (volatile unsigned*)(lds + LDS_BYTES - 128);
    if (F.tid < 32) MISC[F.tid] = 0u;
    __syncthreads();
    XcdBarrier xbar = xcd_barrier_post((unsigned*)(ws + WS_CTL) + 4096, MISC + 8);
#define IN(k) (lo <= (k) && (k) < hi)
#define REP(k) ((MK_REP_PHASE == (k)) ? 2 : 1)
#define SEAM(k) do { if (IN(k) && IN((k) + 1)) { if ((k) < MK_CG_SEAMS) grid.sync(); else xcd_barrier(xbar); } } while (0)

    if (IN(0)) for (int rep = 0; rep < REP(0); ++rep) ph0_mod(F);
    SEAM(0);
    if (IN(1)) for (int rep = 0; rep < REP(1); ++rep) ph1_rows(F);
    SEAM(1);
    if (IN(2)) for (int rep = 0; rep < REP(2); ++rep) {
        pg8::Gemm g1{F.H, F.WMAIN, MTOT, LDP, DM}, g2{F.WV, F.H, 1024, MTOT, DM};
        pg8::DualOrder S; S.o1.init(g1, F.G, (int)blockIdx.x); S.o2.init(g2, F.G, (int)blockIdx.x); S.G = F.G; S.c = (int)blockIdx.x;
        pg8::EpiDual E{pg8::EpiStore{F.P1, MTOT}, pg8::EpiStoreBlk{F.VT, 1024}};
        pg8::gemm_phase<pg8::EpiDual, pg8::DualOrder, true, true>(glds, g1, S, E);
    }
    SEAM(2);
    if (IN(3)) { for (int rep = 0; rep < REP(3); ++rep) ph3_gla_kv(F); for (int rep = 0; rep < REP(11); ++rep) ph5_na(F); }
    SEAM(3);
    if (IN(4)) ph4_gla_scan(F);
    if (MK_REP_PHASE == 4) { xcd_barrier(xbar); ph3_gla_kv(F); xcd_barrier(xbar); ph4_gla_scan(F); }
    SEAM(4);
    if (IN(5)) { for (int rep = 0; rep < REP(5); ++rep) ph5_gla_out(F); }
    SEAM(5);
    if (IN(6)) for (int rep = 0; rep < REP(6); ++rep) { pg8::Gemm g{F.MIX, F.WOUT, MLAT, DM, DM}; pg8::StaticOrder S; S.init(g, F.G, (int)blockIdx.x); pg8::EpiStoreSsq E{F.Y, DM, F.SSQ1};
        pg8::gemm_phase<pg8::EpiStoreSsq, pg8::StaticOrder, true, true>(glds, g, S, E); }
    SEAM(6);
    if (IN(7)) for (int rep = 0; rep < REP(7); ++rep) ph7_mid(F);
    SEAM(7);
    if (IN(8)) for (int rep = 0; rep < REP(8); ++rep) { pg8::Gemm g{F.H, F.WGU, MLAT, 2 * FFN, DM}; pg8::StaticOrder S; S.init(g, F.G, (int)blockIdx.x); pg8::EpiSwiglu E{F.ACT, FFN};
        pg8::gemm_phase<pg8::EpiSwiglu, pg8::StaticOrder, true, true>(glds, g, S, E); }
    SEAM(8);
    if (IN(9)) for (int rep = 0; rep < REP(9); ++rep) { pg8::Gemm g{F.ACT, F.WDOWN, MLAT, DM, FFN}; pg8::StaticOrder S; S.init(g, F.G, (int)blockIdx.x, 1); pg8::EpiStoreSsq E{F.DOWN, DM, F.SSQ2};
        pg8::gemm_phase<pg8::EpiStoreSsq, pg8::StaticOrder, true, true>(glds, g, S, E); }
    SEAM(9);
    if (IN(10)) for (int rep = 0; rep < REP(10); ++rep) ph10_final(F);
#undef IN
#undef SEAM
#undef REP
}

extern "C" void kernel_launch(void* const* d_in, const int* in_sizes, int n_in, void* d_out, int out_size, void* d_ws, size_t ws_size, hipStream_t stream) {
    static int grid = 0;
    if (grid == 0) {
        if (n_in != 20 || in_sizes[0] != MLAT * DM || out_size != MLAT * DM || ws_size < WS_END) { fprintf(stderr, "kernel_launch: unexpected shapes (n_in %d, in0 %d, out %d, ws %zu)\n", n_in, n_in > 0 ? in_sizes[0] : -1, out_size, ws_size); grid = -1; return; }
        int dev = 0, cus = 0, per_cu = 0;
        if (hipGetDevice(&dev) != hipSuccess || hipDeviceGetAttribute(&cus, hipDeviceAttributeMultiprocessorCount, dev) != hipSuccess) { fprintf(stderr, "kernel_launch: device query failed\n"); grid = -1; return; }
        if (hipFuncSetAttribute((const void*)mk_fwd, hipFuncAttributeMaxDynamicSharedMemorySize, LDS_BYTES) != hipSuccess) { fprintf(stderr, "kernel_launch: hipFuncSetAttribute failed\n"); grid = -1; return; }
        if (hipOccupancyMaxActiveBlocksPerMultiprocessor(&per_cu, (const void*)mk_fwd, NTHREADS, LDS_BYTES) != hipSuccess || per_cu < 1) { fprintf(stderr, "kernel_launch: occupancy query says %d blocks per CU\n", per_cu); (void)hipGetLastError(); grid = -1; return; }
        grid = cus;
    }
    if (grid < 0) return;
    if (hipMemsetAsync((char*)d_ws + WS_CTL, 0, CTL_ZERO_BYTES, stream) != hipSuccess) { fprintf(stderr, "kernel_launch: hipMemsetAsync failed\n"); return; }
    Args a{};
    for (int i = 0; i < 20; ++i) a.in[i] = (const float*)d_in[i];
    a.out = (float*)d_out; a.ws = (unsigned char*)d_ws;
#if MK_PER_PHASE
    for (int p = 0; p < NPHASES; ++p) { a.ph_lo = p; a.ph_hi = p + 1; void* kargs[] = {&a};
        hipError_t e = hipLaunchCooperativeKernel((const void*)mk_fwd, dim3(grid), dim3(NTHREADS), kargs, LDS_BYTES, stream);
        if (e != hipSuccess) { fprintf(stderr, "kernel_launch: launch of phase %d failed: %s\n", p, hipGetErrorString(e)); break; } }
#else
    a.ph_lo = 0; a.ph_hi = NPHASES; void* kargs[] = {&a};
    hipError_t e = hipLaunchCooperativeKernel((const void*)mk_fwd, dim3(grid), dim3(NTHREADS), kargs, LDS_BYTES, stream);
    if (e != hipSuccess) fprintf(stderr, "kernel_launch: cooperative launch failed: %s (grid %d)\n", hipGetErrorString(e), grid);
#endif
}
```

```cpp
#include <hip/hip_runtime.h>
#include <hip/hip_cooperative_groups.h>
#include <cstdio>
#include <cstdint>
namespace cg = cooperative_groups;

#ifndef MK_PER_PHASE
#define MK_PER_PHASE 0
#endif
#ifndef MK_REP_PHASE
#define MK_REP_PHASE -1
#endif
#ifndef MK_CG_SEAMS
#define MK_CG_SEAMS 0
#endif

namespace pg8 {
#define PG8_LAS __attribute__((address_space(3)))
typedef unsigned short bf16_t;
typedef short bf16x8 __attribute__((ext_vector_type(8)));
typedef float f32x4 __attribute__((ext_vector_type(4)));
typedef unsigned u32x4 __attribute__((ext_vector_type(4)));
constexpr int BM = 256, BK = 64, HALF = 128, HTB = HALF * BK * 2, STAGE_BYTES = 8 * HTB, NXCD = 8, WGM = 8;

__host__ __device__ __forceinline__ int lds_byte(int r, int c) { const int st = (r >> 4) * 2 + (c >> 5), rr = r & 15, cc = c & 31, ob = rr * 64 + cc * 2; return st * 1024 + (ob ^ (((ob >> 9) & 1) << 5)); }
__host__ __device__ __forceinline__ void stage_rc(int b, int& R, int& C) { const int st = b / 1024, sb = b % 1024, swz = sb ^ (((sb >> 9) & 1) << 5); R = (st >> 1) * 16 + swz / 64; C = (st & 1) * 32 + (swz % 64) / 2; }
__host__ __device__ __forceinline__ int perm32(int rho) { const int n = rho >> 4, i = rho & 15; return 8 * (i >> 2) + 4 * n + (i & 3); }

struct Unit { int pm, pn, kind; const char* a; const char* b; };
struct Gemm { const bf16_t* A; const bf16_t* Bt; int M, N, K; };

struct StaticOrder {
    int nM, nN, nwg, G, c, rev; const char* A; const char* Bt; size_t tstep;
    __host__ __device__ void init(const Gemm& g, int G_, int c_, int rev_ = 0) { nM = g.M / BM; nN = g.N / BM; nwg = nM * nN; G = G_; c = c_; rev = rev_; A = (const char*)g.A; Bt = (const char*)g.Bt; tstep = (size_t)BM * g.K * 2; }
    __host__ __device__ void map(int wgid, Unit& u) const {
        { const int q = nwg / NXCD, r = nwg % NXCD, xcd = wgid % NXCD, off = wgid / NXCD; wgid = (xcd < r ? xcd * (q + 1) : r * (q + 1) + (xcd - r) * q) + off; }
        const int nig = WGM * nN, gid = wgid / nig, fm = gid * WGM, gsz = (nM - fm) < WGM ? (nM - fm) : WGM;
        u.pm = fm + ((wgid % nig) % gsz); if (rev) u.pm = nM - 1 - u.pm; u.pn = (wgid % nig) / gsz; u.kind = 0; u.a = A + (size_t)u.pm * tstep; u.b = Bt + (size_t)u.pn * tstep;
    }
    __host__ __device__ bool next(int i, Unit& u) const { const long L = (long)i * G + c; if (L >= nwg) return false; map((int)L, u); return true; }
    __device__ __forceinline__ void a_ready(const Unit&) const {}
    __device__ __forceinline__ void done(const Unit&) const {}
};
struct DualOrder {
    StaticOrder o1, o2; int G, c;
    __host__ __device__ bool next(int i, Unit& u) const { const long L = (long)i * G + c; if (L >= o1.nwg + o2.nwg) return false;
        if (L < o1.nwg) o1.map((int)L, u); else { o2.map((int)(L - o1.nwg), u); u.kind = 1; } return true; }
    __device__ __forceinline__ void a_ready(const Unit&) const {}
    __device__ __forceinline__ void done(const Unit&) const {}
};

__device__ __forceinline__ unsigned cvt_pk_bf16(float lo, float hi) { unsigned r; asm volatile("v_cvt_pk_bf16_f32 %0, %1, %2" : "=v"(r) : "v"(lo), "v"(hi)); return r; }

struct EpiStore {
    static constexpr bool PERM = true, AFTER_DRAIN = false;
    bf16_t* O; int nrows;
    __device__ __forceinline__ void operator()(const f32x4 (&acc)[2][2][4][2], const Unit& u, int wr, int wc, int fr, int fq) const {
        const int row0 = u.pm * BM + wr * 64 + fr, col0 = wc * 32 + 8 * fq; bf16_t* blk = O + (size_t)u.pn * nrows * 256;
#pragma unroll
        for (int ai = 0; ai < 2; ++ai)
#pragma unroll
            for (int m = 0; m < 4; ++m) { bf16_t* rowp = blk + (size_t)(row0 + ai * HALF + m * 16) * 256 + col0;
#pragma unroll
                for (int bj = 0; bj < 2; ++bj) { const f32x4 v0 = acc[ai][bj][m][0], v1 = acc[ai][bj][m][1];
                    u32x4 w; w.x = cvt_pk_bf16(v0[0], v0[1]); w.y = cvt_pk_bf16(v0[2], v0[3]); w.z = cvt_pk_bf16(v1[0], v1[1]); w.w = cvt_pk_bf16(v1[2], v1[3]);
                    *(u32x4*)(rowp + bj * HALF) = w; } }
    }
};
struct EpiStoreBlk {
    static constexpr bool PERM = true, AFTER_DRAIN = false;
    bf16_t* O; int nrows;
    __device__ __forceinline__ void operator()(const f32x4 (&acc)[2][2][4][2], const Unit& u, int wr, int wc, int fr, int fq) const {
        const int row0 = u.pm * BM + wr * 64 + fr;
#pragma unroll
        for (int ai = 0; ai < 2; ++ai)
#pragma unroll
            for (int m = 0; m < 4; ++m) { const int r = row0 + ai * HALF + m * 16;
#pragma unroll
                for (int bj = 0; bj < 2; ++bj) { const f32x4 v0 = acc[ai][bj][m][0], v1 = acc[ai][bj][m][1];
                    u32x4 w; w.x = cvt_pk_bf16(v0[0], v0[1]); w.y = cvt_pk_bf16(v0[2], v0[3]); w.z = cvt_pk_bf16(v1[0], v1[1]); w.w = cvt_pk_bf16(v1[2], v1[3]);
                    const int g32 = u.pn * 8 + bj * 4 + wc;
                    *(u32x4*)(O + ((size_t)g32 * (nrows >> 4) + (r >> 4)) * 512 + fq * 128 + (r & 15) * 8) = w; } }
    }
};
struct EpiDual {
    static constexpr bool PERM = true, AFTER_DRAIN = false;
    EpiStore e0; EpiStoreBlk e1;
    __device__ __forceinline__ void operator()(const f32x4 (&acc)[2][2][4][2], const Unit& u, int wr, int wc, int fr, int fq) const { if (u.kind == 0) e0(acc, u, wr, wc, fr, fq); else e1(acc, u, wr, wc, fr, fq); }
};
struct EpiStoreSsq {
    static constexpr bool PERM = true, AFTER_DRAIN = false;
    bf16_t* O; int ldc; float* ssq;
    __device__ __forceinline__ void operator()(const f32x4 (&acc)[2][2][4][2], const Unit& u, int wr, int wc, int fr, int fq) const {
        const int row0 = u.pm * BM + wr * 64 + fr, col0 = u.pn * BM + wc * 32 + 8 * fq;
#pragma unroll
        for (int ai = 0; ai < 2; ++ai)
#pragma unroll
            for (int m = 0; m < 4; ++m) { const int row = row0 + ai * HALF + m * 16; bf16_t* rowp = O + (size_t)row * ldc + col0; float s = 0.f;
#pragma unroll
                for (int bj = 0; bj < 2; ++bj) { const f32x4 v0 = acc[ai][bj][m][0], v1 = acc[ai][bj][m][1];
                    s += (v0[0] * v0[0] + v0[1] * v0[1]) + (v0[2] * v0[2] + v0[3] * v0[3]) + (v1[0] * v1[0] + v1[1] * v1[1]) + (v1[2] * v1[2] + v1[3] * v1[3]);
                    u32x4 w; w.x = cvt_pk_bf16(v0[0], v0[1]); w.y = cvt_pk_bf16(v0[2], v0[3]); w.z = cvt_pk_bf16(v1[0], v1[1]); w.w = cvt_pk_bf16(v1[2], v1[3]);
                    *(u32x4*)(rowp + bj * HALF) = w; }
                s += __shfl_xor(s, 16); s += __shfl_xor(s, 32);
                if (fq == 0) ssq[(size_t)row * 16 + u.pn * 4 + wc] = s; }
    }
};
struct EpiSwiglu {
    static constexpr bool PERM = true, AFTER_DRAIN = false;
    bf16_t* O; int ldc;
    __device__ __forceinline__ void operator()(const f32x4 (&acc)[2][2][4][2], const Unit& u, int wr, int wc, int fr, int fq) const {
        const int row0 = u.pm * BM + wr * 64 + fr, col0 = u.pn * HALF + wc * 32 + 8 * fq;
#pragma unroll
        for (int ai = 0; ai < 2; ++ai)
#pragma unroll
            for (int m = 0; m < 4; ++m) { bf16_t* rowp = O + (size_t)(row0 + ai * HALF + m * 16) * ldc + col0; float a[8];
#pragma unroll
                for (int n = 0; n < 2; ++n)
#pragma unroll
                    for (int i = 0; i < 4; ++i) { const float g = acc[ai][0][m][n][i], uu = acc[ai][1][m][n][i]; a[n * 4 + i] = g * __builtin_amdgcn_rcpf(1.0f + __expf(-g)) * uu; }
                u32x4 w; w.x = cvt_pk_bf16(a[0], a[1]); w.y = cvt_pk_bf16(a[2], a[3]); w.z = cvt_pk_bf16(a[4], a[5]); w.w = cvt_pk_bf16(a[6], a[7]);
                *(u32x4*)rowp = w; }
    }
};

template <class Epi, class Sched, bool ALIGN_EPI = false, bool SP2 = false>
__device__ __forceinline__ void gemm_phase(PG8_LAS unsigned char* lds, const Gemm g, const Sched& S, const Epi& E) {
    const int tid = threadIdx.x, wid = __builtin_amdgcn_readfirstlane(tid >> 6), lane = tid & 63, wr = wid >> 2, wc = wid & 3, fr = lane & 15, fq = lane >> 4;
    const int K = g.K, nt = K / BK;
    unsigned voffA[2], voffB[2];
#pragma unroll
    for (int i = 0; i < 2; ++i) { int R, C; stage_rc(tid * 16 + i * 8192, R, C); const int Rb = Epi::PERM ? ((R & ~31) + perm32(R & 31)) : R;
        voffA[i] = (unsigned)(R * K + C) * 2u; voffB[i] = (unsigned)(Rb * K + C) * 2u; }
    const size_t kstep = (size_t)(BK * 2);
    const size_t hstep = (size_t)HALF * K * 2;
    const unsigned ldsw = (unsigned)wid * 1024u;
    const int aoff = lds_byte(wr * 64 + fr, fq * 8), boff = lds_byte(wc * 32 + fr, fq * 8);
#define PG8_SA(b, h) (((b) * 2 + (h)) * HTB)
#define PG8_SB(b, h) ((4 + (b) * 2 + (h)) * HTB)
#define PG8_STAGE(bufoff, gbase, voff) do { _Pragma("unroll") for (int _i = 0; _i < 2; ++_i) \
        __builtin_amdgcn_global_load_lds((const unsigned*)((const char*)(gbase) + (voff)[_i]), (PG8_LAS unsigned*)(lds + (bufoff) + ldsw + _i * 8192), 16, 0, 0); } while (0)
#define PG8_LDA(dst, b, h) do { _Pragma("unroll") for (int m = 0; m < 4; ++m) _Pragma("unroll") for (int k = 0; k < 2; ++k) dst[m][k] = *(const PG8_LAS bf16x8*)(lds + PG8_SA(b, h) + aoff + m * 2048 + k * 1024); } while (0)
#define PG8_LDB(dst, b, h) do { _Pragma("unroll") for (int n = 0; n < 2; ++n) _Pragma("unroll") for (int k = 0; k < 2; ++k) dst[n][k] = *(const PG8_LAS bf16x8*)(lds + PG8_SB(b, h) + boff + n * 2048 + k * 1024); } while (0)
#define PG8_MMA(ai, bj, At, Bt) do { __builtin_amdgcn_s_setprio(1); _Pragma("unroll") for (int m = 0; m < 4; ++m) _Pragma("unroll") for (int n = 0; n < 2; ++n) _Pragma("unroll") for (int k = 0; k < 2; ++k) \
        acc[ai][bj][m][n] = __builtin_amdgcn_mfma_f32_16x16x32_bf16(Bt[n][k], At[m][k], acc[ai][bj][m][n], 0, 0, 0); __builtin_amdgcn_s_setprio(0); } while (0)
#define PG8_WAIT_V(n) asm volatile("s_waitcnt vmcnt(" #n ")" ::: "memory")
#define PG8_WAIT_L(n) asm volatile("s_waitcnt lgkmcnt(" #n ")" ::: "memory")
#define PG8_BAR __builtin_amdgcn_s_barrier()
#define PG8_SCHED __builtin_amdgcn_sched_barrier(0)
    Unit cur, nxt; int ui = 0;
    if (!S.next(0, cur)) return;
    f32x4 acc[2][2][4][2];
#pragma unroll
    for (int a = 0; a < 2; ++a)
#pragma unroll
        for (int b = 0; b < 2; ++b)
#pragma unroll
            for (int m = 0; m < 4; ++m)
#pragma unroll
                for (int n = 0; n < 2; ++n) acc[a][b][m][n] = (f32x4){0.f, 0.f, 0.f, 0.f};
    bf16x8 At[4][2], B0[2][2], B1[2][2];
    const char* cA = cur.a; const char* cB = cur.b;
    S.a_ready(cur);
    if constexpr (SP2) {
        PG8_STAGE(PG8_SB(0, 0), cB, voffB); PG8_STAGE(PG8_SB(0, 1), cB + hstep, voffB); PG8_STAGE(PG8_SA(0, 0), cA, voffA); PG8_STAGE(PG8_SA(0, 1), cA + hstep, voffA);
        if (wr == 1) PG8_BAR;
        PG8_WAIT_V(2); PG8_BAR;
        PG8_STAGE(PG8_SB(1, 0), cB + kstep, voffB); PG8_STAGE(PG8_SA(1, 0), cA + kstep, voffA); PG8_STAGE(PG8_SB(1, 1), cB + hstep + kstep, voffB);
        PG8_WAIT_V(6); PG8_BAR;
    } else {
        PG8_STAGE(PG8_SB(0, 0), cB, voffB); PG8_STAGE(PG8_SA(0, 0), cA, voffA); PG8_STAGE(PG8_SB(0, 1), cB + hstep, voffB); PG8_STAGE(PG8_SA(0, 1), cA + hstep, voffA);
        if (wr == 1) PG8_BAR;
        PG8_WAIT_V(4); PG8_BAR;
        PG8_STAGE(PG8_SB(1, 0), cB + kstep, voffB); PG8_STAGE(PG8_SA(1, 0), cA + kstep, voffA); PG8_STAGE(PG8_SB(1, 1), cB + hstep + kstep, voffB);
        PG8_WAIT_V(6); PG8_BAR;
    }
    for (;;) {
        const bool has_next = S.next(ui + 1, nxt);
        const char* nA = has_next ? nxt.a : cA; const char* nB = has_next ? nxt.b : cB;
        for (int t = 0; t < nt; t += 2) {
            const bool last = (t == nt - 2);
            const char* a1 = cA + (size_t)(t + 1) * kstep;
            const char* a2 = last ? nA : cA + (size_t)(t + 2) * kstep; const char* b2 = last ? nB : cB + (size_t)(t + 2) * kstep;
            const char* a3 = a2 + kstep; const char* b3 = b2 + kstep;
            if (last && has_next) S.a_ready(nxt);
            if constexpr (SP2) {
            PG8_LDB(B0, 0, 0); PG8_LDB(B1, 0, 1); PG8_SCHED; PG8_LDA(At, 0, 0); PG8_STAGE(PG8_SA(1, 1), a1 + hstep, voffA);
            PG8_WAIT_V(8); PG8_WAIT_L(0); PG8_BAR; PG8_MMA(0, 0, At, B0); PG8_MMA(0, 1, At, B1); PG8_BAR; PG8_SCHED;
            PG8_LDA(At, 0, 1); PG8_STAGE(PG8_SB(0, 0), b2, voffB); PG8_STAGE(PG8_SB(0, 1), b2 + hstep, voffB); PG8_STAGE(PG8_SA(0, 0), a2, voffA);
            PG8_WAIT_V(8); PG8_WAIT_L(0); PG8_BAR; PG8_MMA(1, 0, At, B0); PG8_MMA(1, 1, At, B1); PG8_BAR; PG8_SCHED;
            PG8_LDB(B0, 1, 0); PG8_LDB(B1, 1, 1); PG8_SCHED; PG8_LDA(At, 1, 0); PG8_STAGE(PG8_SA(0, 1), a2 + hstep, voffA);
            PG8_WAIT_V(8); PG8_WAIT_L(0); PG8_BAR; PG8_MMA(0, 0, At, B0); PG8_MMA(0, 1, At, B1); PG8_BAR; PG8_SCHED;
            PG8_LDA(At, 1, 1); PG8_STAGE(PG8_SB(1, 0), b3, voffB); PG8_STAGE(PG8_SB(1, 1), b3 + hstep, voffB); PG8_STAGE(PG8_SA(1, 0), a3, voffA);
            PG8_WAIT_V(8); PG8_WAIT_L(0); PG8_BAR; PG8_MMA(1, 0, At, B0); PG8_MMA(1, 1, At, B1); PG8_BAR; PG8_SCHED;
            } else {
            PG8_LDB(B0, 0, 0); PG8_SCHED; PG8_LDA(At, 0, 0); PG8_STAGE(PG8_SA(1, 1), a1 + hstep, voffA);
            PG8_WAIT_L(8); PG8_BAR; PG8_WAIT_L(0); PG8_MMA(0, 0, At, B0); PG8_BAR; PG8_SCHED;
            PG8_LDB(B1, 0, 1); PG8_STAGE(PG8_SB(0, 0), b2, voffB);
            PG8_BAR; PG8_WAIT_L(0); PG8_MMA(0, 1, At, B1); PG8_BAR;
            PG8_LDA(At, 0, 1); PG8_STAGE(PG8_SA(0, 0), a2, voffA);
            PG8_BAR; PG8_WAIT_L(0); PG8_MMA(1, 0, At, B0); PG8_BAR; PG8_SCHED;
            PG8_STAGE(PG8_SB(0, 1), b2 + hstep, voffB);
            PG8_WAIT_V(6); PG8_BAR; PG8_MMA(1, 1, At, B1); PG8_BAR;
            PG8_LDB(B0, 1, 0); PG8_SCHED; PG8_LDA(At, 1, 0); PG8_STAGE(PG8_SA(0, 1), a2 + hstep, voffA);
            PG8_WAIT_L(8); PG8_BAR; PG8_WAIT_L(0); PG8_MMA(0, 0, At, B0); PG8_BAR; PG8_SCHED;
            PG8_LDB(B1, 1, 1); PG8_STAGE(PG8_SB(1, 0), b3, voffB);
            PG8_BAR; PG8_WAIT_L(0); PG8_MMA(0, 1, At, B1); PG8_BAR;
            PG8_LDA(At, 1, 1); PG8_STAGE(PG8_SA(1, 0), a3, voffA);
            PG8_BAR; PG8_WAIT_L(0); PG8_MMA(1, 0, At, B0); PG8_BAR; PG8_SCHED;
            PG8_STAGE(PG8_SB(1, 1), b3 + hstep, voffB);
            PG8_WAIT_V(6); PG8_BAR; PG8_MMA(1, 1, At, B1); PG8_BAR;
            }
        }
        if constexpr (ALIGN_EPI) { if (wr == 0) PG8_BAR; }
        if constexpr (!Epi::AFTER_DRAIN) { E(acc, cur, wr, wc, fr, fq); S.done(cur); }
        if (!has_next) break;
#pragma unroll
        for (int a = 0; a < 2; ++a)
#pragma unroll
            for (int b = 0; b < 2; ++b)
#pragma unroll
                for (int m = 0; m < 4; ++m)
#pragma unroll
                    for (int n = 0; n < 2; ++n) acc[a][b][m][n] = (f32x4){0.f, 0.f, 0.f, 0.f};
        cur = nxt; cA = nA; cB = nB; ++ui;
        if constexpr (ALIGN_EPI) { if (wr == 1) PG8_BAR; }
    }
    PG8_WAIT_V(0);
    if constexpr (!ALIGN_EPI) { if (wr == 0) PG8_BAR; }
    PG8_BAR;
#undef PG8_SA
#undef PG8_SB
#undef PG8_STAGE
#undef PG8_LDA
#undef PG8_LDB
#undef PG8_MMA
#undef PG8_WAIT_V
#undef PG8_WAIT_L
#undef PG8_BAR
#undef PG8_SCHED
}
}

typedef unsigned short bf16;
typedef short bf16x8 __attribute__((ext_vector_type(8)));
typedef float f32x4 __attribute__((ext_vector_type(4)));
typedef unsigned u32x4 __attribute__((ext_vector_type(4)));
typedef unsigned u32x2 __attribute__((ext_vector_type(2)));
#define LAS __attribute__((address_space(3)))

constexpr int NB = 8, SEQ = 8192, DM = 1024, CTXL = 256;
constexpr int MLAT = NB * SEQ, MCTX = NB * CTXL, MTOT = MLAT + MCTX;
constexpr int LDP = 2304;
constexpr int CQ = 0, CK = 512, CGQ = 1024, CGK = 1280, CGR = 1536, CAF = 2048, CAB = 2064;
__device__ __forceinline__ size_t vt_off(int row, int tok) { return ((size_t)(tok >> 5) * 64 + (row >> 4)) * 512 + ((tok >> 3) & 3) * 128 + (row & 15) * 8; }
__device__ __forceinline__ size_t p1_off(int row, int col) { return ((size_t)(col >> 8) * MTOT + row) * 256 + (col & 255); }
constexpr int FFN = 2816, NMOD = 6 * DM;
constexpr int NCH = 132;
constexpr float EPS = 1e-6f;

constexpr size_t MiB = 1u << 20;
constexpr size_t WS_CTL = 0, CTL_ZERO_BYTES = 1 * MiB;
constexpr size_t WS_MOD = 1 * MiB;
constexpr size_t WS_ROPE = 1 * MiB + 512 * 1024;
constexpr size_t WS_WMAIN = 2 * MiB;
constexpr size_t WS_WV = 7 * MiB;
constexpr size_t WS_WOUT = 9 * MiB;
constexpr size_t WS_WGU = 11 * MiB;
constexpr size_t WS_WDOWN = 22 * MiB;
constexpr size_t WS_H = 32 * MiB;
constexpr size_t WS_P1 = 164 * MiB;
constexpr size_t WS_VT = 461 * MiB;
constexpr size_t WS_KV = 593 * MiB;
constexpr size_t WS_DEC = 725 * MiB;
constexpr size_t WS_SSQ1 = 728 * MiB;
constexpr size_t WS_SSQ2 = 732 * MiB;
constexpr size_t WS_MIX = 736 * MiB;
constexpr size_t WS_Y = WS_KV;
constexpr size_t WS_ACT = WS_P1;
constexpr size_t WS_DOWN = WS_MIX;
constexpr size_t WS_X1B = 864 * MiB;
constexpr size_t WS_END = 992 * MiB;
static_assert(WS_P1 + (size_t)MTOT * LDP * 2 <= WS_VT && WS_VT + (size_t)1024 * MTOT * 2 <= WS_KV && WS_KV + (size_t)64 * NCH * 128 * 64 * 2 <= WS_DEC, "ws map");
static_assert(WS_ACT + (size_t)MLAT * FFN * 2 <= WS_KV && WS_H + (size_t)MTOT * DM * 2 <= WS_P1 && WS_MIX + (size_t)MLAT * DM * 2 <= WS_END, "ws map 2");

constexpr int LDS_BYTES = 147456;
constexpr int NTHREADS = 512;

__device__ __forceinline__ unsigned f2bf(float f) { unsigned u = __builtin_bit_cast(unsigned, f); return (u + 0x7fffu + ((u >> 16) & 1u)) >> 16; }
typedef float f32x2_t __attribute__((ext_vector_type(2)));
typedef __bf16 bf16x2_t __attribute__((ext_vector_type(2)));
__device__ __forceinline__ unsigned pk2(float lo, float hi) { const f32x2_t v = {lo, hi}; return __builtin_bit_cast(unsigned, __builtin_convertvector(v, bf16x2_t)); }
__device__ __forceinline__ float bflo(unsigned w) { return __builtin_bit_cast(float, w << 16); }
__device__ __forceinline__ float bfhi(unsigned w) { return __builtin_bit_cast(float, w & 0xffff0000u); }
__device__ __forceinline__ float wave_sum(float v) {
#pragma unroll
    for (int o = 1; o < 64; o <<= 1) v += __shfl_xor(v, o);
    return v;
}
__device__ __forceinline__ void unpack8(const u32x4 w, float (&o)[8]) { o[0] = bflo(w.x); o[1] = bfhi(w.x); o[2] = bflo(w.y); o[3] = bfhi(w.y); o[4] = bflo(w.z); o[5] = bfhi(w.z); o[6] = bflo(w.w); o[7] = bfhi(w.w); }
__device__ __forceinline__ float logsig16(float z) { return (fminf(z, 0.f) - __logf(1.0f + __expf(-fabsf(z)))) * (1.0f / 16.0f); }

#define XB_TMO      128
#define XB_XCNT(j)  (256  + 64 * (j))
#define XB_XSUB(j)  (1280 + 64 * (j))
#define XB_XGEN(j)  (2304 + 64 * (j))
#define XB_TOP      3328
#define XB_TOPGEN   3392
#define XCD_BAR_WORDS 3456
#define XB_SPIN_CAP (1u << 18)
__device__ __forceinline__ unsigned xb_ld(unsigned* p)              { return __hip_atomic_load(p, __ATOMIC_RELAXED, __HIP_MEMORY_SCOPE_AGENT); }
__device__ __forceinline__ unsigned xb_add(unsigned* p, unsigned v) { return __hip_atomic_fetch_add(p, v, __ATOMIC_RELAXED, __HIP_MEMORY_SCOPE_AGENT); }
__device__ __forceinline__ unsigned xb_xcc_id() { return (unsigned)__builtin_amdgcn_s_getreg((3 << 11) | 20) & 0xFu; }
#define XB_SPIN(cond, bar) do { unsigned _sp = 0; while (cond) { __builtin_amdgcn_s_sleep(1); \
    if ((++_sp & 255u) == 0u) { if (xb_ld(&(bar)[XB_TMO])) break; if (_sp > XB_SPIN_CAP) { atomicAdd(&(bar)[XB_TMO], 1u); break; } } } } while (0)
struct XcdBarrier { unsigned* bar; unsigned x; volatile unsigned* st; };
__device__ __forceinline__ XcdBarrier xcd_barrier_post(unsigned* bar, volatile unsigned* st) {
    XcdBarrier b; b.bar = bar; b.x = xb_xcc_id(); b.st = st;
    if (threadIdx.x == 0) (void)xb_add(&bar[XB_XCNT(b.x)], 1u);
    return b;
}
__device__ __forceinline__ void xcd_barrier_complete(unsigned* bar, unsigned x, unsigned& nloc, unsigned& nx) {
    const unsigned G = gridDim.x * gridDim.y * gridDim.z;
    unsigned sum, cnt, mine, sp = 0u;
    for (;;) {
        sum = 0u; cnt = 0u; mine = 0u;
#pragma unroll
        for (unsigned j = 0; j < 16; ++j) { const unsigned c = xb_ld(&bar[XB_XCNT(j)]); sum += c; cnt += (c > 0u) ? 1u : 0u; mine = (j == x) ? c : mine; }
        if (sum == G) break;
        __builtin_amdgcn_s_sleep(1);
        if ((++sp & 255u) == 0u) { if (xb_ld(&bar[XB_TMO])) break; if (sp > XB_SPIN_CAP) { atomicAdd(&bar[XB_TMO], 1u); break; } }
    }
    nloc = mine > 0u ? mine : 1u; nx = cnt > 0u ? cnt : 1u;
}
__device__ __forceinline__ void xcd_barrier(const XcdBarrier& b) {
    asm volatile("s_waitcnt vmcnt(0)" ::: "memory");
    __syncthreads();
    if (threadIdx.x == 0) {
        unsigned* bar = b.bar;
        __builtin_amdgcn_s_waitcnt(0);
        unsigned nloc = b.st[0], nx = b.st[1];
        if (nloc == 0u) { xcd_barrier_complete(bar, b.x, nloc, nx); b.st[0] = nloc; b.st[1] = nx; }
        const unsigned old = xb_add(&bar[XB_XSUB(b.x)], 1u);
        const unsigned gen = old / nloc;
        if (old + 1u == (gen + 1u) * nloc) {
            __builtin_amdgcn_fence(__ATOMIC_RELEASE, "agent");
            asm volatile("s_waitcnt vmcnt(0)" ::: "memory");
            const unsigned og = xb_add(&bar[XB_TOP], 1u);
            const unsigned tg = og / nx;
            if (og + 1u == (tg + 1u) * nx) xb_add(&bar[XB_TOPGEN], 1u);
            else XB_SPIN(xb_ld(&bar[XB_TOPGEN]) == tg, bar);
            __builtin_amdgcn_fence(__ATOMIC_ACQUIRE, "agent");
            xb_add(&bar[XB_XGEN(b.x)], 1u);
            asm volatile("s_waitcnt vmcnt(0)" ::: "memory");
        } else {
            XB_SPIN(xb_ld(&bar[XB_XGEN(b.x)]) == gen, bar);
            __builtin_amdgcn_fence(__ATOMIC_ACQUIRE, "agent");
            asm volatile("s_waitcnt vmcnt(0)" ::: "memory");
        }
    }
    __syncthreads();
}

struct Frame {
    unsigned char* lds;
    int tid, lane, wave, G;
    const float *x, *c, *ctx, *c_ctx, *w_mod, *b_mod, *g_pre_mix, *g_post_mix, *g_pre_ffn, *g_post_ffn, *w_in, *rpb, *wa2_f, *ba_f, *wa2_b, *ba_b, *gla_norm, *w_out, *w_gu, *w_down;
    float* out;
    float *MOD, *ROPE, *DEC, *SSQ1, *SSQ2;
    bf16 *WMAIN, *WV, *WOUT, *WGU, *WDOWN, *H, *P1, *VT, *KV, *MIX, *Y, *ACT, *DOWN, *X1B;
};

__device__ __forceinline__ void ph0_mod(const Frame& F) {
    float* S = (float*)F.lds;
    float* PART = S + 9 * 1024;
    for (int i = F.tid; i < 9 * 1024; i += NTHREADS) { const int r = i >> 10, k = i & 1023; const float v = r < 8 ? F.c[r * 1024 + k] : F.c_ctx[k]; S[i] = v / (1.0f + expf(-v)); }
    __syncthreads();
    for (int cgp = blockIdx.x; cgp < 256; cgp += F.G) {
        const int n0 = cgp * 24, cgi = F.tid % 6, ks = F.tid / 6;
        float acc[9][4];
#pragma unroll
        for (int r = 0; r < 9; ++r)
#pragma unroll
            for (int j = 0; j < 4; ++j) acc[r][j] = 0.f;
        if (ks < 85) {
            for (int k = ks; k < 1024; k += 85) { const f32x4 w = *(const f32x4*)(F.w_mod + (size_t)k * NMOD + n0 + 4 * cgi);
#pragma unroll
                for (int r = 0; r < 9; ++r) { const float s = S[r * 1024 + k]; acc[r][0] += s * w[0]; acc[r][1] += s * w[1]; acc[r][2] += s * w[2]; acc[r][3] += s * w[3]; } }
#pragma unroll
            for (int r = 0; r < 9; ++r)
#pragma unroll
                for (int j = 0; j < 4; ++j) PART[(ks * 9 + r) * 24 + cgi * 4 + j] = acc[r][j];
        }
        __syncthreads();
        if (F.tid < 216) { const int r = F.tid / 24, col = F.tid % 24; float s = 0.f; for (int k2 = 0; k2 < 85; ++k2) s += PART[(k2 * 9 + r) * 24 + col]; F.MOD[r * NMOD + n0 + col] = s + F.b_mod[n0 + col]; }
        __syncthreads();
    }
    for (int i = blockIdx.x * NTHREADS + F.tid; i < 128 * 16; i += F.G * NTHREADS) {
        const int pos = i >> 4, ii = i & 15; const float inv = (float)pow(10000.0, -(double)ii / 16.0); const float ang = (float)pos * inv;
        F.ROPE[i] = (float)cos((double)ang); F.ROPE[2048 + i] = (float)sin((double)ang);
    }
}

__device__ __forceinline__ void transpose_item(const float* W, int ldn, int k0, int nsrc0, bf16* WT, int ldk, int drow0, float* scr, int lane) {
#pragma unroll 8
    for (int i = 0; i < 32; ++i) { const int kk = 2 * i + (lane >> 5); scr[kk * 33 + (lane & 31)] = W[(size_t)(k0 + kk) * ldn + nsrc0 + (lane & 31)]; }
    __builtin_amdgcn_wave_barrier();
    const int c = lane & 7;
#pragma unroll
    for (int j = 0; j < 4; ++j) { const int n = (lane >> 3) + 8 * j; const float* s = scr + (8 * c) * 33 + n;
        u32x4 o; o.x = pk2(s[0 * 33], s[1 * 33]); o.y = pk2(s[2 * 33], s[3 * 33]); o.z = pk2(s[4 * 33], s[5 * 33]); o.w = pk2(s[6 * 33], s[7 * 33]);
        *(u32x4*)(WT + (size_t)(drow0 + n) * ldk + k0 + 8 * c) = o; }
    __builtin_amdgcn_wave_barrier();
}
__device__ __forceinline__ void ph1_rows(const Frame& F) {
    const int gw = blockIdx.x * 8 + F.wave, NGW = F.G * 8;
    int curb = -1; f32x4 cA[4], cB[4];
#pragma unroll
    for (int j = 0; j < 4; ++j) { cA[j] = (f32x4){0.f, 0.f, 0.f, 0.f}; cB[j] = cA[j]; }
    for (int row0 = gw; row0 < MTOT; row0 += 2 * NGW) {
        const int nr = (row0 + NGW < MTOT) ? 2 : 1;
        f32x4 v[2][4];
#pragma unroll
        for (int q = 0; q < 2; ++q) { const int row = (q < nr) ? row0 + q * NGW : row0; const float* src = row < MLAT ? F.x + (size_t)row * DM : F.ctx + (size_t)(row - MLAT) * DM;
#pragma unroll
            for (int j = 0; j < 4; ++j) v[q][j] = __builtin_nontemporal_load((const f32x4*)src + F.lane + 64 * j); }
#pragma unroll
        for (int q = 0; q < 2; ++q) { if (q < nr) { const int row = row0 + q * NGW; const int b = row < MLAT ? (row >> 13) : 8; float ss = 0.f;
#pragma unroll
            for (int j = 0; j < 4; ++j) ss += (v[q][j][0] * v[q][j][0] + v[q][j][1] * v[q][j][1]) + (v[q][j][2] * v[q][j][2] + v[q][j][3] * v[q][j][3]);
            if (b != curb) { curb = b;
#pragma unroll
                for (int j = 0; j < 4; ++j) { const int col = 4 * (F.lane + 64 * j); const f32x4 g = *(const f32x4*)(F.g_pre_mix + col), sh = *(const f32x4*)(F.MOD + b * NMOD + col), sc = *(const f32x4*)(F.MOD + b * NMOD + DM + col);
                    cA[j] = g * (sc + 1.0f); cB[j] = sh; } }
            const float rstd = 1.0f / sqrtf(wave_sum(ss) * (1.0f / DM) + EPS);
#pragma unroll
            for (int j = 0; j < 4; ++j) { const f32x4 o = v[q][j] * rstd * cA[j] + cB[j]; u32x2 w; w.x = pk2(o[0], o[1]); w.y = pk2(o[2], o[3]); *(u32x2*)(F.H + (size_t)row * DM + 4 * (F.lane + 64 * j)) = w; } } }
    }
    float* scr = (float*)(F.lds + F.wave * 16384);
    constexpr int I_MAIN = 16 * 65, I_V = 16 * 32, I_OUT = 16 * 32, I_GU = 16 * 176, I_DOWN = 44 * 32, NITEMS = I_MAIN + I_V + I_OUT + I_GU + I_DOWN;
    for (int it = gw; it < NITEMS; it += NGW) {
        int r = it;
        if (r < I_MAIN) { const int kb = r / 65, nb = r % 65, dr = nb * 32; const int sc = dr < 1024 ? dr : (dr < 1536 ? dr + 512 : dr + 1024); transpose_item(F.w_in, 3104, kb * 64, sc, F.WMAIN, DM, dr, scr, F.lane); continue; } r -= I_MAIN;
        if (r < I_V) { const int kb = r / 32, nb = r % 32, dr = nb * 32; const int sc = dr < 512 ? dr + 1024 : dr + 1536; transpose_item(F.w_in, 3104, kb * 64, sc, F.WV, DM, dr, scr, F.lane); continue; } r -= I_V;
        if (r < I_OUT) { const int kb = r / 32, nb = r % 32; transpose_item(F.w_out, DM, kb * 64, nb * 32, F.WOUT, DM, nb * 32, scr, F.lane); continue; } r -= I_OUT;
        if (r < I_GU) { const int kb = r / 176, nb = r % 176, dr = nb * 32, pn = dr >> 8, jj = dr & 255; const int sc = jj < 128 ? 128 * pn + jj : FFN + 128 * pn + (jj - 128); transpose_item(F.w_gu, 2 * FFN, kb * 64, sc, F.WGU, DM, dr, scr, F.lane); continue; } r -= I_GU;
        { const int kb = r / 32, nb = r % 32; transpose_item(F.w_down, DM, kb * 64, nb * 32, F.WDOWN, FFN, nb * 32, scr, F.lane); }
    }
    for (int i = blockIdx.x * NTHREADS + F.tid; i < 224 * 1024 / 8; i += F.G * NTHREADS) *((u32x4*)(F.WMAIN + (size_t)2080 * DM) + i) = (u32x4){0u, 0u, 0u, 0u};
}

struct RopeCS { f32x4 c0, c1, s0, s1; };
__device__ __forceinline__ void rope_cs_issue(const float* rope, int dc, int posr, int posc, RopeCS& R) {
    const int pos = (dc >> 2) ? posc : posr, i0 = 8 * (dc & 1);
    R.c0 = *(const f32x4*)(rope + pos * 16 + i0); R.c1 = *(const f32x4*)(rope + pos * 16 + i0 + 4); R.s0 = *(const f32x4*)(rope + 2048 + pos * 16 + i0); R.s1 = *(const f32x4*)(rope + 2048 + pos * 16 + i0 + 4);
}
__device__ __forceinline__ int rope_partner(int dc) { return ((dc & 3) < 2) ? dc + 2 : dc - 2; }
__device__ __forceinline__ void rope_apply(const u32x4 mine, const u32x4 part, const RopeCS& R, int dc, bool do_rope, float (&o)[8]) {
    float a[8]; unpack8(mine, a);
    if (!do_rope) {
#pragma unroll
        for (int j = 0; j < 8; ++j) o[j] = a[j];
        return; }
    float p[8]; unpack8(part, p);
    const bool first = (dc & 3) < 2;
    const float cs[8] = {R.c0[0], R.c0[1], R.c0[2], R.c0[3], R.c1[0], R.c1[1], R.c1[2], R.c1[3]}, sn[8] = {R.s0[0], R.s0[1], R.s0[2], R.s0[3], R.s1[0], R.s1[1], R.s1[2], R.s1[3]};
#pragma unroll
    for (int j = 0; j < 8; ++j) o[j] = first ? (a[j] * cs[j] - p[j] * sn[j]) : (p[j] * sn[j] + a[j] * cs[j]);
}
__device__ __forceinline__ void stage_gate_weights(const Frame& F, u32x4* WB, float* BAS) {
    for (int e = F.tid; e < 2048; e += NTHREADS) { const int ln = e & 63, dt = (e >> 6) & 3, dirh = e >> 8, fq = ln >> 4, dd = ln & 15; const float* wa = (dirh >> 2) ? F.wa2_b : F.wa2_f; const int hh = dirh & 3;
        u32x4 v = (u32x4){0u, 0u, 0u, 0u};
        if (fq < 2) { float t[8];
#pragma unroll
            for (int jj = 0; jj < 8; ++jj) t[jj] = wa[(8 * fq + jj) * 256 + hh * 64 + 16 * dt + dd];
            v.x = pk2(t[0], t[1]); v.y = pk2(t[2], t[3]); v.z = pk2(t[4], t[5]); v.w = pk2(t[6], t[7]); }
        WB[e] = v; }
    { const int dh = F.tid >> 6, dd = F.tid & 63; BAS[F.tid] = ((dh >> 2) ? F.ba_b : F.ba_f)[(dh & 3) * 64 + dd]; }
}

__device__ __forceinline__ void gate_cum16(const bf16x8 (&a)[2][2], const bf16x8 wb, float ba, int dir, int lane, float (&r)[2][8], float& bend) {
    const int fq = lane >> 4, dl = lane & 15;
#pragma unroll
    for (int h2 = 0; h2 < 2; ++h2)
#pragma unroll
        for (int t = 0; t < 2; ++t) { const f32x4 z = __builtin_amdgcn_mfma_f32_16x16x32_bf16(a[h2][t], wb, (f32x4){0.f, 0.f, 0.f, 0.f}, 0, 0, 0);
#pragma unroll
            for (int q = 0; q < 4; ++q) r[h2][4 * t + q] = logsig16(z[q] + ba); }
    if (dir == 0) {
#pragma unroll
        for (int h2 = 0; h2 < 2; ++h2)
#pragma unroll
            for (int i = 1; i < 8; ++i) r[h2][i] += r[h2][i - 1];
    } else {
#pragma unroll
        for (int h2 = 0; h2 < 2; ++h2)
#pragma unroll
            for (int i = 6; i >= 0; --i) r[h2][i] += r[h2][i + 1];
    }
    const float T0 = dir ? r[0][0] : r[0][7], T1 = dir ? r[1][0] : r[1][7];
    float t0[4], t1[4];
#pragma unroll
    for (int k = 0; k < 4; ++k) { t0[k] = __shfl(T0, dl + 16 * k); t1[k] = __shfl(T1, dl + 16 * k); }
    const float s0 = (t0[0] + t0[1]) + (t0[2] + t0[3]), s1 = (t1[0] + t1[1]) + (t1[2] + t1[3]);
    float o0 = 0.f, o1 = 0.f;
#pragma unroll
    for (int k = 0; k < 4; ++k) { const bool in = dir ? (k > fq) : (k < fq); o0 += in ? t0[k] : 0.f; o1 += in ? t1[k] : 0.f; }
    if (dir == 0) o1 += s0; else o0 += s1;
    bend = s0 + s1;
#pragma unroll
    for (int i = 0; i < 8; ++i) { r[0][i] += o0; r[1][i] += o1; }
}

__device__ __forceinline__ void ph3_gla_kv(const Frame& F) {
    float* KF = (float*)F.lds;
    bf16* KETF = (bf16*)(KF + 64 * 68);
    bf16* KETB = KETF + 64 * 72;
    u32x4* WB = (u32x4*)(KETB + 64 * 72);
    float* BAS = (float*)(WB + 2048);
    const int tid = F.tid, lane = F.lane, w = F.wave;
    stage_gate_weights(F, WB, BAS);
    __syncthreads();
    const int c = tid >> 3, dc = tid & 7, pdc = rope_partner(dc), fr = lane & 15, fq = lane >> 4;
    auto geom = [&](int it, int& h, int& ch, int& tok0, bool& isctx, size_t& itf, size_t& itb) {
        const int n = it % NCH, bh = it / NCH; h = bh & 3; const int b = bh >> 2;
        isctx = n < 4; ch = isctx ? n : n - 4;
        tok0 = isctx ? MLAT + b * CTXL + 64 * ch : b * SEQ + 64 * ch;
        const int nb = isctx ? 3 - n : 4 + (127 - ch);
        itf = (size_t)(bh * 2) * NCH + n; itb = (size_t)(bh * 2 + 1) * NCH + nb;
    };
    const int gdir = w >> 2, gdt = w & 3, gd = 16 * gdt + fr, gkap = 8 * (fr >> 2) + (fr & 3);
    u32x4 pkm, pkp; RopeCS pcs; bf16x8 pbv[2], pga[2][2];
    auto issue_a = [&](int it) { int h, ch, tok0; bool isctx; size_t itf, itb; geom(it, h, ch, tok0, isctx, itf, itb);
        pkm = *(const u32x4*)(F.P1 + p1_off(tok0 + c, CGK + h * 64 + 8 * dc)); pkp = *(const u32x4*)(F.P1 + p1_off(tok0 + c, CGK + h * 64 + 8 * pdc));
#pragma unroll
        for (int h2 = 0; h2 < 2; ++h2)
#pragma unroll
            for (int t = 0; t < 2; ++t) pga[h2][t] = *(const bf16x8*)(F.P1 + p1_off(tok0 + 32 * h2 + gkap + 4 * t, CAF + 16 * gdir + 8 * (fq & 1)));
        rope_cs_issue(F.ROPE, dc, ch, c, pcs); };
    auto issue_c = [&](int it) { int h, ch, tok0; bool isctx; size_t itf, itb; geom(it, h, ch, tok0, isctx, itf, itb);
        pbv[0] = *(const bf16x8*)(F.VT + vt_off(512 + h * 128 + 16 * w + fr, tok0 + 8 * fq)); pbv[1] = *(const bf16x8*)(F.VT + vt_off(512 + h * 128 + 16 * w + fr, tok0 + 32 + 8 * fq)); };
    const int NIT = 32 * NCH;
    if ((int)blockIdx.x < NIT) { issue_a(blockIdx.x); issue_c(blockIdx.x); }
    for (int it = blockIdx.x; it < NIT; it += F.G) {
        int h, ch, tok0; bool isctx; size_t itf, itb; geom(it, h, ch, tok0, isctx, itf, itb);
        const int itn = (it + F.G < NIT) ? it + F.G : it;
        float gr_[2][8], bend;
        {
            float k8[8];
            rope_apply(pkm, pkp, pcs, dc, !isctx, k8);
            *(f32x4*)(KF + c * 68 + 8 * dc) = (f32x4){k8[0], k8[1], k8[2], k8[3]}; *(f32x4*)(KF + c * 68 + 8 * dc + 4) = (f32x4){k8[4], k8[5], k8[6], k8[7]};
            const bf16x8 zero = (bf16x8){0, 0, 0, 0, 0, 0, 0, 0};
            bf16x8 ga[2][2];
#pragma unroll
            for (int h2 = 0; h2 < 2; ++h2)
#pragma unroll
                for (int t = 0; t < 2; ++t) ga[h2][t] = (fq < 2) ? pga[h2][t] : zero;
            issue_a(itn);
            const bf16x8 wb = __builtin_bit_cast(bf16x8, WB[((gdir * 4 + h) * 4 + gdt) * 64 + lane]); const float ba = BAS[(gdir * 4 + h) * 64 + gd];
            gate_cum16(ga, wb, ba, gdir, lane, gr_, bend);
        }
        __syncthreads();
        {
            bf16* KET = gdir ? KETB : KETF;
#pragma unroll
            for (int h2 = 0; h2 < 2; ++h2) { float ke[8];
#pragma unroll
                for (int i = 0; i < 8; ++i) ke[i] = KF[(32 * h2 + 8 * fq + i) * 68 + gd] * __expf(bend - gr_[h2][i]);
                u32x4 o; o.x = pk2(ke[0], ke[1]); o.y = pk2(ke[2], ke[3]); o.z = pk2(ke[4], ke[5]); o.w = pk2(ke[6], ke[7]);
                *(u32x4*)(KET + gd * 72 + 32 * h2 + 8 * fq) = o; }
            if (fq == 0) F.DEC[(gdir ? itb : itf) * 64 + gd] = __expf(bend);
        }
        __syncthreads();
        {
            const bf16x8 bv0 = pbv[0], bv1 = pbv[1];
            bf16* dstf = F.KV + (itf * 128 + 16 * w + fr) * 64 + 8 * fq; bf16* dstb = F.KV + (itb * 128 + 16 * w + fr) * 64 + 8 * fq;
            const int kapr = 8 * (fr >> 2) + (fr & 3);
#pragma unroll
            for (int p = 0; p < 2; ++p) { f32x4 af_[2], ab_[2];
#pragma unroll
                for (int t = 0; t < 2; ++t) { const int row = 32 * p + kapr + 4 * t; f32x4 accf = (f32x4){0.f, 0.f, 0.f, 0.f}, accb = accf;
                    const bf16x8 af0 = *(const bf16x8*)(KETF + row * 72 + 8 * fq), af1 = *(const bf16x8*)(KETF + row * 72 + 32 + 8 * fq);
                    const bf16x8 ab0 = *(const bf16x8*)(KETB + row * 72 + 8 * fq), ab1 = *(const bf16x8*)(KETB + row * 72 + 32 + 8 * fq);
                    accf = __builtin_amdgcn_mfma_f32_16x16x32_bf16(af0, bv0, accf, 0, 0, 0); accb = __builtin_amdgcn_mfma_f32_16x16x32_bf16(ab0, bv0, accb, 0, 0, 0);
                    accf = __builtin_amdgcn_mfma_f32_16x16x32_bf16(af1, bv1, accf, 0, 0, 0); accb = __builtin_amdgcn_mfma_f32_16x16x32_bf16(ab1, bv1, accb, 0, 0, 0);
                    af_[t] = accf; ab_[t] = accb; }
                u32x4 o; o.x = pk2(af_[0][0], af_[0][1]); o.y = pk2(af_[0][2], af_[0][3]); o.z = pk2(af_[1][0], af_[1][1]); o.w = pk2(af_[1][2], af_[1][3]); *(u32x4*)(dstf + 32 * p) = o;
                o.x = pk2(ab_[0][0], ab_[0][1]); o.y = pk2(ab_[0][2], ab_[0][3]); o.z = pk2(ab_[1][0], ab_[1][1]); o.w = pk2(ab_[1][2], ab_[1][3]); *(u32x4*)(dstb + 32 * p) = o; }
            issue_c(itn);
        }
    }
    __syncthreads();
}

__device__ __forceinline__ void ph4_gla_scan(const Frame& F) {
    constexpr int UB = 12;
    for (int idx = blockIdx.x * NTHREADS + F.tid; idx < 64 * 2048; idx += F.G * NTHREADS) {
        const int seq = idx >> 11, within = idx & 2047, e = within >> 4, d = 4 * (within & 15);
        bf16* p = F.KV + ((size_t)seq * NCH * 128 + e) * 64 + d; const float* dp = F.DEC + (size_t)seq * NCH * 64 + d;
        float s0 = 0.f, s1 = 0.f, s2 = 0.f, s3 = 0.f;
        for (int n0 = 0; n0 < NCH; n0 += UB) {
            u32x2 kv[UB]; f32x4 dc[UB];
#pragma unroll
            for (int u = 0; u < UB; ++u) { kv[u] = *(const u32x2*)(p + (size_t)(n0 + u) * 128 * 64); dc[u] = *(const f32x4*)(dp + (n0 + u) * 64); }
#pragma unroll
            for (int u = 0; u < UB; ++u) {
                u32x2 o; o.x = pk2(s0, s1); o.y = pk2(s2, s3); *(u32x2*)(p + (size_t)(n0 + u) * 128 * 64) = o;
                s0 = dc[u][0] * s0 + bflo(kv[u].x); s1 = dc[u][1] * s1 + bfhi(kv[u].x); s2 = dc[u][2] * s2 + bflo(kv[u].y); s3 = dc[u][3] * s3 + bfhi(kv[u].y); }
        }
    }
}

__device__ __forceinline__ void ph5_gla_out(const Frame& F) {
    float* BCF = (float*)F.lds;
    float* BCB = BCF + 64 * 68;
    float* SS = BCB + 64 * 68;
    bf16* QDF = (bf16*)(SS + 512);
    bf16* KIF = QDF + 64 * 72;
    bf16* QDB = KIF + 64 * 72;
    bf16* KIB = QDB + 64 * 72;
    bf16* AT = KIB + 64 * 72;
    u32x4* WB = (u32x4*)(AT + 64 * 72);
    float* BAS = (float*)(WB + 2048);
    float* GN = BAS + 512;
    const int tid = F.tid, lane = F.lane, w = F.wave, fr = lane & 15, fq = lane >> 4;
    stage_gate_weights(F, WB, BAS);
    GN[tid] = F.gla_norm[tid];
    __syncthreads();
    const int c = tid >> 3, dc = tid & 7, pdc = rope_partner(dc);
    const int gdir = w >> 2, gdt = w & 3, gd = 16 * gdt + fr, gkap = 8 * (fr >> 2) + (fr & 3);
    u32x4 pqm, pqp, pkm, pkp; RopeCS pcs; u32x2 pgr[4]; bf16x8 pav[2], pasf[2], pasb[2], pga[2][2];
    auto issue_a = [&](int it) { const int j = it & 127, h = (it >> 7) & 3, b = it >> 9; const int tok0 = b * SEQ + 64 * j;
        pqm = *(const u32x4*)(F.P1 + p1_off(tok0 + c, CGQ + h * 64 + 8 * dc)); pqp = *(const u32x4*)(F.P1 + p1_off(tok0 + c, CGQ + h * 64 + 8 * pdc));
        pkm = *(const u32x4*)(F.P1 + p1_off(tok0 + c, CGK + h * 64 + 8 * dc)); pkp = *(const u32x4*)(F.P1 + p1_off(tok0 + c, CGK + h * 64 + 8 * pdc));
#pragma unroll
        for (int h2 = 0; h2 < 2; ++h2)
#pragma unroll
            for (int t = 0; t < 2; ++t) pga[h2][t] = *(const bf16x8*)(F.P1 + p1_off(tok0 + 32 * h2 + gkap + 4 * t, CAF + 16 * gdir + 8 * (fq & 1)));
        rope_cs_issue(F.ROPE, dc, j, c, pcs);
#pragma unroll
        for (int ct = 0; ct < 4; ++ct) pgr[ct] = *(const u32x2*)(F.P1 + p1_off(tok0 + 16 * ct + fr, CGR + h * 128 + 16 * w + 4 * fq)); };
    auto issue_e = [&](int it) { const int j = it & 127, h = (it >> 7) & 3, b = it >> 9; const int tok0 = b * SEQ + 64 * j;
        const int seqf = (b * 4 + h) * 2, seqb = seqf + 1;
        const bf16* vrow = F.VT + vt_off(512 + h * 128 + 16 * w + fr, tok0 + 8 * fq); const bf16* vrow1 = F.VT + vt_off(512 + h * 128 + 16 * w + fr, tok0 + 32 + 8 * fq);
        const bf16* sfp = F.KV + (((size_t)seqf * NCH + 4 + j) * 128 + 16 * w + fr) * 64 + 8 * fq;
        const bf16* sbp = F.KV + (((size_t)seqb * NCH + 4 + (127 - j)) * 128 + 16 * w + fr) * 64 + 8 * fq;
        pav[0] = *(const bf16x8*)vrow; pav[1] = *(const bf16x8*)vrow1; pasf[0] = *(const bf16x8*)sfp; pasf[1] = *(const bf16x8*)(sfp + 32); pasb[0] = *(const bf16x8*)sbp; pasb[1] = *(const bf16x8*)(sbp + 32); };
    const int NIT = NB * 4 * 128;
    if ((int)blockIdx.x < NIT) { issue_a(blockIdx.x); issue_e(blockIdx.x); }
    for (int it = blockIdx.x; it < NIT; it += F.G) {
        const int j = it & 127, h = (it >> 7) & 3, b = it >> 9;
        const int tok0 = b * SEQ + 64 * j;
        const int itn = (it + F.G < NIT) ? it + F.G : it;
        float q8[8], k8[8]; u32x2 gr[4];
        {
            rope_apply(pqm, pqp, pcs, dc, true, q8);
            rope_apply(pkm, pkp, pcs, dc, true, k8);
#pragma unroll
            for (int ct = 0; ct < 4; ++ct) gr[ct] = pgr[ct];
            const bf16x8 zero = (bf16x8){0, 0, 0, 0, 0, 0, 0, 0};
            bf16x8 ga[2][2];
#pragma unroll
            for (int h2 = 0; h2 < 2; ++h2)
#pragma unroll
                for (int t = 0; t < 2; ++t) ga[h2][t] = (fq < 2) ? pga[h2][t] : zero;
            issue_a(itn);
            const bf16x8 wb = __builtin_bit_cast(bf16x8, WB[((gdir * 4 + h) * 4 + gdt) * 64 + lane]); const float ba = BAS[(gdir * 4 + h) * 64 + gd];
            float r[2][8], bend; gate_cum16(ga, wb, ba, gdir, lane, r, bend);
            float* BC = gdir ? BCB : BCF;
#pragma unroll
            for (int h2 = 0; h2 < 2; ++h2)
#pragma unroll
                for (int i = 0; i < 8; ++i) BC[(32 * h2 + 8 * fq + i) * 68 + gd] = r[h2][i];
        }
        __syncthreads();
        {
            const f32x4 f0 = *(const f32x4*)(BCF + c * 68 + 8 * dc), f1 = *(const f32x4*)(BCF + c * 68 + 8 * dc + 4), b0 = *(const f32x4*)(BCB + c * 68 + 8 * dc), b1 = *(const f32x4*)(BCB + c * 68 + 8 * dc + 4);
            const float bf[8] = {f0[0], f0[1], f0[2], f0[3], f1[0], f1[1], f1[2], f1[3]}, bb[8] = {b0[0], b0[1], b0[2], b0[3], b1[0], b1[1], b1[2], b1[3]};
            float qf[8], kf[8], qb[8], kb[8];
#pragma unroll
            for (int i = 0; i < 8; ++i) { qf[i] = q8[i] * __expf(bf[i]) * 0.125f; kf[i] = k8[i] * __expf(-bf[i]); qb[i] = q8[i] * __expf(bb[i]) * 0.125f; kb[i] = k8[i] * __expf(-bb[i]); }
            u32x4 o;
            o.x = pk2(qf[0], qf[1]); o.y = pk2(qf[2], qf[3]); o.z = pk2(qf[4], qf[5]); o.w = pk2(qf[6], qf[7]); *(u32x4*)(QDF + c * 72 + 8 * dc) = o;
            o.x = pk2(kf[0], kf[1]); o.y = pk2(kf[2], kf[3]); o.z = pk2(kf[4], kf[5]); o.w = pk2(kf[6], kf[7]); *(u32x4*)(KIF + c * 72 + 8 * dc) = o;
            o.x = pk2(qb[0], qb[1]); o.y = pk2(qb[2], qb[3]); o.z = pk2(qb[4], qb[5]); o.w = pk2(qb[6], qb[7]); *(u32x4*)(QDB + c * 72 + 8 * dc) = o;
            o.x = pk2(kb[0], kb[1]); o.y = pk2(kb[2], kb[3]); o.z = pk2(kb[4], kb[5]); o.w = pk2(kb[6], kb[7]); *(u32x4*)(KIB + c * 72 + 8 * dc) = o;
        }
        __syncthreads();
        {
            const int ct = w & 3, sp = w >> 2;
            const bf16x8 bqf0 = *(const bf16x8*)(QDF + (16 * ct + fr) * 72 + 8 * fq), bqf1 = *(const bf16x8*)(QDF + (16 * ct + fr) * 72 + 32 + 8 * fq);
            const bf16x8 bqb0 = *(const bf16x8*)(QDB + (16 * ct + fr) * 72 + 8 * fq), bqb1 = *(const bf16x8*)(QDB + (16 * ct + fr) * 72 + 32 + 8 * fq);
#pragma unroll
            for (int t = 0; t < 2; ++t) { const int st = 2 * sp + t;
                f32x4 af = (f32x4){0.f, 0.f, 0.f, 0.f}, ab = af;
                af = __builtin_amdgcn_mfma_f32_16x16x32_bf16(*(const bf16x8*)(KIF + (16 * st + fr) * 72 + 8 * fq), bqf0, af, 0, 0, 0);
                af = __builtin_amdgcn_mfma_f32_16x16x32_bf16(*(const bf16x8*)(KIF + (16 * st + fr) * 72 + 32 + 8 * fq), bqf1, af, 0, 0, 0);
                ab = __builtin_amdgcn_mfma_f32_16x16x32_bf16(*(const bf16x8*)(KIB + (16 * st + fr) * 72 + 8 * fq), bqb0, ab, 0, 0, 0);
                ab = __builtin_amdgcn_mfma_f32_16x16x32_bf16(*(const bf16x8*)(KIB + (16 * st + fr) * 72 + 32 + 8 * fq), bqb1, ab, 0, 0, 0);
                const int cc = 16 * ct + fr, s0 = 16 * st + 4 * fq; float tt[4];
#pragma unroll
                for (int r = 0; r < 4; ++r) { const int s = s0 + r; tt[r] = (s <= cc ? af[r] : 0.f) + (s >= cc ? ab[r] : 0.f); }
                u32x2 o; o.x = pk2(tt[0], tt[1]); o.y = pk2(tt[2], tt[3]); *(u32x2*)(AT + cc * 72 + s0) = o; }
        }
        __syncthreads();
        f32x4 o4[4];
        {
#pragma unroll
            for (int ct = 0; ct < 4; ++ct) { f32x4 acc = (f32x4){0.f, 0.f, 0.f, 0.f};
#pragma unroll
                for (int ks = 0; ks < 2; ++ks) {
                    acc = __builtin_amdgcn_mfma_f32_16x16x32_bf16(pav[ks], *(const bf16x8*)(AT + (16 * ct + fr) * 72 + 32 * ks + 8 * fq), acc, 0, 0, 0);
                    acc = __builtin_amdgcn_mfma_f32_16x16x32_bf16(pasf[ks], *(const bf16x8*)(QDF + (16 * ct + fr) * 72 + 32 * ks + 8 * fq), acc, 0, 0, 0);
                    acc = __builtin_amdgcn_mfma_f32_16x16x32_bf16(pasb[ks], *(const bf16x8*)(QDB + (16 * ct + fr) * 72 + 32 * ks + 8 * fq), acc, 0, 0, 0); }
                o4[ct] = acc;
                float p = (acc[0] * acc[0] + acc[1] * acc[1]) + (acc[2] * acc[2] + acc[3] * acc[3]); p += __shfl_xor(p, 16); p += __shfl_xor(p, 32);
                if (fq == 0) SS[w * 64 + 16 * ct + fr] = p; }
            issue_e(itn);
        }
        __syncthreads();
        {
            const f32x4 gn = *(const f32x4*)(GN + h * 128 + 16 * w + 4 * fq);
#pragma unroll
            for (int ct = 0; ct < 4; ++ct) { const int cc = 16 * ct + fr; float tot = 0.f;
#pragma unroll
                for (int w2 = 0; w2 < 8; ++w2) tot += SS[w2 * 64 + cc];
                const float rs = 1.0f / sqrtf(tot * (1.0f / 128.0f) + EPS);
                const float g[4] = {bflo(gr[ct].x), bfhi(gr[ct].x), bflo(gr[ct].y), bfhi(gr[ct].y)}; float y[4];
#pragma unroll
                for (int r = 0; r < 4; ++r) y[r] = o4[ct][r] * rs * gn[r] * (g[r] * __builtin_amdgcn_rcpf(1.0f + __expf(-g[r])));
                u32x2 o; o.x = pk2(y[0], y[1]); o.y = pk2(y[2], y[3]); *(u32x2*)(F.MIX + (size_t)(tok0 + cc) * DM + 512 + h * 128 + 16 * w + 4 * fq) = o; }
        }
        __syncthreads();
    }
}

__device__ __forceinline__ void ph5_na(const Frame& F) {
    constexpr int NT = 4;
    constexpr float LOG2E = 1.4426950408889634f, QS = 0.125f * LOG2E;
    bf16* CKs = (bf16*)F.lds;
    bf16* CVs = CKs + 256 * 72;
    float* RPB = (float*)(CVs + 64 * 264);
    bf16* QSw = (bf16*)(RPB + 468) + F.wave * (4 * 16 * 64);
    const int tid = F.tid, lane = F.lane, w = F.wave, qi = lane & 15, fq = lane >> 4;
    const int j = w & 3, sub = w >> 2;
    const int c = 16 * j + qi;
    const int kc0 = (j == 0) ? 0 : (j == 1) ? 8 : (j == 2) ? 24 : 32;
    const int cs = (c - 8 < 0) ? 0 : (c - 8 > 48 ? 48 : c - 8);
    const int kap = 8 * (qi >> 2) + (qi & 3);
    unsigned cmask = 0;
#pragma unroll
    for (int e = 0; e < 8; ++e) { const int kc = kc0 + 8 * fq + e; if (kc >= cs && kc < cs + 16) cmask |= 1u << e; }
    const int dc0 = kc0 + 8 * fq - c + 15;
    int dcc[8];
#pragma unroll
    for (int e = 0; e < 8; ++e) { const int t = dc0 + e; dcc[e] = t < 0 ? 0 : (t > 30 ? 30 : t); }
    const float NEG_INF = -__builtin_inff();
    const int ipw = (1024 + F.G - 1) / F.G;
    int cur_bh = -1;
    for (int it = blockIdx.x * ipw; it < (blockIdx.x + 1) * ipw && it < 1024; ++it) {
        const int rg = it & 15, bh = it >> 4, head = bh & 7, b = bh >> 3;
        if (bh != cur_bh) {
            cur_bh = bh;
            __syncthreads();
            { const int row = tid >> 1, hf = tid & 1; const bf16* src = F.P1 + p1_off(MLAT + b * CTXL + row, CK + head * 64 + 32 * hf);
              u32x4 v0 = *(const u32x4*)src, v1 = *(const u32x4*)(src + 8), v2 = *(const u32x4*)(src + 16), v3 = *(const u32x4*)(src + 24);
              bf16* dst = CKs + row * 72 + 32 * hf; *(u32x4*)dst = v0; *(u32x4*)(dst + 8) = v1; *(u32x4*)(dst + 16) = v2; *(u32x4*)(dst + 24) = v3; }
            { const int row = tid >> 3, sg = tid & 7; const int t0 = MLAT + b * CTXL + 32 * sg;
              u32x4 v0 = *(const u32x4*)(F.VT + vt_off(head * 64 + row, t0)), v1 = *(const u32x4*)(F.VT + vt_off(head * 64 + row, t0 + 8)), v2 = *(const u32x4*)(F.VT + vt_off(head * 64 + row, t0 + 16)), v3 = *(const u32x4*)(F.VT + vt_off(head * 64 + row, t0 + 24));
              bf16* dst = CVs + row * 264 + 32 * sg; *(u32x4*)dst = v0; *(u32x4*)(dst + 8) = v1; *(u32x4*)(dst + 16) = v2; *(u32x4*)(dst + 24) = v3; }
            if (tid < 465) RPB[tid] = F.rpb[head * 465 + tid] * LOG2E;
            __syncthreads();
        }
        const int rA = 8 * rg + 4 * sub;
        {
            bf16x8 qt[NT][2];
#pragma unroll
            for (int nt = 0; nt < NT; ++nt) { const bf16* qp = F.P1 + p1_off(b * SEQ + (rA + nt) * 64 + c, CQ + head * 64 + 8 * fq); qt[nt][0] = *(const bf16x8*)qp; qt[nt][1] = *(const bf16x8*)(qp + 32); }
#pragma unroll
            for (int nt = 0; nt < NT; ++nt)
#pragma unroll
                for (int ks = 0; ks < 2; ++ks) *(bf16x8*)(QSw + (nt * 16 + qi) * 64 + 8 * ((4 * ks + fq) ^ (qi & 7))) = qt[nt][ks];
        }
        float m[NT], l[NT]; f32x4 O[4][NT];
#pragma unroll
        for (int nt = 0; nt < NT; ++nt) { m[nt] = NEG_INF; l[nt] = 0.f;
#pragma unroll
            for (int dt = 0; dt < 4; ++dt) O[dt][nt] = (f32x4){0.f, 0.f, 0.f, 0.f}; }
        auto na_tile = [&](int nt, bool local, int kr, const bf16x8 (&kf)[2][2], const bf16x8 (&vf)[4]) {
            const int r = rA + nt;
            const bf16x8 q0 = *(const bf16x8*)(QSw + (nt * 16 + qi) * 64 + 8 * (fq ^ (qi & 7))), q1 = *(const bf16x8*)(QSw + (nt * 16 + qi) * 64 + 8 * ((4 + fq) ^ (qi & 7)));
            f32x4 s0 = (f32x4){0.f, 0.f, 0.f, 0.f}, s1 = s0;
            s0 = __builtin_amdgcn_mfma_f32_16x16x32_bf16(kf[0][0], q0, s0, 0, 0, 0); s0 = __builtin_amdgcn_mfma_f32_16x16x32_bf16(kf[0][1], q1, s0, 0, 0, 0);
            s1 = __builtin_amdgcn_mfma_f32_16x16x32_bf16(kf[1][0], q0, s1, 0, 0, 0); s1 = __builtin_amdgcn_mfma_f32_16x16x32_bf16(kf[1][1], q1, s1, 0, 0, 0);
            float sc[8];
            if (local) { const float* rp = RPB + (kr - r + 7) * 31; float bias[8];
#pragma unroll
                for (int e = 0; e < 8; ++e) bias[e] = rp[dcc[e]];
#pragma unroll
                for (int e = 0; e < 8; ++e) { const float a = (e < 4) ? s0[e & 3] : s1[e & 3]; sc[e] = ((cmask >> e) & 1u) ? a * QS + bias[e] : NEG_INF; }
            } else {
#pragma unroll
                for (int e = 0; e < 8; ++e) { const float a = (e < 4) ? s0[e & 3] : s1[e & 3]; sc[e] = a * QS; }
            }
            const float lmax = fmaxf(fmaxf(fmaxf(sc[0], sc[1]), fmaxf(sc[2], sc[3])), fmaxf(fmaxf(sc[4], sc[5]), fmaxf(sc[6], sc[7])));
            if (!__all(lmax <= m[nt] + 11.0f)) {
                float mx = fmaxf(lmax, __shfl_xor(lmax, 16)); mx = fmaxf(mx, __shfl_xor(mx, 32));
                const float mn = fmaxf(m[nt], mx), alpha = __builtin_amdgcn_exp2f(m[nt] - mn); m[nt] = mn; l[nt] *= alpha;
#pragma unroll
                for (int dt = 0; dt < 4; ++dt) O[dt][nt] = O[dt][nt] * alpha; }
            const float mn = m[nt];
            float p[8], ps = 0.f;
#pragma unroll
            for (int e = 0; e < 8; ++e) { p[e] = __builtin_amdgcn_exp2f(sc[e] - mn); ps += p[e]; }
            l[nt] += ps;
            u32x4 pw; pw.x = pk2(p[0], p[1]); pw.y = pk2(p[2], p[3]); pw.z = pk2(p[4], p[5]); pw.w = pk2(p[6], p[7]);
            const bf16x8 pf = __builtin_bit_cast(bf16x8, pw);
#pragma unroll
            for (int dt = 0; dt < 4; ++dt) O[dt][nt] = __builtin_amdgcn_mfma_f32_16x16x32_bf16(vf[dt], pf, O[dt][nt], 0, 0, 0);
            __builtin_amdgcn_sched_barrier(0);
        };
#pragma unroll 1
        for (int s = 0; s < 8; ++s) {
            bf16x8 kf[2][2], vf[4];
#pragma unroll
            for (int t = 0; t < 2; ++t) { const bf16* kp = CKs + (32 * s + kap + 4 * t) * 72 + 8 * fq; kf[t][0] = *(const bf16x8*)kp; kf[t][1] = *(const bf16x8*)(kp + 32); }
#pragma unroll
            for (int dt = 0; dt < 4; ++dt) vf[dt] = *(const bf16x8*)(CVs + (dt * 16 + qi) * 264 + 32 * s + 8 * fq);
#pragma unroll
            for (int nt = 0; nt < NT; ++nt) na_tile(nt, false, 0, kf, vf);
        }
        const int rsA = (rA - 4 < 0) ? 0 : (rA - 4 > 120 ? 120 : rA - 4);
        const int rlast = rA + NT - 1; const int rsB = (rlast - 4 < 0) ? 0 : (rlast - 4 > 120 ? 120 : rlast - 4);
        const int nloc = rsB + 8 - rsA, slast = nloc - 1;
        auto na_loadk = [&](int s, bf16x8 (&kf)[2][2]) {
            const int base_tok = b * SEQ + (rsA + s) * 64 + kc0;
#pragma unroll
            for (int t = 0; t < 2; ++t) { const bf16* kp = F.P1 + p1_off(base_tok + kap + 4 * t, CK + head * 64 + 8 * fq); kf[t][0] = *(const bf16x8*)kp; kf[t][1] = *(const bf16x8*)(kp + 32); }
        };
        auto na_step = [&](int s, const bf16x8 (&kf)[2][2]) {
            const int kr = rsA + s; const int base_tok = b * SEQ + kr * 64 + kc0;
            bf16x8 vf[4];
#pragma unroll
            for (int dt = 0; dt < 4; ++dt) vf[dt] = *(const bf16x8*)(F.VT + vt_off(head * 64 + dt * 16 + qi, base_tok + 8 * fq));
#pragma unroll
            for (int nt = 0; nt < NT; ++nt) {
                const int r = rA + nt; const int rs = (r - 4 < 0) ? 0 : (r - 4 > 120 ? 120 : r - 4);
                if (kr < rs || kr >= rs + 8) continue;
                na_tile(nt, true, kr, kf, vf);
            }
        };
        bf16x8 kfA[2][2], kfB[2][2];
        na_loadk(0, kfA);
        for (int s = 0; s < slast; s += 2) {
            na_loadk(s + 1, kfB);
            na_step(s, kfA);
            na_loadk((s + 2 < slast) ? s + 2 : slast, kfA);
            na_step(s + 1, kfB);
        }
        if (nloc & 1) na_step(slast, kfA);
#pragma unroll
        for (int nt = 0; nt < NT; ++nt) { float lt = l[nt]; lt += __shfl_xor(lt, 16); lt += __shfl_xor(lt, 32); const float inv = 1.0f / lt;
            bf16* op = F.MIX + (size_t)(b * SEQ + (rA + nt) * 64 + c) * DM + head * 64 + 4 * fq;
#pragma unroll
            for (int dt = 0; dt < 4; ++dt) { const f32x4 o = O[dt][nt] * inv; u32x2 ow; ow.x = pk2(o[0], o[1]); ow.y = pk2(o[2], o[3]); *(u32x2*)(op + 16 * dt) = ow; } }
    }
    __syncthreads();
}

__device__ __forceinline__ void ph7_mid(const Frame& F) {
    const int gw = blockIdx.x * 8 + F.wave, NGW = F.G * 8;
    int curb = -1; f32x4 c1[4], cA[4], cB[4];
#pragma unroll
    for (int j = 0; j < 4; ++j) { c1[j] = (f32x4){0.f, 0.f, 0.f, 0.f}; cA[j] = c1[j]; cB[j] = c1[j]; }
    for (int row0 = gw; row0 < MLAT; row0 += 2 * NGW) {
        const int nr = (row0 + NGW < MLAT) ? 2 : 1;
        f32x4 v[2][4]; u32x2 yw[2][4]; float sqp[2];
#pragma unroll
        for (int q = 0; q < 2; ++q) { const int row = (q < nr) ? row0 + q * NGW : row0;
#pragma unroll
            for (int j = 0; j < 4; ++j) { v[q][j] = __builtin_nontemporal_load((const f32x4*)(F.x + (size_t)row * DM) + F.lane + 64 * j); yw[q][j] = *((const u32x2*)(F.Y + (size_t)row * DM) + F.lane + 64 * j); }
            sqp[q] = F.lane < 16 ? F.SSQ1[(size_t)row * 16 + F.lane] : 0.f; }
#pragma unroll
        for (int q = 0; q < 2; ++q) { if (q < nr) { const int row = row0 + q * NGW; const int b = row >> 13;
            const float sq1 = wave_sum(sqp[q]);
            if (b != curb) { curb = b;
#pragma unroll
                for (int j = 0; j < 4; ++j) { const int col = 4 * (F.lane + 64 * j); const float* mb = F.MOD + b * NMOD;
                    c1[j] = *(const f32x4*)(mb + 2 * DM + col) * *(const f32x4*)(F.g_post_mix + col);
                    cA[j] = *(const f32x4*)(F.g_pre_ffn + col) * (*(const f32x4*)(mb + 4 * DM + col) + 1.0f); cB[j] = *(const f32x4*)(mb + 3 * DM + col); } }
            const float rstd1 = 1.0f / sqrtf(sq1 * (1.0f / DM) + EPS);
            float ss = 0.f;
#pragma unroll
            for (int j = 0; j < 4; ++j) { const f32x4 y = (f32x4){bflo(yw[q][j].x), bfhi(yw[q][j].x), bflo(yw[q][j].y), bfhi(yw[q][j].y)}; v[q][j] = v[q][j] + c1[j] * (y * rstd1);
                ss += (v[q][j][0] * v[q][j][0] + v[q][j][1] * v[q][j][1]) + (v[q][j][2] * v[q][j][2] + v[q][j][3] * v[q][j][3]);
                u32x2 xw; xw.x = pk2(v[q][j][0], v[q][j][1]); xw.y = pk2(v[q][j][2], v[q][j][3]); *(u32x2*)(F.X1B + (size_t)row * DM + 4 * (F.lane + 64 * j)) = xw; }
            const float rstd2 = 1.0f / sqrtf(wave_sum(ss) * (1.0f / DM) + EPS);
#pragma unroll
            for (int j = 0; j < 4; ++j) { const f32x4 o = v[q][j] * rstd2 * cA[j] + cB[j]; u32x2 wv; wv.x = pk2(o[0], o[1]); wv.y = pk2(o[2], o[3]); *(u32x2*)(F.H + (size_t)row * DM + 4 * (F.lane + 64 * j)) = wv; } } }
    }
}
__device__ __forceinline__ void ph10_final(const Frame& F) {
    const int gw = blockIdx.x * 8 + F.wave, NGW = F.G * 8;
    int curb = -1; f32x4 c2[4];
#pragma unroll
    for (int j = 0; j < 4; ++j) c2[j] = (f32x4){0.f, 0.f, 0.f, 0.f};
    for (int row0 = gw; row0 < MLAT; row0 += 2 * NGW) {
        const int nr = (row0 + NGW < MLAT) ? 2 : 1;
        u32x2 xw[2][4], dw[2][4]; float sp2[2];
#pragma unroll
        for (int q = 0; q < 2; ++q) { const int row = (q < nr) ? row0 + q * NGW : row0;
#pragma unroll
            for (int j = 0; j < 4; ++j) { xw[q][j] = *((const u32x2*)(F.X1B + (size_t)row * DM) + F.lane + 64 * j); dw[q][j] = *((const u32x2*)(F.DOWN + (size_t)row * DM) + F.lane + 64 * j); }
            sp2[q] = F.lane < 16 ? F.SSQ2[(size_t)row * 16 + F.lane] : 0.f; }
#pragma unroll
        for (int q = 0; q < 2; ++q) { if (q < nr) { const int row = row0 + q * NGW; const int b = row >> 13;
            const float sq2 = wave_sum(sp2[q]);
            if (b != curb) { curb = b;
#pragma unroll
                for (int j = 0; j < 4; ++j) { const int col = 4 * (F.lane + 64 * j); const float* mb = F.MOD + b * NMOD; c2[j] = *(const f32x4*)(mb + 5 * DM + col) * *(const f32x4*)(F.g_post_ffn + col); } }
            const float rstd2 = 1.0f / sqrtf(sq2 * (1.0f / DM) + EPS);
#pragma unroll
            for (int j = 0; j < 4; ++j) { const f32x4 x1 = (f32x4){bflo(xw[q][j].x), bfhi(xw[q][j].x), bflo(xw[q][j].y), bfhi(xw[q][j].y)}, d = (f32x4){bflo(dw[q][j].x), bfhi(dw[q][j].x), bflo(dw[q][j].y), bfhi(dw[q][j].y)};
                const f32x4 o = x1 + c2[j] * (d * rstd2); __builtin_nontemporal_store(o, (f32x4*)(F.out + (size_t)row * DM) + F.lane + 64 * j); } } }
    }
}

struct Args { const float* in[20]; float* out; unsigned char* ws; int ph_lo, ph_hi; };
constexpr int NPHASES = 11;

__global__ void __launch_bounds__(NTHREADS, 2) mk_fwd(Args args) {
    extern __shared__ __attribute__((aligned(16))) unsigned char lds[];
    cg::grid_group grid = cg::this_grid();
    Frame F;
    F.lds = lds; F.tid = threadIdx.x; F.lane = F.tid & 63; F.wave = __builtin_amdgcn_readfirstlane(F.tid >> 6); F.G = gridDim.x;
    F.x = args.in[0]; F.c = args.in[1]; F.ctx = args.in[2]; F.c_ctx = args.in[3]; F.w_mod = args.in[4]; F.b_mod = args.in[5]; F.g_pre_mix = args.in[6]; F.g_post_mix = args.in[7];
    F.g_pre_ffn = args.in[8]; F.g_post_ffn = args.in[9]; F.w_in = args.in[10]; F.rpb = args.in[11]; F.wa2_f = args.in[12]; F.ba_f = args.in[13]; F.wa2_b = args.in[14]; F.ba_b = args.in[15];
    F.gla_norm = args.in[16]; F.w_out = args.in[17]; F.w_gu = args.in[18]; F.w_down = args.in[19]; F.out = args.out;
    unsigned char* ws = args.ws;
    F.MOD = (float*)(ws + WS_MOD); F.ROPE = (float*)(ws + WS_ROPE); F.DEC = (float*)(ws + WS_DEC); F.SSQ1 = (float*)(ws + WS_SSQ1); F.SSQ2 = (float*)(ws + WS_SSQ2);
    F.WMAIN = (bf16*)(ws + WS_WMAIN); F.WV = (bf16*)(ws + WS_WV); F.WOUT = (bf16*)(ws + WS_WOUT); F.WGU = (bf16*)(ws + WS_WGU); F.WDOWN = (bf16*)(ws + WS_WDOWN);
    F.H = (bf16*)(ws + WS_H); F.P1 = (bf16*)(ws + WS_P1); F.VT = (bf16*)(ws + WS_VT); F.KV = (bf16*)(ws + WS_KV); F.MIX = (bf16*)(ws + WS_MIX); F.Y = (bf16*)(ws + WS_Y); F.ACT = (bf16*)(ws + WS_ACT); F.DOWN = (bf16*)(ws + WS_DOWN); F.X1B = (bf16*)(ws + WS_X1B);
    PG8_LAS unsigned char* glds = (PG8_LAS unsigned char*)lds;
    const int lo = args.ph_lo, hi = args.ph_hi;
    volatile unsigned* MISC = (volatile unsigned*)(lds + LDS_BYTES - 128);
    if (F.tid < 32) MISC[F.tid] = 0u;
    __syncthreads();
    XcdBarrier xbar = xcd_barrier_post((unsigned*)(ws + WS_CTL) + 4096, MISC + 8);
#define IN(k) (lo <= (k) && (k) < hi)
#define REP(k) ((MK_REP_PHASE == (k)) ? 2 : 1)
#define SEAM(k) do { if (IN(k) && IN((k) + 1)) { if ((k) < MK_CG_SEAMS) grid.sync(); else xcd_barrier(xbar); } } while (0)

    if (IN(0)) for (int rep = 0; rep < REP(0); ++rep) ph0_mod(F);
    SEAM(0);
    if (IN(1)) for (int rep = 0; rep < REP(1); ++rep) ph1_rows(F);
    SEAM(1);
    if (IN(2)) for (int rep = 0; rep < REP(2); ++rep) {
        pg8::Gemm g1{F.H, F.WMAIN, MTOT, LDP, DM}, g2{F.WV, F.H, 1024, MTOT, DM};
        pg8::DualOrder S; S.o1.init(g1, F.G, (int)blockIdx.x); S.o2.init(g2, F.G, (int)blockIdx.x); S.G = F.G; S.c = (int)blockIdx.x;
        pg8::EpiDual E{pg8::EpiStore{F.P1, MTOT}, pg8::EpiStoreBlk{F.VT, 1024}};
        pg8::gemm_phase<pg8::EpiDual, pg8::DualOrder, true, true>(glds, g1, S, E);
    }
    SEAM(2);
    if (IN(3)) { for (int rep = 0; rep < REP(3); ++rep) ph3_gla_kv(F); for (int rep = 0; rep < REP(11); ++rep) ph5_na(F); }
    SEAM(3);
    if (IN(4)) ph4_gla_scan(F);
    if (MK_REP_PHASE == 4) { xcd_barrier(xbar); ph3_gla_kv(F); xcd_barrier(xbar); ph4_gla_scan(F); }
    SEAM(4);
    if (IN(5)) { for (int rep = 0; rep < REP(5); ++rep) ph5_gla_out(F); }
    SEAM(5);
    if (IN(6)) for (int rep = 0; rep < REP(6); ++rep) { pg8::Gemm g{F.MIX, F.WOUT, MLAT, DM, DM}; pg8::StaticOrder S; S.init(g, F.G, (int)blockIdx.x); pg8::EpiStoreSsq E{F.Y, DM, F.SSQ1};
        pg8::gemm_phase<pg8::EpiStoreSsq, pg8::StaticOrder, true, true>(glds, g, S, E); }
    SEAM(6);
    if (IN(7)) for (int rep = 0; rep < REP(7); ++rep) ph7_mid(F);
    SEAM(7);
    if (IN(8)) for (int rep = 0; rep < REP(8); ++rep) { pg8::Gemm g{F.H, F.WGU, MLAT, 2 * FFN, DM}; pg8::StaticOrder S; S.init(g, F.G, (int)blockIdx.x); pg8::EpiSwiglu E{F.ACT, FFN};
        pg8::gemm_phase<pg8::EpiSwiglu, pg8::StaticOrder, true, true>(glds, g, S, E); }
    SEAM(8);
    if (IN(9)) for (int rep = 0; rep < REP(9); ++rep) { pg8::Gemm g{F.ACT, F.WDOWN, MLAT, DM, FFN}; pg8::StaticOrder S; S.init(g, F.G, (int)blockIdx.x, 1); pg8::EpiStoreSsq E{F.DOWN, DM, F.SSQ2};
        pg8::gemm_phase<pg8::EpiStoreSsq, pg8::StaticOrder, true, true>(glds, g, S, E); }
    SEAM(9);
    if (IN(10)) for (int rep = 0; rep < REP(10); ++rep) ph10_final(F);
#undef IN
#undef SEAM
#undef REP
}

extern "C" void kernel_launch(void* const* d_in, const int* in_sizes, int n_in, void* d_out, int out_size, void* d_ws, size_t ws_size, hipStream_t stream) {
    static int grid = 0;
    if (grid == 0) {
        if (n_in != 20 || in_sizes[0] != MLAT * DM || out_size != MLAT * DM || ws_size < WS_END) { fprintf(stderr, "kernel_launch: unexpected shapes (n_in %d, in0 %d, out %d, ws %zu)\n", n_in, n_in > 0 ? in_sizes[0] : -1, out_size, ws_size); grid = -1; return; }
        int dev = 0, cus = 0, per_cu = 0;
        if (hipGetDevice(&dev) != hipSuccess || hipDeviceGetAttribute(&cus, hipDeviceAttributeMultiprocessorCount, dev) != hipSuccess) { fprintf(stderr, "kernel_launch: device query failed\n"); grid = -1; return; }
        if (hipFuncSetAttribute((const void*)mk_fwd, hipFuncAttributeMaxDynamicSharedMemorySize, LDS_BYTES) != hipSuccess) { fprintf(stderr, "kernel_launch: hipFuncSetAttribute failed\n"); grid = -1; return; }
        if (hipOccupancyMaxActiveBlocksPerMultiprocessor(&per_cu, (const void*)mk_fwd, NTHREADS, LDS_BYTES) != hipSuccess || per_cu < 1) { fprintf(stderr, "kernel_launch: occupancy query says %d blocks per CU\n", per_cu); (void)hipGetLastError(); grid = -1; return; }
        grid = cus;
    }
    if (grid < 0) return;
    if (hipMemsetAsync((char*)d_ws + WS_CTL, 0, CTL_ZERO_BYTES, stream) != hipSuccess) { fprintf(stderr, "kernel_launch: hipMemsetAsync failed\n"); return; }
    Args a{};
    for (int i = 0; i < 20; ++i) a.in[i] = (const float*)d_in[i];
    a.out = (float*)d_out; a.ws = (unsigned char*)d_ws;
#if MK_PER_PHASE
    for (int p = 0; p < NPHASES; ++p) { a.ph_lo = p; a.ph_hi = p + 1; void* kargs[] = {&a};
        hipError_t e = hipLaunchCooperativeKernel((const void*)mk_fwd, dim3(grid), dim3(NTHREADS), kargs, LDS_BYTES, stream);
        if (e != hipSuccess) { fprintf(stderr, "kernel_launch: launch of phase %d failed: %s\n", p, hipGetErrorString(e)); break; } }
#else
    a.ph_lo = 0; a.ph_hi = NPHASES; void* kargs[] = {&a};
    hipError_t e = hipLaunchCooperativeKernel((const void*)mk_fwd, dim3(grid), dim3(NTHREADS), kargs, LDS_BYTES, stream);
    if (e != hipSuccess) fprintf(stderr, "kernel_launch: cooperative launch failed: %s (grid %d)\n", hipGetErrorString(e), grid);
#endif
}
```

```cpp
#include <hip/hip_runtime.h>
#include <hip/hip_cooperative_groups.h>
#include <cstdio>
#include <cstdint>
namespace cg = cooperative_groups;

#ifndef MK_PER_PHASE
#define MK_PER_PHASE 0
#endif
#ifndef MK_REP_PHASE
#define MK_REP_PHASE -1
#endif
#ifndef MK_CG_SEAMS
#define MK_CG_SEAMS 0
#endif

namespace pg8 {
#define PG8_LAS __attribute__((address_space(3)))
typedef unsigned short bf16_t;
typedef short bf16x8 __attribute__((ext_vector_type(8)));
typedef float f32x4 __attribute__((ext_vector_type(4)));
typedef unsigned u32x4 __attribute__((ext_vector_type(4)));
constexpr int BM = 256, BK = 64, HALF = 128, HTB = HALF * BK * 2, STAGE_BYTES = 8 * HTB, NXCD = 8, WGM = 8;

__host__ __device__ __forceinline__ int lds_byte(int r, int c) { const int st = (r >> 4) * 2 + (c >> 5), rr = r & 15, cc = c & 31, ob = rr * 64 + cc * 2; return st * 1024 + (ob ^ (((ob >> 9) & 1) << 5)); }
__host__ __device__ __forceinline__ void stage_rc(int b, int& R, int& C) { const int st = b / 1024, sb = b % 1024, swz = sb ^ (((sb >> 9) & 1) << 5); R = (st >> 1) * 16 + swz / 64; C = (st & 1) * 32 + (swz % 64) / 2; }
__host__ __device__ __forceinline__ int perm32(int rho) { const int n = rho >> 4, i = rho & 15; return 8 * (i >> 2) + 4 * n + (i & 3); }

struct Unit { int pm, pn, kind; const char* a; const char* b; };
struct Gemm { const bf16_t* A; const bf16_t* Bt; int M, N, K; };

struct StaticOrder {
    int nM, nN, nwg, G, c, rev; const char* A; const char* Bt; size_t tstep;
    __host__ __device__ void init(const Gemm& g, int G_, int c_, int rev_ = 0) { nM = g.M / BM; nN = g.N / BM; nwg = nM * nN; G = G_; c = c_; rev = rev_; A = (const char*)g.A; Bt = (const char*)g.Bt; tstep = (size_t)BM * g.K * 2; }
    __host__ __device__ void map(int wgid, Unit& u) const {
        { const int q = nwg / NXCD, r = nwg % NXCD, xcd = wgid % NXCD, off = wgid / NXCD; wgid = (xcd < r ? xcd * (q + 1) : r * (q + 1) + (xcd - r) * q) + off; }
        const int nig = WGM * nN, gid = wgid / nig, fm = gid * WGM, gsz = (nM - fm) < WGM ? (nM - fm) : WGM;
        u.pm = fm + ((wgid % nig) % gsz); if (rev) u.pm = nM - 1 - u.pm; u.pn = (wgid % nig) / gsz; u.kind = 0; u.a = A + (size_t)u.pm * tstep; u.b = Bt + (size_t)u.pn * tstep;
    }
    __host__ __device__ bool next(int i, Unit& u) const { const long L = (long)i * G + c; if (L >= nwg) return false; map((int)L, u); return true; }
    __device__ __forceinline__ void a_ready(const Unit&) const {}
    __device__ __forceinline__ void done(const Unit&) const {}
};
struct DualOrder {
    StaticOrder o1, o2; int G, c;
    __host__ __device__ bool next(int i, Unit& u) const { const long L = (long)i * G + c; if (L >= o1.nwg + o2.nwg) return false;
        if (L < o1.nwg) o1.map((int)L, u); else { o2.map((int)(L - o1.nwg), u); u.kind = 1; } return true; }
    __device__ __forceinline__ void a_ready(const Unit&) const {}
    __device__ __forceinline__ void done(const Unit&) const {}
};

__device__ __forceinline__ unsigned cvt_pk_bf16(float lo, float hi) { unsigned r; asm volatile("v_cvt_pk_bf16_f32 %0, %1, %2" : "=v"(r) : "v"(lo), "v"(hi)); return r; }

struct EpiStore {
    static constexpr bool PERM = true, AFTER_DRAIN = false;
    bf16_t* O; int nrows;
    __device__ __forceinline__ void operator()(const f32x4 (&acc)[2][2][4][2], const Unit& u, int wr, int wc, int fr, int fq) const {
        const int row0 = u.pm * BM + wr * 64 + fr, col0 = wc * 32 + 8 * fq; bf16_t* blk = O + (size_t)u.pn * nrows * 256;
#pragma unroll
        for (int ai = 0; ai < 2; ++ai)
#pragma unroll
            for (int m = 0; m < 4; ++m) { bf16_t* rowp = blk + (size_t)(row0 + ai * HALF + m * 16) * 256 + col0;
#pragma unroll
                for (int bj = 0; bj < 2; ++bj) { const f32x4 v0 = acc[ai][bj][m][0], v1 = acc[ai][bj][m][1];
                    u32x4 w; w.x = cvt_pk_bf16(v0[0], v0[1]); w.y = cvt_pk_bf16(v0[2], v0[3]); w.z = cvt_pk_bf16(v1[0], v1[1]); w.w = cvt_pk_bf16(v1[2], v1[3]);
                    *(u32x4*)(rowp + bj * HALF) = w; } }
    }
};
struct EpiStoreBlk {
    static constexpr bool PERM = true, AFTER_DRAIN = false;
    bf16_t* O; int nrows;
    __device__ __forceinline__ void operator()(const f32x4 (&acc)[2][2][4][2], const Unit& u, int wr, int wc, int fr, int fq) const {
        const int row0 = u.pm * BM + wr * 64 + fr;
#pragma unroll
        for (int ai = 0; ai < 2; ++ai)
#pragma unroll
            for (int m = 0; m < 4; ++m) { const int r = row0 + ai * HALF + m * 16;
#pragma unroll
                for (int bj = 0; bj < 2; ++bj) { const f32x4 v0 = acc[ai][bj][m][0], v1 = acc[ai][bj][m][1];
                    u32x4 w; w.x = cvt_pk_bf16(v0[0], v0[1]); w.y = cvt_pk_bf16(v0[2], v0[3]); w.z = cvt_pk_bf16(v1[0], v1[1]); w.w = cvt_pk_bf16(v1[2], v1[3]);
                    const int g32 = u.pn * 8 + bj * 4 + wc;
                    *(u32x4*)(O + ((size_t)g32 * (nrows >> 4) + (r >> 4)) * 512 + fq * 128 + (r & 15) * 8) = w; } }
    }
};
struct EpiDual {
    static constexpr bool PERM = true, AFTER_DRAIN = false;
    EpiStore e0; EpiStoreBlk e1;
    __device__ __forceinline__ void operator()(const f32x4 (&acc)[2][2][4][2], const Unit& u, int wr, int wc, int fr, int fq) const { if (u.kind == 0) e0(acc, u, wr, wc, fr, fq); else e1(acc, u, wr, wc, fr, fq); }
};
struct EpiStoreSsq {
    static constexpr bool PERM = true, AFTER_DRAIN = false;
    bf16_t* O; int ldc; float* ssq;
    __device__ __forceinline__ void operator()(const f32x4 (&acc)[2][2][4][2], const Unit& u, int wr, int wc, int fr, int fq) const {
        const int row0 = u.pm * BM + wr * 64 + fr, col0 = u.pn * BM + wc * 32 + 8 * fq;
#pragma unroll
        for (int ai = 0; ai < 2; ++ai)
#pragma unroll
            for (int m = 0; m < 4; ++m) { const int row = row0 + ai * HALF + m * 16; bf16_t* rowp = O + (size_t)row * ldc + col0; float s = 0.f;
#pragma unroll
                for (int bj = 0; bj < 2; ++bj) { const f32x4 v0 = acc[ai][bj][m][0], v1 = acc[ai][bj][m][1];
                    s += (v0[0] * v0[0] + v0[1] * v0[1]) + (v0[2] * v0[2] + v0[3] * v0[3]) + (v1[0] * v1[0] + v1[1] * v1[1]) + (v1[2] * v1[2] + v1[3] * v1[3]);
                    u32x4 w; w.x = cvt_pk_bf16(v0[0], v0[1]); w.y = cvt_pk_bf16(v0[2], v0[3]); w.z = cvt_pk_bf16(v1[0], v1[1]); w.w = cvt_pk_bf16(v1[2], v1[3]);
                    *(u32x4*)(rowp + bj * HALF) = w; }
                s += __shfl_xor(s, 16); s += __shfl_xor(s, 32);
                if (fq == 0) ssq[(size_t)row * 16 + u.pn * 4 + wc] = s; }
    }
};
struct EpiSwiglu {
    static constexpr bool PERM = true, AFTER_DRAIN = false;
    bf16_t* O; int ldc;
    __device__ __forceinline__ void operator()(const f32x4 (&acc)[2][2][4][2], const Unit& u, int wr, int wc, int fr, int fq) const {
        const int row0 = u.pm * BM + wr * 64 + fr, col0 = u.pn * HALF + wc * 32 + 8 * fq;
#pragma unroll
        for (int ai = 0; ai < 2; ++ai)
#pragma unroll
            for (int m = 0; m < 4; ++m) { bf16_t* rowp = O + (size_t)(row0 + ai * HALF + m * 16) * ldc + col0; float a[8];
#pragma unroll
                for (int n = 0; n < 2; ++n)
#pragma unroll
                    for (int i = 0; i < 4; ++i) { const float g = acc[ai][0][m][n][i], uu = acc[ai][1][m][n][i]; a[n * 4 + i] = g * __builtin_amdgcn_rcpf(1.0f + __expf(-g)) * uu; }
                u32x4 w; w.x = cvt_pk_bf16(a[0], a[1]); w.y = cvt_pk_bf16(a[2], a[3]); w.z = cvt_pk_bf16(a[4], a[5]); w.w = cvt_pk_bf16(a[6], a[7]);
                *(u32x4*)rowp = w; }
    }
};

template <class Epi, class Sched, bool ALIGN_EPI = false, bool SP2 = false>
__device__ __forceinline__ void gemm_phase(PG8_LAS unsigned char* lds, const Gemm g, const Sched& S, const Epi& E) {
    const int tid = threadIdx.x, wid = __builtin_amdgcn_readfirstlane(tid >> 6), lane = tid & 63, wr = wid >> 2, wc = wid & 3, fr = lane & 15, fq = lane >> 4;
    const int K = g.K, nt = K / BK;
    unsigned voffA[2], voffB[2];
#pragma unroll
    for (int i = 0; i < 2; ++i) { int R, C; stage_rc(tid * 16 + i * 8192, R, C); const int Rb = Epi::PERM ? ((R & ~31) + perm32(R & 31)) : R;
        voffA[i] = (unsigned)(R * K + C) * 2u; voffB[i] = (unsigned)(Rb * K + C) * 2u; }
    const size_t kstep = (size_t)(BK * 2);
    const size_t hstep = (size_t)HALF * K * 2;
    const unsigned ldsw = (unsigned)wid * 1024u;
    const int aoff = lds_byte(wr * 64 + fr, fq * 8), boff = lds_byte(wc * 32 + fr, fq * 8);
#define PG8_SA(b, h) (((b) * 2 + (h)) * HTB)
#define PG8_SB(b, h) ((4 + (b) * 2 + (h)) * HTB)
#define PG8_STAGE(bufoff, gbase, voff) do { _Pragma("unroll") for (int _i = 0; _i < 2; ++_i) \
        __builtin_amdgcn_global_load_lds((const unsigned*)((const char*)(gbase) + (voff)[_i]), (PG8_LAS unsigned*)(lds + (bufoff) + ldsw + _i * 8192), 16, 0, 0); } while (0)
#define PG8_LDA(dst, b, h) do { _Pragma("unroll") for (int m = 0; m < 4; ++m) _Pragma("unroll") for (int k = 0; k < 2; ++k) dst[m][k] = *(const PG8_LAS bf16x8*)(lds + PG8_SA(b, h) + aoff + m * 2048 + k * 1024); } while (0)
#define PG8_LDB(dst, b, h) do { _Pragma("unroll") for (int n = 0; n < 2; ++n) _Pragma("unroll") for (int k = 0; k < 2; ++k) dst[n][k] = *(const PG8_LAS bf16x8*)(lds + PG8_SB(b, h) + boff + n * 2048 + k * 1024); } while (0)
#define PG8_MMA(ai, bj, At, Bt) do { __builtin_amdgcn_s_setprio(1); _Pragma("unroll") for (int m = 0; m < 4; ++m) _Pragma("unroll") for (int n = 0; n < 2; ++n) _Pragma("unroll") for (int k = 0; k < 2; ++k) \
        acc[ai][bj][m][n] = __builtin_amdgcn_mfma_f32_16x16x32_bf16(Bt[n][k], At[m][k], acc[ai][bj][m][n], 0, 0, 0); __builtin_amdgcn_s_setprio(0); } while (0)
#define PG8_WAIT_V(n) asm volatile("s_waitcnt vmcnt(" #n ")" ::: "memory")
#define PG8_WAIT_L(n) asm volatile("s_waitcnt lgkmcnt(" #n ")" ::: "memory")
#define PG8_BAR __builtin_amdgcn_s_barrier()
#define PG8_SCHED __builtin_amdgcn_sched_barrier(0)
    Unit cur, nxt; int ui = 0;
    if (!S.next(0, cur)) return;
    f32x4 acc[2][2][4][2];
#pragma unroll
    for (int a = 0; a < 2; ++a)
#pragma unroll
        for (int b = 0; b < 2; ++b)
#pragma unroll
            for (int m = 0; m < 4; ++m)
#pragma unroll
                for (int n = 0; n < 2; ++n) acc[a][b][m][n] = (f32x4){0.f, 0.f, 0.f, 0.f};
    bf16x8 At[4][2], B0[2][2], B1[2][2];
    const char* cA = cur.a; const char* cB = cur.b;
    S.a_ready(cur);
    if constexpr (SP2) {
        PG8_STAGE(PG8_SB(0, 0), cB, voffB); PG8_STAGE(PG8_SB(0, 1), cB + hstep, voffB); PG8_STAGE(PG8_SA(0, 0), cA, voffA); PG8_STAGE(PG8_SA(0, 1), cA + hstep, voffA);
        if (wr == 1) PG8_BAR;
        PG8_WAIT_V(2); PG8_BAR;
        PG8_STAGE(PG8_SB(1, 0), cB + kstep, voffB); PG8_STAGE(PG8_SA(1, 0), cA + kstep, voffA); PG8_STAGE(PG8_SB(1, 1), cB + hstep + kstep, voffB);
        PG8_WAIT_V(6); PG8_BAR;
    } else {
        PG8_STAGE(PG8_SB(0, 0), cB, voffB); PG8_STAGE(PG8_SA(0, 0), cA, voffA); PG8_STAGE(PG8_SB(0, 1), cB + hstep, voffB); PG8_STAGE(PG8_SA(0, 1), cA + hstep, voffA);
        if (wr == 1) PG8_BAR;
        PG8_WAIT_V(4); PG8_BAR;
        PG8_STAGE(PG8_SB(1, 0), cB + kstep, voffB); PG8_STAGE(PG8_SA(1, 0), cA + kstep, voffA); PG8_STAGE(PG8_SB(1, 1), cB + hstep + kstep, voffB);
        PG8_WAIT_V(6); PG8_BAR;
    }
    for (;;) {
        const bool has_next = S.next(ui + 1, nxt);
        const char* nA = has_next ? nxt.a : cA; const char* nB = has_next ? nxt.b : cB;
        for (int t = 0; t < nt; t += 2) {
            const bool last = (t == nt - 2);
            const char* a1 = cA + (size_t)(t + 1) * kstep;
            const char* a2 = last ? nA : cA + (size_t)(t + 2) * kstep; const char* b2 = last ? nB : cB + (size_t)(t + 2) * kstep;
            const char* a3 = a2 + kstep; const char* b3 = b2 + kstep;
            if (last && has_next) S.a_ready(nxt);
            if constexpr (SP2) {
            PG8_LDB(B0, 0, 0); PG8_LDB(B1, 0, 1); PG8_SCHED; PG8_LDA(At, 0, 0); PG8_STAGE(PG8_SA(1, 1), a1 + hstep, voffA);
            PG8_WAIT_V(8); PG8_WAIT_L(0); PG8_BAR; PG8_MMA(0, 0, At, B0); PG8_MMA(0, 1, At, B1); PG8_BAR; PG8_SCHED;
            PG8_LDA(At, 0, 1); PG8_STAGE(PG8_SB(0, 0), b2, voffB); PG8_STAGE(PG8_SB(0, 1), b2 + hstep, voffB); PG8_STAGE(PG8_SA(0, 0), a2, voffA);
            PG8_WAIT_V(8); PG8_WAIT_L(0); PG8_BAR; PG8_MMA(1, 0, At, B0); PG8_MMA(1, 1, At, B1); PG8_BAR; PG8_SCHED;
            PG8_LDB(B0, 1, 0); PG8_LDB(B1, 1, 1); PG8_SCHED; PG8_LDA(At, 1, 0); PG8_STAGE(PG8_SA(0, 1), a2 + hstep, voffA);
            PG8_WAIT_V(8); PG8_WAIT_L(0); PG8_BAR; PG8_MMA(0, 0, At, B0); PG8_MMA(0, 1, At, B1); PG8_BAR; PG8_SCHED;
            PG8_LDA(At, 1, 1); PG8_STAGE(PG8_SB(1, 0), b3, voffB); PG8_STAGE(PG8_SB(1, 1), b3 + hstep, voffB); PG8_STAGE(PG8_SA(1, 0), a3, voffA);
            PG8_WAIT_V(8); PG8_WAIT_L(0); PG8_BAR; PG8_MMA(1, 0, At, B0); PG8_MMA(1, 1, At, B1); PG8_BAR; PG8_SCHED;
            } else {
            PG8_LDB(B0, 0, 0); PG8_SCHED; PG8_LDA(At, 0, 0); PG8_STAGE(PG8_SA(1, 1), a1 + hstep, voffA);
            PG8_WAIT_L(8); PG8_BAR; PG8_WAIT_L(0); PG8_MMA(0, 0, At, B0); PG8_BAR; PG8_SCHED;
            PG8_LDB(B1, 0, 1); PG8_STAGE(PG8_SB(0, 0), b2, voffB);
            PG8_BAR; PG8_WAIT_L(0); PG8_MMA(0, 1, At, B1); PG8_BAR;
            PG8_LDA(At, 0, 1); PG8_STAGE(PG8_SA(0, 0), a2, voffA);
            PG8_BAR; PG8_WAIT_L(0); PG8_MMA(1, 0, At, B0); PG8_BAR; PG8_SCHED;
            PG8_STAGE(PG8_SB(0, 1), b2 + hstep, voffB);
            PG8_WAIT_V(6); PG8_BAR; PG8_MMA(1, 1, At, B1); PG8_BAR;
            PG8_LDB(B0, 1, 0); PG8_SCHED; PG8_LDA(At, 1, 0); PG8_STAGE(PG8_SA(0, 1), a2 + hstep, voffA);
            PG8_WAIT_L(8); PG8_BAR; PG8_WAIT_L(0); PG8_MMA(0, 0, At, B0); PG8_BAR; PG8_SCHED;
            PG8_LDB(B1, 1, 1); PG8_STAGE(PG8_SB(1, 0), b3, voffB);
            PG8_BAR; PG8_WAIT_L(0); PG8_MMA(0, 1, At, B1); PG8_BAR;
            PG8_LDA(At, 1, 1); PG8_STAGE(PG8_SA(1, 0), a3, voffA);
            PG8_BAR; PG8_WAIT_L(0); PG8_MMA(1, 0, At, B0); PG8_BAR; PG8_SCHED;
            PG8_STAGE(PG8_SB(1, 1), b3 + hstep, voffB);
            PG8_WAIT_V(6); PG8_BAR; PG8_MMA(1, 1, At, B1); PG8_BAR;
            }
        }
        if constexpr (ALIGN_EPI) { if (wr == 0) PG8_BAR; }
        if constexpr (!Epi::AFTER_DRAIN) { E(acc, cur, wr, wc, fr, fq); S.done(cur); }
        if (!has_next) break;
#pragma unroll
        for (int a = 0; a < 2; ++a)
#pragma unroll
            for (int b = 0; b < 2; ++b)
#pragma unroll
                for (int m = 0; m < 4; ++m)
#pragma unroll
                    for (int n = 0; n < 2; ++n) acc[a][b][m][n] = (f32x4){0.f, 0.f, 0.f, 0.f};
        cur = nxt; cA = nA; cB = nB; ++ui;
        if constexpr (ALIGN_EPI) { if (wr == 1) PG8_BAR; }
    }
    PG8_WAIT_V(0);
    if constexpr (!ALIGN_EPI) { if (wr == 0) PG8_BAR; }
    PG8_BAR;
#undef PG8_SA
#undef PG8_SB
#undef PG8_STAGE
#undef PG8_LDA
#undef PG8_LDB
#undef PG8_MMA
#undef PG8_WAIT_V
#undef PG8_WAIT_L
#undef PG8_BAR
#undef PG8_SCHED
}
}

typedef unsigned short bf16;
typedef short bf16x8 __attribute__((ext_vector_type(8)));
typedef float f32x4 __attribute__((ext_vector_type(4)));
typedef unsigned u32x4 __attribute__((ext_vector_type(4)));
typedef unsigned u32x2 __attribute__((ext_vector_type(2)));
#define LAS __attribute__((address_space(3)))

constexpr int NB = 8, SEQ = 8192, DM = 1024, CTXL = 256;
constexpr int MLAT = NB * SEQ, MCTX = NB * CTXL, MTOT = MLAT + MCTX;
constexpr int LDP = 2304;
constexpr int CQ = 0, CK = 512, CGQ = 1024, CGK = 1280, CGR = 1536, CAF = 2048, CAB = 2064;
__device__ __forceinline__ size_t vt_off(int row, int tok) { return ((size_t)(tok >> 5) * 64 + (row >> 4)) * 512 + ((tok >> 3) & 3) * 128 + (row & 15) * 8; }
__device__ __forceinline__ size_t p1_off(int row, int col) { return ((size_t)(col >> 8) * MTOT + row) * 256 + (col & 255); }
constexpr int FFN = 2816, NMOD = 6 * DM;
constexpr int NCH = 132;
constexpr float EPS = 1e-6f;

constexpr size_t MiB = 1u << 20;
constexpr size_t WS_CTL = 0, CTL_ZERO_BYTES = 1 * MiB;
constexpr size_t WS_MOD = 1 * MiB;
constexpr size_t WS_ROPE = 1 * MiB + 512 * 1024;
constexpr size_t WS_WMAIN = 2 * MiB;
constexpr size_t WS_WV = 7 * MiB;
constexpr size_t WS_WOUT = 9 * MiB;
constexpr size_t WS_WGU = 11 * MiB;
constexpr size_t WS_WDOWN = 22 * MiB;
constexpr size_t WS_H = 32 * MiB;
constexpr size_t WS_P1 = 164 * MiB;
constexpr size_t WS_VT = 461 * MiB;
constexpr size_t WS_KV = 593 * MiB;
constexpr size_t WS_DEC = 725 * MiB;
constexpr size_t WS_SSQ1 = 728 * MiB;
constexpr size_t WS_SSQ2 = 732 * MiB;
constexpr size_t WS_MIX = 736 * MiB;
constexpr size_t WS_Y = WS_KV;
constexpr size_t WS_ACT = WS_P1;
constexpr size_t WS_DOWN = WS_MIX;
constexpr size_t WS_X1B = 864 * MiB;
constexpr size_t WS_END = 992 * MiB;
static_assert(WS_P1 + (size_t)MTOT * LDP * 2 <= WS_VT && WS_VT + (size_t)1024 * MTOT * 2 <= WS_KV && WS_KV + (size_t)64 * NCH * 128 * 64 * 2 <= WS_DEC, "ws map");
static_assert(WS_ACT + (size_t)MLAT * FFN * 2 <= WS_KV && WS_H + (size_t)MTOT * DM * 2 <= WS_P1 && WS_MIX + (size_t)MLAT * DM * 2 <= WS_END, "ws map 2");

constexpr int LDS_BYTES = 147456;
constexpr int NTHREADS = 512;

__device__ __forceinline__ unsigned f2bf(float f) { unsigned u = __builtin_bit_cast(unsigned, f); return (u + 0x7fffu + ((u >> 16) & 1u)) >> 16; }
typedef float f32x2_t __attribute__((ext_vector_type(2)));
typedef __bf16 bf16x2_t __attribute__((ext_vector_type(2)));
__device__ __forceinline__ unsigned pk2(float lo, float hi) { const f32x2_t v = {lo, hi}; return __builtin_bit_cast(unsigned, __builtin_convertvector(v, bf16x2_t)); }
__device__ __forceinline__ float bflo(unsigned w) { return __builtin_bit_cast(float, w << 16); }
__device__ __forceinline__ float bfhi(unsigned w) { return __builtin_bit_cast(float, w & 0xffff0000u); }
__device__ __forceinline__ float wave_sum(float v) {
#pragma unroll
    for (int o = 1; o < 64; o <<= 1) v += __shfl_xor(v, o);
    return v;
}
__device__ __forceinline__ void unpack8(const u32x4 w, float (&o)[8]) { o[0] = bflo(w.x); o[1] = bfhi(w.x); o[2] = bflo(w.y); o[3] = bfhi(w.y); o[4] = bflo(w.z); o[5] = bfhi(w.z); o[6] = bflo(w.w); o[7] = bfhi(w.w); }
__device__ __forceinline__ float logsig16(float z) { return (fminf(z, 0.f) - __logf(1.0f + __expf(-fabsf(z)))) * (1.0f / 16.0f); }

#define XB_TMO      128
#define XB_XCNT(j)  (256  + 64 * (j))
#define XB_XSUB(j)  (1280 + 64 * (j))
#define XB_XGEN(j)  (2304 + 64 * (j))
#define XB_TOP      3328
#define XB_TOPGEN   3392
#define XCD_BAR_WORDS 3456
#define XB_SPIN_CAP (1u << 18)
__device__ __forceinline__ unsigned xb_ld(unsigned* p)              { return __hip_atomic_load(p, __ATOMIC_RELAXED, __HIP_MEMORY_SCOPE_AGENT); }
__device__ __forceinline__ unsigned xb_add(unsigned* p, unsigned v) { return __hip_atomic_fetch_add(p, v, __ATOMIC_RELAXED, __HIP_MEMORY_SCOPE_AGENT); }
__device__ __forceinline__ unsigned xb_xcc_id() { return (unsigned)__builtin_amdgcn_s_getreg((3 << 11) | 20) & 0xFu; }
#define XB_SPIN(cond, bar) do { unsigned _sp = 0; while (cond) { __builtin_amdgcn_s_sleep(1); \
    if ((++_sp & 255u) == 0u) { if (xb_ld(&(bar)[XB_TMO])) break; if (_sp > XB_SPIN_CAP) { atomicAdd(&(bar)[XB_TMO], 1u); break; } } } } while (0)
struct XcdBarrier { unsigned* bar; unsigned x; volatile unsigned* st; };
__device__ __forceinline__ XcdBarrier xcd_barrier_post(unsigned* bar, volatile unsigned* st) {
    XcdBarrier b; b.bar = bar; b.x = xb_xcc_id(); b.st = st;
    if (threadIdx.x == 0) (void)xb_add(&bar[XB_XCNT(b.x)], 1u);
    return b;
}
__device__ __forceinline__ void xcd_barrier_complete(unsigned* bar, unsigned x, unsigned& nloc, unsigned& nx) {
    const unsigned G = gridDim.x * gridDim.y * gridDim.z;
    unsigned sum, cnt, mine, sp = 0u;
    for (;;) {
        sum = 0u; cnt = 0u; mine = 0u;
#pragma unroll
        for (unsigned j = 0; j < 16; ++j) { const unsigned c = xb_ld(&bar[XB_XCNT(j)]); sum += c; cnt += (c > 0u) ? 1u : 0u; mine = (j == x) ? c : mine; }
        if (sum == G) break;
        __builtin_amdgcn_s_sleep(1);
        if ((++sp & 255u) == 0u) { if (xb_ld(&bar[XB_TMO])) break; if (sp > XB_SPIN_CAP) { atomicAdd(&bar[XB_TMO], 1u); break; } }
    }
    nloc = mine > 0u ? mine : 1u; nx = cnt > 0u ? cnt : 1u;
}
__device__ __forceinline__ void xcd_barrier(const XcdBarrier& b) {
    asm volatile("s_waitcnt vmcnt(0)" ::: "memory");
    __syncthreads();
    if (threadIdx.x == 0) {
        unsigned* bar = b.bar;
        __builtin_amdgcn_s_waitcnt(0);
        unsigned nloc = b.st[0], nx = b.st[1];
        if (nloc == 0u) { xcd_barrier_complete(bar, b.x, nloc, nx); b.st[0] = nloc; b.st[1] = nx; }
        const unsigned old = xb_add(&bar[XB_XSUB(b.x)], 1u);
        const unsigned gen = old / nloc;
        if (old + 1u == (gen + 1u) * nloc) {
            __builtin_amdgcn_fence(__ATOMIC_RELEASE, "agent");
            asm volatile("s_waitcnt vmcnt(0)" ::: "memory");
            const unsigned og = xb_add(&bar[XB_TOP], 1u);
            const unsigned tg = og / nx;
            if (og + 1u == (tg + 1u) * nx) xb_add(&bar[XB_TOPGEN], 1u);
            else XB_SPIN(xb_ld(&bar[XB_TOPGEN]) == tg, bar);
            __builtin_amdgcn_fence(__ATOMIC_ACQUIRE, "agent");
            xb_add(&bar[XB_XGEN(b.x)], 1u);
            asm volatile("s_waitcnt vmcnt(0)" ::: "memory");
        } else {
            XB_SPIN(xb_ld(&bar[XB_XGEN(b.x)]) == gen, bar);
            __builtin_amdgcn_fence(__ATOMIC_ACQUIRE, "agent");
            asm volatile("s_waitcnt vmcnt(0)" ::: "memory");
        }
    }
    __syncthreads();
}

struct Frame {
    unsigned char* lds;
    int tid, lane, wave, G;
    const float *x, *c, *ctx, *c_ctx, *w_mod, *b_mod, *g_pre_mix, *g_post_mix, *g_pre_ffn, *g_post_ffn, *w_in, *rpb, *wa2_f, *ba_f, *wa2_b, *ba_b, *gla_norm, *w_out, *w_gu, *w_down;
    float* out;
    float *MOD, *ROPE, *DEC, *SSQ1, *SSQ2;
    bf16 *WMAIN, *WV, *WOUT, *WGU, *WDOWN, *H, *P1, *VT, *KV, *MIX, *Y, *ACT, *DOWN, *X1B;
};

__device__ __forceinline__ void ph0_mod(const Frame& F) {
    float* S = (float*)F.lds;
    float* PART = S + 9 * 1024;
    for (int i = F.tid; i < 9 * 1024; i += NTHREADS) { const int r = i >> 10, k = i & 1023; const float v = r < 8 ? F.c[r * 1024 + k] : F.c_ctx[k]; S[i] = v / (1.0f + expf(-v)); }
    __syncthreads();
    for (int cgp = blockIdx.x; cgp < 256; cgp += F.G) {
        const int n0 = cgp * 24, cgi = F.tid % 6, ks = F.tid / 6;
        float acc[9][4];
#pragma unroll
        for (int r = 0; r < 9; ++r)
#pragma unroll
            for (int j = 0; j < 4; ++j) acc[r][j] = 0.f;
        if (ks < 85) {
            for (int k = ks; k < 1024; k += 85) { const f32x4 w = *(const f32x4*)(F.w_mod + (size_t)k * NMOD + n0 + 4 * cgi);
#pragma unroll
                for (int r = 0; r < 9; ++r) { const float s = S[r * 1024 + k]; acc[r][0] += s * w[0]; acc[r][1] += s * w[1]; acc[r][2] += s * w[2]; acc[r][3] += s * w[3]; } }
#pragma unroll
            for (int r = 0; r < 9; ++r)
#pragma unroll
                for (int j = 0; j < 4; ++j) PART[(ks * 9 + r) * 24 + cgi * 4 + j] = acc[r][j];
        }
        __syncthreads();
        if (F.tid < 216) { const int r = F.tid / 24, col = F.tid % 24; float s = 0.f; for (int k2 = 0; k2 < 85; ++k2) s += PART[(k2 * 9 + r) * 24 + col]; F.MOD[r * NMOD + n0 + col] = s + F.b_mod[n0 + col]; }
        __syncthreads();
    }
    for (int i = blockIdx.x * NTHREADS + F.tid; i < 128 * 16; i += F.G * NTHREADS) {
        const int pos = i >> 4, ii = i & 15; const float inv = (float)pow(10000.0, -(double)ii / 16.0); const float ang = (float)pos * inv;
        F.ROPE[i] = (float)cos((double)ang); F.ROPE[2048 + i] = (float)sin((double)ang);
    }
}

__device__ __forceinline__ void transpose_item(const float* W, int ldn, int k0, int nsrc0, bf16* WT, int ldk, int drow0, float* scr, int lane) {
#pragma unroll 8
    for (int i = 0; i < 32; ++i) { const int kk = 2 * i + (lane >> 5); scr[kk * 33 + (lane & 31)] = W[(size_t)(k0 + kk) * ldn + nsrc0 + (lane & 31)]; }
    __builtin_amdgcn_wave_barrier();
    const int c = lane & 7;
#pragma unroll
    for (int j = 0; j < 4; ++j) { const int n = (lane >> 3) + 8 * j; const float* s = scr + (8 * c) * 33 + n;
        u32x4 o; o.x = pk2(s[0 * 33], s[1 * 33]); o.y = pk2(s[2 * 33], s[3 * 33]); o.z = pk2(s[4 * 33], s[5 * 33]); o.w = pk2(s[6 * 33], s[7 * 33]);
        *(u32x4*)(WT + (size_t)(drow0 + n) * ldk + k0 + 8 * c) = o; }
    __builtin_amdgcn_wave_barrier();
}
constexpr int TI_MAIN = 16 * 65, TI_V = 16 * 32, TI_OUT = 16 * 32, TI_GU = 16 * 176, TI_DOWN = 44 * 32, TI_ALL = TI_MAIN + TI_V + TI_OUT + TI_GU + TI_DOWN;
__device__ __forceinline__ void transpose_dispatch(const Frame& F, int it, float* scr) {
    int r = it;
    if (r < TI_MAIN) { const int kb = r / 65, nb = r % 65, dr = nb * 32; const int sc = dr < 1024 ? dr : (dr < 1536 ? dr + 512 : dr + 1024); transpose_item(F.w_in, 3104, kb * 64, sc, F.WMAIN, DM, dr, scr, F.lane); return; } r -= TI_MAIN;
    if (r < TI_V) { const int kb = r / 32, nb = r % 32, dr = nb * 32; const int sc = dr < 512 ? dr + 1024 : dr + 1536; transpose_item(F.w_in, 3104, kb * 64, sc, F.WV, DM, dr, scr, F.lane); return; } r -= TI_V;
    if (r < TI_OUT) { const int kb = r / 32, nb = r % 32; transpose_item(F.w_out, DM, kb * 64, nb * 32, F.WOUT, DM, nb * 32, scr, F.lane); return; } r -= TI_OUT;
    if (r < TI_GU) { const int kb = r / 176, nb = r % 176, dr = nb * 32, pn = dr >> 8, jj = dr & 255; const int sc = jj < 128 ? 128 * pn + jj : FFN + 128 * pn + (jj - 128); transpose_item(F.w_gu, 2 * FFN, kb * 64, sc, F.WGU, DM, dr, scr, F.lane); return; } r -= TI_GU;
    { const int kb = r / 32, nb = r % 32; transpose_item(F.w_down, DM, kb * 64, nb * 32, F.WDOWN, FFN, nb * 32, scr, F.lane); }
}
__device__ __forceinline__ void ph2_tail_weights(const Frame& F, int nunits) {
    const int nfull = nunits % F.G, c = (int)blockIdx.x;
    const int rank = (c >= nfull) ? c - nfull : -1, nidle = F.G - nfull;
    __syncthreads();
    if (rank < 0) return;
    float* scr = (float*)(F.lds + F.wave * 16384);
    for (int it = TI_MAIN + TI_V + rank * 8 + F.wave; it < TI_ALL; it += nidle * 8) transpose_dispatch(F, it, scr);
}
__device__ __forceinline__ void ph1_rows(const Frame& F) {
    const int gw = blockIdx.x * 8 + F.wave, NGW = F.G * 8;
    int curb = -1; f32x4 cA[4], cB[4];
#pragma unroll
    for (int j = 0; j < 4; ++j) { cA[j] = (f32x4){0.f, 0.f, 0.f, 0.f}; cB[j] = cA[j]; }
    for (int row0 = gw; row0 < MTOT; row0 += 2 * NGW) {
        const int nr = (row0 + NGW < MTOT) ? 2 : 1;
        f32x4 v[2][4];
#pragma unroll
        for (int q = 0; q < 2; ++q) { const int row = (q < nr) ? row0 + q * NGW : row0; const float* src = row < MLAT ? F.x + (size_t)row * DM : F.ctx + (size_t)(row - MLAT) * DM;
#pragma unroll
            for (int j = 0; j < 4; ++j) v[q][j] = __builtin_nontemporal_load((const f32x4*)src + F.lane + 64 * j); }
#pragma unroll
        for (int q = 0; q < 2; ++q) { if (q < nr) { const int row = row0 + q * NGW; const int b = row < MLAT ? (row >> 13) : 8; float ss = 0.f;
#pragma unroll
            for (int j = 0; j < 4; ++j) ss += (v[q][j][0] * v[q][j][0] + v[q][j][1] * v[q][j][1]) + (v[q][j][2] * v[q][j][2] + v[q][j][3] * v[q][j][3]);
            if (b != curb) { curb = b;
#pragma unroll
                for (int j = 0; j < 4; ++j) { const int col = 4 * (F.lane + 64 * j); const f32x4 g = *(const f32x4*)(F.g_pre_mix + col), sh = *(const f32x4*)(F.MOD + b * NMOD + col), sc = *(const f32x4*)(F.MOD + b * NMOD + DM + col);
                    cA[j] = g * (sc + 1.0f); cB[j] = sh; } }
            const float rstd = 1.0f / sqrtf(wave_sum(ss) * (1.0f / DM) + EPS);
#pragma unroll
            for (int j = 0; j < 4; ++j) { const f32x4 o = v[q][j] * rstd * cA[j] + cB[j]; u32x2 w; w.x = pk2(o[0], o[1]); w.y = pk2(o[2], o[3]); *(u32x2*)(F.H + (size_t)row * DM + 4 * (F.lane + 64 * j)) = w; } } }
    }
    float* scr = (float*)(F.lds + F.wave * 16384);
    for (int it = gw; it < TI_MAIN + TI_V; it += NGW) transpose_dispatch(F, it, scr);
    for (int i = blockIdx.x * NTHREADS + F.tid; i < 224 * 1024 / 8; i += F.G * NTHREADS) *((u32x4*)(F.WMAIN + (size_t)2080 * DM) + i) = (u32x4){0u, 0u, 0u, 0u};
}

struct RopeCS { f32x4 c0, c1, s0, s1; };
__device__ __forceinline__ void rope_cs_issue(const float* rope, int dc, int posr, int posc, RopeCS& R) {
    const int pos = (dc >> 2) ? posc : posr, i0 = 8 * (dc & 1);
    R.c0 = *(const f32x4*)(rope + pos * 16 + i0); R.c1 = *(const f32x4*)(rope + pos * 16 + i0 + 4); R.s0 = *(const f32x4*)(rope + 2048 + pos * 16 + i0); R.s1 = *(const f32x4*)(rope + 2048 + pos * 16 + i0 + 4);
}
__device__ __forceinline__ int rope_partner(int dc) { return ((dc & 3) < 2) ? dc + 2 : dc - 2; }
__device__ __forceinline__ void rope_apply(const u32x4 mine, const u32x4 part, const RopeCS& R, int dc, bool do_rope, float (&o)[8]) {
    float a[8]; unpack8(mine, a);
    if (!do_rope) {
#pragma unroll
        for (int j = 0; j < 8; ++j) o[j] = a[j];
        return; }
    float p[8]; unpack8(part, p);
    const bool first = (dc & 3) < 2;
    const float cs[8] = {R.c0[0], R.c0[1], R.c0[2], R.c0[3], R.c1[0], R.c1[1], R.c1[2], R.c1[3]}, sn[8] = {R.s0[0], R.s0[1], R.s0[2], R.s0[3], R.s1[0], R.s1[1], R.s1[2], R.s1[3]};
#pragma unroll
    for (int j = 0; j < 8; ++j) o[j] = first ? (a[j] * cs[j] - p[j] * sn[j]) : (p[j] * sn[j] + a[j] * cs[j]);
}
__device__ __forceinline__ void stage_gate_weights(const Frame& F, u32x4* WB, float* BAS) {
    for (int e = F.tid; e < 2048; e += NTHREADS) { const int ln = e & 63, dt = (e >> 6) & 3, dirh = e >> 8, fq = ln >> 4, dd = ln & 15; const float* wa = (dirh >> 2) ? F.wa2_b : F.wa2_f; const int hh = dirh & 3;
        u32x4 v = (u32x4){0u, 0u, 0u, 0u};
        if (fq < 2) { float t[8];
#pragma unroll
            for (int jj = 0; jj < 8; ++jj) t[jj] = wa[(8 * fq + jj) * 256 + hh * 64 + 16 * dt + dd];
            v.x = pk2(t[0], t[1]); v.y = pk2(t[2], t[3]); v.z = pk2(t[4], t[5]); v.w = pk2(t[6], t[7]); }
        WB[e] = v; }
    { const int dh = F.tid >> 6, dd = F.tid & 63; BAS[F.tid] = ((dh >> 2) ? F.ba_b : F.ba_f)[(dh & 3) * 64 + dd]; }
}

__device__ __forceinline__ void gate_cum16(const bf16x8 (&a)[2][2], const bf16x8 wb, float ba, int dir, int lane, float (&r)[2][8], float& bend) {
    const int fq = lane >> 4, dl = lane & 15;
#pragma unroll
    for (int h2 = 0; h2 < 2; ++h2)
#pragma unroll
        for (int t = 0; t < 2; ++t) { const f32x4 z = __builtin_amdgcn_mfma_f32_16x16x32_bf16(a[h2][t], wb, (f32x4){0.f, 0.f, 0.f, 0.f}, 0, 0, 0);
#pragma unroll
            for (int q = 0; q < 4; ++q) r[h2][4 * t + q] = logsig16(z[q] + ba); }
    if (dir == 0) {
#pragma unroll
        for (int h2 = 0; h2 < 2; ++h2)
#pragma unroll
            for (int i = 1; i < 8; ++i) r[h2][i] += r[h2][i - 1];
    } else {
#pragma unroll
        for (int h2 = 0; h2 < 2; ++h2)
#pragma unroll
            for (int i = 6; i >= 0; --i) r[h2][i] += r[h2][i + 1];
    }
    const float T0 = dir ? r[0][0] : r[0][7], T1 = dir ? r[1][0] : r[1][7];
    float t0[4], t1[4];
#pragma unroll
    for (int k = 0; k < 4; ++k) { t0[k] = __shfl(T0, dl + 16 * k); t1[k] = __shfl(T1, dl + 16 * k); }
    const float s0 = (t0[0] + t0[1]) + (t0[2] + t0[3]), s1 = (t1[0] + t1[1]) + (t1[2] + t1[3]);
    float o0 = 0.f, o1 = 0.f;
#pragma unroll
    for (int k = 0; k < 4; ++k) { const bool in = dir ? (k > fq) : (k < fq); o0 += in ? t0[k] : 0.f; o1 += in ? t1[k] : 0.f; }
    if (dir == 0) o1 += s0; else o0 += s1;
    bend = s0 + s1;
#pragma unroll
    for (int i = 0; i < 8; ++i) { r[0][i] += o0; r[1][i] += o1; }
}

__device__ __forceinline__ void ph3_gla_kv(const Frame& F) {
    float* KF = (float*)F.lds;
    bf16* KETF = (bf16*)(KF + 64 * 68);
    bf16* KETB = KETF + 64 * 72;
    u32x4* WB = (u32x4*)(KETB + 64 * 72);
    float* BAS = (float*)(WB + 2048);
    const int tid = F.tid, lane = F.lane, w = F.wave;
    stage_gate_weights(F, WB, BAS);
    __syncthreads();
    const int c = tid >> 3, dc = tid & 7, pdc = rope_partner(dc), fr = lane & 15, fq = lane >> 4;
    auto geom = [&](int it, int& h, int& ch, int& tok0, bool& isctx, size_t& itf, size_t& itb) {
        const int n = it % NCH, bh = it / NCH; h = bh & 3; const int b = bh >> 2;
        isctx = n < 4; ch = isctx ? n : n - 4;
        tok0 = isctx ? MLAT + b * CTXL + 64 * ch : b * SEQ + 64 * ch;
        const int nb = isctx ? 3 - n : 4 + (127 - ch);
        itf = (size_t)(bh * 2) * NCH + n; itb = (size_t)(bh * 2 + 1) * NCH + nb;
    };
    const int gdir = w >> 2, gdt = w & 3, gd = 16 * gdt + fr, gkap = 8 * (fr >> 2) + (fr & 3);
    u32x4 pkm, pkp; RopeCS pcs; bf16x8 pbv[2], pga[2][2];
    auto issue_a = [&](int it) { int h, ch, tok0; bool isctx; size_t itf, itb; geom(it, h, ch, tok0, isctx, itf, itb);
        pkm = *(const u32x4*)(F.P1 + p1_off(tok0 + c, CGK + h * 64 + 8 * dc)); pkp = *(const u32x4*)(F.P1 + p1_off(tok0 + c, CGK + h * 64 + 8 * pdc));
#pragma unroll
        for (int h2 = 0; h2 < 2; ++h2)
#pragma unroll
            for (int t = 0; t < 2; ++t) pga[h2][t] = *(const bf16x8*)(F.P1 + p1_off(tok0 + 32 * h2 + gkap + 4 * t, CAF + 16 * gdir + 8 * (fq & 1)));
        rope_cs_issue(F.ROPE, dc, ch, c, pcs); };
    auto issue_c = [&](int it) { int h, ch, tok0; bool isctx; size_t itf, itb; geom(it, h, ch, tok0, isctx, itf, itb);
        pbv[0] = *(const bf16x8*)(F.VT + vt_off(512 + h * 128 + 16 * w + fr, tok0 + 8 * fq)); pbv[1] = *(const bf16x8*)(F.VT + vt_off(512 + h * 128 + 16 * w + fr, tok0 + 32 + 8 * fq)); };
    const int NIT = 32 * NCH;
    if ((int)blockIdx.x < NIT) { issue_a(blockIdx.x); issue_c(blockIdx.x); }
    for (int it = blockIdx.x; it < NIT; it += F.G) {
        int h, ch, tok0; bool isctx; size_t itf, itb; geom(it, h, ch, tok0, isctx, itf, itb);
        const int itn = (it + F.G < NIT) ? it + F.G : it;
        float gr_[2][8], bend;
        {
            float k8[8];
            rope_apply(pkm, pkp, pcs, dc, !isctx, k8);
            *(f32x4*)(KF + c * 68 + 8 * dc) = (f32x4){k8[0], k8[1], k8[2], k8[3]}; *(f32x4*)(KF + c * 68 + 8 * dc + 4) = (f32x4){k8[4], k8[5], k8[6], k8[7]};
            const bf16x8 zero = (bf16x8){0, 0, 0, 0, 0, 0, 0, 0};
            bf16x8 ga[2][2];
#pragma unroll
            for (int h2 = 0; h2 < 2; ++h2)
#pragma unroll
                for (int t = 0; t < 2; ++t) ga[h2][t] = (fq < 2) ? pga[h2][t] : zero;
            issue_a(itn);
            const bf16x8 wb = __builtin_bit_cast(bf16x8, WB[((gdir * 4 + h) * 4 + gdt) * 64 + lane]); const float ba = BAS[(gdir * 4 + h) * 64 + gd];
            gate_cum16(ga, wb, ba, gdir, lane, gr_, bend);
        }
        __syncthreads();
        {
            bf16* KET = gdir ? KETB : KETF;
#pragma unroll
            for (int h2 = 0; h2 < 2; ++h2) { float ke[8];
#pragma unroll
                for (int i = 0; i < 8; ++i) ke[i] = KF[(32 * h2 + 8 * fq + i) * 68 + gd] * __expf(bend - gr_[h2][i]);
                u32x4 o; o.x = pk2(ke[0], ke[1]); o.y = pk2(ke[2], ke[3]); o.z = pk2(ke[4], ke[5]); o.w = pk2(ke[6], ke[7]);
                *(u32x4*)(KET + gd * 72 + 32 * h2 + 8 * fq) = o; }
            if (fq == 0) F.DEC[(gdir ? itb : itf) * 64 + gd] = __expf(bend);
        }
        __syncthreads();
        {
            const bf16x8 bv0 = pbv[0], bv1 = pbv[1];
            bf16* dstf = F.KV + (itf * 128 + 16 * w + fr) * 64 + 8 * fq; bf16* dstb = F.KV + (itb * 128 + 16 * w + fr) * 64 + 8 * fq;
            const int kapr = 8 * (fr >> 2) + (fr & 3);
#pragma unroll
            for (int p = 0; p < 2; ++p) { f32x4 af_[2], ab_[2];
#pragma unroll
                for (int t = 0; t < 2; ++t) { const int row = 32 * p + kapr + 4 * t; f32x4 accf = (f32x4){0.f, 0.f, 0.f, 0.f}, accb = accf;
                    const bf16x8 af0 = *(const bf16x8*)(KETF + row * 72 + 8 * fq), af1 = *(const bf16x8*)(KETF + row * 72 + 32 + 8 * fq);
                    const bf16x8 ab0 = *(const bf16x8*)(KETB + row * 72 + 8 * fq), ab1 = *(const bf16x8*)(KETB + row * 72 + 32 + 8 * fq);
                    accf = __builtin_amdgcn_mfma_f32_16x16x32_bf16(af0, bv0, accf, 0, 0, 0); accb = __builtin_amdgcn_mfma_f32_16x16x32_bf16(ab0, bv0, accb, 0, 0, 0);
                    accf = __builtin_amdgcn_mfma_f32_16x16x32_bf16(af1, bv1, accf, 0, 0, 0); accb = __builtin_amdgcn_mfma_f32_16x16x32_bf16(ab1, bv1, accb, 0, 0, 0);
                    af_[t] = accf; ab_[t] = accb; }
                u32x4 o; o.x = pk2(af_[0][0], af_[0][1]); o.y = pk2(af_[0][2], af_[0][3]); o.z = pk2(af_[1][0], af_[1][1]); o.w = pk2(af_[1][2], af_[1][3]); *(u32x4*)(dstf + 32 * p) = o;
                o.x = pk2(ab_[0][0], ab_[0][1]); o.y = pk2(ab_[0][2], ab_[0][3]); o.z = pk2(ab_[1][0], ab_[1][1]); o.w = pk2(ab_[1][2], ab_[1][3]); *(u32x4*)(dstb + 32 * p) = o; }
            issue_c(itn);
        }
    }
    __syncthreads();
}

__device__ __forceinline__ void ph4_gla_scan(const Frame& F) {
    constexpr int UB = 12;
    for (int idx = blockIdx.x * NTHREADS + F.tid; idx < 64 * 2048; idx += F.G * NTHREADS) {
        const int seq = idx >> 11, within = idx & 2047, e = within >> 4, d = 4 * (within & 15);
        bf16* p = F.KV + ((size_t)seq * NCH * 128 + e) * 64 + d; const float* dp = F.DEC + (size_t)seq * NCH * 64 + d;
        float s0 = 0.f, s1 = 0.f, s2 = 0.f, s3 = 0.f;
        for (int n0 = 0; n0 < NCH; n0 += UB) {
            u32x2 kv[UB]; f32x4 dc[UB];
#pragma unroll
            for (int u = 0; u < UB; ++u) { kv[u] = *(const u32x2*)(p + (size_t)(n0 + u) * 128 * 64); dc[u] = *(const f32x4*)(dp + (n0 + u) * 64); }
#pragma unroll
            for (int u = 0; u < UB; ++u) {
                u32x2 o; o.x = pk2(s0, s1); o.y = pk2(s2, s3); *(u32x2*)(p + (size_t)(n0 + u) * 128 * 64) = o;
                s0 = dc[u][0] * s0 + bflo(kv[u].x); s1 = dc[u][1] * s1 + bfhi(kv[u].x); s2 = dc[u][2] * s2 + bflo(kv[u].y); s3 = dc[u][3] * s3 + bfhi(kv[u].y); }
        }
    }
}

__device__ __forceinline__ void ph5_gla_out(const Frame& F) {
    float* BCF = (float*)F.lds;
    float* BCB = BCF + 64 * 68;
    float* SS = BCB + 64 * 68;
    bf16* QDF = (bf16*)(SS + 512);
    bf16* KIF = QDF + 64 * 72;
    bf16* QDB = KIF + 64 * 72;
    bf16* KIB = QDB + 64 * 72;
    bf16* AT = KIB + 64 * 72;
    u32x4* WB = (u32x4*)(AT + 64 * 72);
    float* BAS = (float*)(WB + 2048);
    float* GN = BAS + 512;
    const int tid = F.tid, lane = F.lane, w = F.wave, fr = lane & 15, fq = lane >> 4;
    stage_gate_weights(F, WB, BAS);
    GN[tid] = F.gla_norm[tid];
    __syncthreads();
    const int c = tid >> 3, dc = tid & 7, pdc = rope_partner(dc);
    const int gdir = w >> 2, gdt = w & 3, gd = 16 * gdt + fr, gkap = 8 * (fr >> 2) + (fr & 3);
    u32x4 pqm, pqp, pkm, pkp; RopeCS pcs; u32x2 pgr[4]; bf16x8 pav[2], pasf[2], pasb[2], pga[2][2];
    auto issue_a = [&](int it) { const int j = it & 127, h = (it >> 7) & 3, b = it >> 9; const int tok0 = b * SEQ + 64 * j;
        pqm = *(const u32x4*)(F.P1 + p1_off(tok0 + c, CGQ + h * 64 + 8 * dc)); pqp = *(const u32x4*)(F.P1 + p1_off(tok0 + c, CGQ + h * 64 + 8 * pdc));
        pkm = *(const u32x4*)(F.P1 + p1_off(tok0 + c, CGK + h * 64 + 8 * dc)); pkp = *(const u32x4*)(F.P1 + p1_off(tok0 + c, CGK + h * 64 + 8 * pdc));
#pragma unroll
        for (int h2 = 0; h2 < 2; ++h2)
#pragma unroll
            for (int t = 0; t < 2; ++t) pga[h2][t] = *(const bf16x8*)(F.P1 + p1_off(tok0 + 32 * h2 + gkap + 4 * t, CAF + 16 * gdir + 8 * (fq & 1)));
        rope_cs_issue(F.ROPE, dc, j, c, pcs);
#pragma unroll
        for (int ct = 0; ct < 4; ++ct) pgr[ct] = *(const u32x2*)(F.P1 + p1_off(tok0 + 16 * ct + fr, CGR + h * 128 + 16 * w + 4 * fq)); };
    auto issue_e = [&](int it) { const int j = it & 127, h = (it >> 7) & 3, b = it >> 9; const int tok0 = b * SEQ + 64 * j;
        const int seqf = (b * 4 + h) * 2, seqb = seqf + 1;
        const bf16* vrow = F.VT + vt_off(512 + h * 128 + 16 * w + fr, tok0 + 8 * fq); const bf16* vrow1 = F.VT + vt_off(512 + h * 128 + 16 * w + fr, tok0 + 32 + 8 * fq);
        const bf16* sfp = F.KV + (((size_t)seqf * NCH + 4 + j) * 128 + 16 * w + fr) * 64 + 8 * fq;
        const bf16* sbp = F.KV + (((size_t)seqb * NCH + 4 + (127 - j)) * 128 + 16 * w + fr) * 64 + 8 * fq;
        pav[0] = *(const bf16x8*)vrow; pav[1] = *(const bf16x8*)vrow1; pasf[0] = *(const bf16x8*)sfp; pasf[1] = *(const bf16x8*)(sfp + 32); pasb[0] = *(const bf16x8*)sbp; pasb[1] = *(const bf16x8*)(sbp + 32); };
    const int NIT = NB * 4 * 128;
    if ((int)blockIdx.x < NIT) { issue_a(blockIdx.x); issue_e(blockIdx.x); }
    for (int it = blockIdx.x; it < NIT; it += F.G) {
        const int j = it & 127, h = (it >> 7) & 3, b = it >> 9;
        const int tok0 = b * SEQ + 64 * j;
        const int itn = (it + F.G < NIT) ? it + F.G : it;
        float q8[8], k8[8]; u32x2 gr[4];
        {
            rope_apply(pqm, pqp, pcs, dc, true, q8);
            rope_apply(pkm, pkp, pcs, dc, true, k8);
#pragma unroll
            for (int ct = 0; ct < 4; ++ct) gr[ct] = pgr[ct];
            const bf16x8 zero = (bf16x8){0, 0, 0, 0, 0, 0, 0, 0};
            bf16x8 ga[2][2];
#pragma unroll
            for (int h2 = 0; h2 < 2; ++h2)
#pragma unroll
                for (int t = 0; t < 2; ++t) ga[h2][t] = (fq < 2) ? pga[h2][t] : zero;
            issue_a(itn);
            const bf16x8 wb = __builtin_bit_cast(bf16x8, WB[((gdir * 4 + h) * 4 + gdt) * 64 + lane]); const float ba = BAS[(gdir * 4 + h) * 64 + gd];
            float r[2][8], bend; gate_cum16(ga, wb, ba, gdir, lane, r, bend);
            float* BC = gdir ? BCB : BCF;
#pragma unroll
            for (int h2 = 0; h2 < 2; ++h2)
#pragma unroll
                for (int i = 0; i < 8; ++i) BC[(32 * h2 + 8 * fq + i) * 68 + gd] = r[h2][i];
        }
        __syncthreads();
        {
            const f32x4 f0 = *(const f32x4*)(BCF + c * 68 + 8 * dc), f1 = *(const f32x4*)(BCF + c * 68 + 8 * dc + 4), b0 = *(const f32x4*)(BCB + c * 68 + 8 * dc), b1 = *(const f32x4*)(BCB + c * 68 + 8 * dc + 4);
            const float bf[8] = {f0[0], f0[1], f0[2], f0[3], f1[0], f1[1], f1[2], f1[3]}, bb[8] = {b0[0], b0[1], b0[2], b0[3], b1[0], b1[1], b1[2], b1[3]};
            float qf[8], kf[8], qb[8], kb[8];
#pragma unroll
            for (int i = 0; i < 8; ++i) { qf[i] = q8[i] * __expf(bf[i]) * 0.125f; kf[i] = k8[i] * __expf(-bf[i]); qb[i] = q8[i] * __expf(bb[i]) * 0.125f; kb[i] = k8[i] * __expf(-bb[i]); }
            u32x4 o;
            o.x = pk2(qf[0], qf[1]); o.y = pk2(qf[2], qf[3]); o.z = pk2(qf[4], qf[5]); o.w = pk2(qf[6], qf[7]); *(u32x4*)(QDF + c * 72 + 8 * dc) = o;
            o.x = pk2(kf[0], kf[1]); o.y = pk2(kf[2], kf[3]); o.z = pk2(kf[4], kf[5]); o.w = pk2(kf[6], kf[7]); *(u32x4*)(KIF + c * 72 + 8 * dc) = o;
            o.x = pk2(qb[0], qb[1]); o.y = pk2(qb[2], qb[3]); o.z = pk2(qb[4], qb[5]); o.w = pk2(qb[6], qb[7]); *(u32x4*)(QDB + c * 72 + 8 * dc) = o;
            o.x = pk2(kb[0], kb[1]); o.y = pk2(kb[2], kb[3]); o.z = pk2(kb[4], kb[5]); o.w = pk2(kb[6], kb[7]); *(u32x4*)(KIB + c * 72 + 8 * dc) = o;
        }
        __syncthreads();
        {
            const int ct = w & 3, sp = w >> 2;
            const bf16x8 bqf0 = *(const bf16x8*)(QDF + (16 * ct + fr) * 72 + 8 * fq), bqf1 = *(const bf16x8*)(QDF + (16 * ct + fr) * 72 + 32 + 8 * fq);
            const bf16x8 bqb0 = *(const bf16x8*)(QDB + (16 * ct + fr) * 72 + 8 * fq), bqb1 = *(const bf16x8*)(QDB + (16 * ct + fr) * 72 + 32 + 8 * fq);
#pragma unroll
            for (int t = 0; t < 2; ++t) { const int st = 2 * sp + t;
                f32x4 af = (f32x4){0.f, 0.f, 0.f, 0.f}, ab = af;
                af = __builtin_amdgcn_mfma_f32_16x16x32_bf16(*(const bf16x8*)(KIF + (16 * st + fr) * 72 + 8 * fq), bqf0, af, 0, 0, 0);
                af = __builtin_amdgcn_mfma_f32_16x16x32_bf16(*(const bf16x8*)(KIF + (16 * st + fr) * 72 + 32 + 8 * fq), bqf1, af, 0, 0, 0);
                ab = __builtin_amdgcn_mfma_f32_16x16x32_bf16(*(const bf16x8*)(KIB + (16 * st + fr) * 72 + 8 * fq), bqb0, ab, 0, 0, 0);
                ab = __builtin_amdgcn_mfma_f32_16x16x32_bf16(*(const bf16x8*)(KIB + (16 * st + fr) * 72 + 32 + 8 * fq), bqb1, ab, 0, 0, 0);
                const int cc = 16 * ct + fr, s0 = 16 * st + 4 * fq; float tt[4];
#pragma unroll
                for (int r = 0; r < 4; ++r) { const int s = s0 + r; tt[r] = (s <= cc ? af[r] : 0.f) + (s >= cc ? ab[r] : 0.f); }
                u32x2 o; o.x = pk2(tt[0], tt[1]); o.y = pk2(tt[2], tt[3]); *(u32x2*)(AT + cc * 72 + s0) = o; }
        }
        __syncthreads();
        f32x4 o4[4];
        {
#pragma unroll
            for (int ct = 0; ct < 4; ++ct) { f32x4 acc = (f32x4){0.f, 0.f, 0.f, 0.f};
#pragma unroll
                for (int ks = 0; ks < 2; ++ks) {
                    acc = __builtin_amdgcn_mfma_f32_16x16x32_bf16(pav[ks], *(const bf16x8*)(AT + (16 * ct + fr) * 72 + 32 * ks + 8 * fq), acc, 0, 0, 0);
                    acc = __builtin_amdgcn_mfma_f32_16x16x32_bf16(pasf[ks], *(const bf16x8*)(QDF + (16 * ct + fr) * 72 + 32 * ks + 8 * fq), acc, 0, 0, 0);
                    acc = __builtin_amdgcn_mfma_f32_16x16x32_bf16(pasb[ks], *(const bf16x8*)(QDB + (16 * ct + fr) * 72 + 32 * ks + 8 * fq), acc, 0, 0, 0); }
                o4[ct] = acc;
                float p = (acc[0] * acc[0] + acc[1] * acc[1]) + (acc[2] * acc[2] + acc[3] * acc[3]); p += __shfl_xor(p, 16); p += __shfl_xor(p, 32);
                if (fq == 0) SS[w * 64 + 16 * ct + fr] = p; }
            issue_e(itn);
        }
        __syncthreads();
        {
            const f32x4 gn = *(const f32x4*)(GN + h * 128 + 16 * w + 4 * fq);
#pragma unroll
            for (int ct = 0; ct < 4; ++ct) { const int cc = 16 * ct + fr; float tot = 0.f;
#pragma unroll
                for (int w2 = 0; w2 < 8; ++w2) tot += SS[w2 * 64 + cc];
                const float rs = 1.0f / sqrtf(tot * (1.0f / 128.0f) + EPS);
                const float g[4] = {bflo(gr[ct].x), bfhi(gr[ct].x), bflo(gr[ct].y), bfhi(gr[ct].y)}; float y[4];
#pragma unroll
                for (int r = 0; r < 4; ++r) y[r] = o4[ct][r] * rs * gn[r] * (g[r] * __builtin_amdgcn_rcpf(1.0f + __expf(-g[r])));
                u32x2 o; o.x = pk2(y[0], y[1]); o.y = pk2(y[2], y[3]); *(u32x2*)(F.MIX + (size_t)(tok0 + cc) * DM + 512 + h * 128 + 16 * w + 4 * fq) = o; }
        }
        __syncthreads();
    }
}

__device__ __forceinline__ void ph5_na(const Frame& F) {
    constexpr int NT = 4;
    constexpr float LOG2E = 1.4426950408889634f, QS = 0.125f * LOG2E;
    bf16* CKs = (bf16*)F.lds;
    bf16* CVs = CKs + 256 * 72;
    float* RPB = (float*)(CVs + 64 * 264);
    bf16* QSw = (bf16*)(RPB + 468) + F.wave * (4 * 16 * 64);
    const int tid = F.tid, lane = F.lane, w = F.wave, qi = lane & 15, fq = lane >> 4;
    const int j = w & 3, sub = w >> 2;
    const int c = 16 * j + qi;
    const int kc0 = (j == 0) ? 0 : (j == 1) ? 8 : (j == 2) ? 24 : 32;
    const int cs = (c - 8 < 0) ? 0 : (c - 8 > 48 ? 48 : c - 8);
    const int kap = 8 * (qi >> 2) + (qi & 3);
    unsigned cmask = 0;
#pragma unroll
    for (int e = 0; e < 8; ++e) { const int kc = kc0 + 8 * fq + e; if (kc >= cs && kc < cs + 16) cmask |= 1u << e; }
    const int dc0 = kc0 + 8 * fq - c + 15;
    int dcc[8];
#pragma unroll
    for (int e = 0; e < 8; ++e) { const int t = dc0 + e; dcc[e] = t < 0 ? 0 : (t > 30 ? 30 : t); }
    const float NEG_INF = -__builtin_inff();
    const int ipw = (1024 + F.G - 1) / F.G;
    int cur_bh = -1;
    for (int it = blockIdx.x * ipw; it < (blockIdx.x + 1) * ipw && it < 1024; ++it) {
        const int rg = it & 15, bh = it >> 4, head = bh & 7, b = bh >> 3;
        if (bh != cur_bh) {
            cur_bh = bh;
            __syncthreads();
            { const int row = tid >> 1, hf = tid & 1; const bf16* src = F.P1 + p1_off(MLAT + b * CTXL + row, CK + head * 64 + 32 * hf);
              u32x4 v0 = *(const u32x4*)src, v1 = *(const u32x4*)(src + 8), v2 = *(const u32x4*)(src + 16), v3 = *(const u32x4*)(src + 24);
              bf16* dst = CKs + row * 72 + 32 * hf; *(u32x4*)dst = v0; *(u32x4*)(dst + 8) = v1; *(u32x4*)(dst + 16) = v2; *(u32x4*)(dst + 24) = v3; }
            { const int row = tid >> 3, sg = tid & 7; const int t0 = MLAT + b * CTXL + 32 * sg;
              u32x4 v0 = *(const u32x4*)(F.VT + vt_off(head * 64 + row, t0)), v1 = *(const u32x4*)(F.VT + vt_off(head * 64 + row, t0 + 8)), v2 = *(const u32x4*)(F.VT + vt_off(head * 64 + row, t0 + 16)), v3 = *(const u32x4*)(F.VT + vt_off(head * 64 + row, t0 + 24));
              bf16* dst = CVs + row * 264 + 32 * sg; *(u32x4*)dst = v0; *(u32x4*)(dst + 8) = v1; *(u32x4*)(dst + 16) = v2; *(u32x4*)(dst + 24) = v3; }
            if (tid < 465) RPB[tid] = F.rpb[head * 465 + tid] * LOG2E;
            __syncthreads();
        }
        const int rA = 8 * rg + 4 * sub;
        {
            bf16x8 qt[NT][2];
#pragma unroll
            for (int nt = 0; nt < NT; ++nt) { const bf16* qp = F.P1 + p1_off(b * SEQ + (rA + nt) * 64 + c, CQ + head * 64 + 8 * fq); qt[nt][0] = *(const bf16x8*)qp; qt[nt][1] = *(const bf16x8*)(qp + 32); }
#pragma unroll
            for (int nt = 0; nt < NT; ++nt)
#pragma unroll
                for (int ks = 0; ks < 2; ++ks) *(bf16x8*)(QSw + (nt * 16 + qi) * 64 + 8 * ((4 * ks + fq) ^ (qi & 7))) = qt[nt][ks];
        }
        float m[NT], l[NT]; f32x4 O[4][NT];
#pragma unroll
        for (int nt = 0; nt < NT; ++nt) { m[nt] = NEG_INF; l[nt] = 0.f;
#pragma unroll
            for (int dt = 0; dt < 4; ++dt) O[dt][nt] = (f32x4){0.f, 0.f, 0.f, 0.f}; }
        auto na_tile = [&](int nt, bool local, int kr, const bf16x8 (&kf)[2][2], const bf16x8 (&vf)[4]) {
            const int r = rA + nt;
            const bf16x8 q0 = *(const bf16x8*)(QSw + (nt * 16 + qi) * 64 + 8 * (fq ^ (qi & 7))), q1 = *(const bf16x8*)(QSw + (nt * 16 + qi) * 64 + 8 * ((4 + fq) ^ (qi & 7)));
            f32x4 s0 = (f32x4){0.f, 0.f, 0.f, 0.f}, s1 = s0;
            s0 = __builtin_amdgcn_mfma_f32_16x16x32_bf16(kf[0][0], q0, s0, 0, 0, 0); s0 = __builtin_amdgcn_mfma_f32_16x16x32_bf16(kf[0][1], q1, s0, 0, 0, 0);
            s1 = __builtin_amdgcn_mfma_f32_16x16x32_bf16(kf[1][0], q0, s1, 0, 0, 0); s1 = __builtin_amdgcn_mfma_f32_16x16x32_bf16(kf[1][1], q1, s1, 0, 0, 0);
            float sc[8];
            if (local) { const float* rp = RPB + (kr - r + 7) * 31; float bias[8];
#pragma unroll
                for (int e = 0; e < 8; ++e) bias[e] = rp[dcc[e]];
#pragma unroll
                for (int e = 0; e < 8; ++e) { const float a = (e < 4) ? s0[e & 3] : s1[e & 3]; sc[e] = ((cmask >> e) & 1u) ? a * QS + bias[e] : NEG_INF; }
            } else {
#pragma unroll
                for (int e = 0; e < 8; ++e) { const float a = (e < 4) ? s0[e & 3] : s1[e & 3]; sc[e] = a * QS; }
            }
            const float lmax = fmaxf(fmaxf(fmaxf(sc[0], sc[1]), fmaxf(sc[2], sc[3])), fmaxf(fmaxf(sc[4], sc[5]), fmaxf(sc[6], sc[7])));
            if (!__all(lmax <= m[nt] + 11.0f)) {
                float mx = fmaxf(lmax, __shfl_xor(lmax, 16)); mx = fmaxf(mx, __shfl_xor(mx, 32));
                const float mn = fmaxf(m[nt], mx), alpha = __builtin_amdgcn_exp2f(m[nt] - mn); m[nt] = mn; l[nt] *= alpha;
#pragma unroll
                for (int dt = 0; dt < 4; ++dt) O[dt][nt] = O[dt][nt] * alpha; }
            const float mn = m[nt];
            float p[8], ps = 0.f;
#pragma unroll
            for (int e = 0; e < 8; ++e) { p[e] = __builtin_amdgcn_exp2f(sc[e] - mn); ps += p[e]; }
            l[nt] += ps;
            u32x4 pw; pw.x = pk2(p[0], p[1]); pw.y = pk2(p[2], p[3]); pw.z = pk2(p[4], p[5]); pw.w = pk2(p[6], p[7]);
            const bf16x8 pf = __builtin_bit_cast(bf16x8, pw);
#pragma unroll
            for (int dt = 0; dt < 4; ++dt) O[dt][nt] = __builtin_amdgcn_mfma_f32_16x16x32_bf16(vf[dt], pf, O[dt][nt], 0, 0, 0);
            __builtin_amdgcn_sched_barrier(0);
        };
#pragma unroll 1
        for (int s = 0; s < 8; ++s) {
            bf16x8 kf[2][2], vf[4];
#pragma unroll
            for (int t = 0; t < 2; ++t) { const bf16* kp = CKs + (32 * s + kap + 4 * t) * 72 + 8 * fq; kf[t][0] = *(const bf16x8*)kp; kf[t][1] = *(const bf16x8*)(kp + 32); }
#pragma unroll
            for (int dt = 0; dt < 4; ++dt) vf[dt] = *(const bf16x8*)(CVs + (dt * 16 + qi) * 264 + 32 * s + 8 * fq);
#pragma unroll
            for (int nt = 0; nt < NT; ++nt) na_tile(nt, false, 0, kf, vf);
        }
        const int rsA = (rA - 4 < 0) ? 0 : (rA - 4 > 120 ? 120 : rA - 4);
        const int rlast = rA + NT - 1; const int rsB = (rlast - 4 < 0) ? 0 : (rlast - 4 > 120 ? 120 : rlast - 4);
        const int nloc = rsB + 8 - rsA, slast = nloc - 1;
        auto na_loadk = [&](int s, bf16x8 (&kf)[2][2]) {
            const int base_tok = b * SEQ + (rsA + s) * 64 + kc0;
#pragma unroll
            for (int t = 0; t < 2; ++t) { const bf16* kp = F.P1 + p1_off(base_tok + kap + 4 * t, CK + head * 64 + 8 * fq); kf[t][0] = *(const bf16x8*)kp; kf[t][1] = *(const bf16x8*)(kp + 32); }
        };
        auto na_step = [&](int s, const bf16x8 (&kf)[2][2]) {
            const int kr = rsA + s; const int base_tok = b * SEQ + kr * 64 + kc0;
            bf16x8 vf[4];
#pragma unroll
            for (int dt = 0; dt < 4; ++dt) vf[dt] = *(const bf16x8*)(F.VT + vt_off(head * 64 + dt * 16 + qi, base_tok + 8 * fq));
#pragma unroll
            for (int nt = 0; nt < NT; ++nt) {
                const int r = rA + nt; const int rs = (r - 4 < 0) ? 0 : (r - 4 > 120 ? 120 : r - 4);
                if (kr < rs || kr >= rs + 8) continue;
                na_tile(nt, true, kr, kf, vf);
            }
        };
        bf16x8 kfA[2][2], kfB[2][2];
        na_loadk(0, kfA);
        for (int s = 0; s < slast; s += 2) {
            na_loadk(s + 1, kfB);
            na_step(s, kfA);
            na_loadk((s + 2 < slast) ? s + 2 : slast, kfA);
            na_step(s + 1, kfB);
        }
        if (nloc & 1) na_step(slast, kfA);
#pragma unroll
        for (int nt = 0; nt < NT; ++nt) { float lt = l[nt]; lt += __shfl_xor(lt, 16); lt += __shfl_xor(lt, 32); const float inv = 1.0f / lt;
            bf16* op = F.MIX + (size_t)(b * SEQ + (rA + nt) * 64 + c) * DM + head * 64 + 4 * fq;
#pragma unroll
            for (int dt = 0; dt < 4; ++dt) { const f32x4 o = O[dt][nt] * inv; u32x2 ow; ow.x = pk2(o[0], o[1]); ow.y = pk2(o[2], o[3]); *(u32x2*)(op + 16 * dt) = ow; } }
    }
    __syncthreads();
}

__device__ __forceinline__ void ph7_mid(const Frame& F) {
    const int gw = blockIdx.x * 8 + F.wave, NGW = F.G * 8;
    int curb = -1; f32x4 c1[4], cA[4], cB[4];
#pragma unroll
    for (int j = 0; j < 4; ++j) { c1[j] = (f32x4){0.f, 0.f, 0.f, 0.f}; cA[j] = c1[j]; cB[j] = c1[j]; }
    for (int row0 = gw; row0 < MLAT; row0 += 2 * NGW) {
        const int nr = (row0 + NGW < MLAT) ? 2 : 1;
        f32x4 v[2][4]; u32x2 yw[2][4]; float sqp[2];
#pragma unroll
        for (int q = 0; q < 2; ++q) { const int row = (q < nr) ? row0 + q * NGW : row0;
#pragma unroll
            for (int j = 0; j < 4; ++j) { v[q][j] = __builtin_nontemporal_load((const f32x4*)(F.x + (size_t)row * DM) + F.lane + 64 * j); yw[q][j] = *((const u32x2*)(F.Y + (size_t)row * DM) + F.lane + 64 * j); }
            sqp[q] = F.lane < 16 ? F.SSQ1[(size_t)row * 16 + F.lane] : 0.f; }
#pragma unroll
        for (int q = 0; q < 2; ++q) { if (q < nr) { const int row = row0 + q * NGW; const int b = row >> 13;
            const float sq1 = wave_sum(sqp[q]);
            if (b != curb) { curb = b;
#pragma unroll
                for (int j = 0; j < 4; ++j) { const int col = 4 * (F.lane + 64 * j); const float* mb = F.MOD + b * NMOD;
                    c1[j] = *(const f32x4*)(mb + 2 * DM + col) * *(const f32x4*)(F.g_post_mix + col);
                    cA[j] = *(const f32x4*)(F.g_pre_ffn + col) * (*(const f32x4*)(mb + 4 * DM + col) + 1.0f); cB[j] = *(const f32x4*)(mb + 3 * DM + col); } }
            const float rstd1 = 1.0f / sqrtf(sq1 * (1.0f / DM) + EPS);
            float ss = 0.f;
#pragma unroll
            for (int j = 0; j < 4; ++j) { const f32x4 y = (f32x4){bflo(yw[q][j].x), bfhi(yw[q][j].x), bflo(yw[q][j].y), bfhi(yw[q][j].y)}; v[q][j] = v[q][j] + c1[j] * (y * rstd1);
                ss += (v[q][j][0] * v[q][j][0] + v[q][j][1] * v[q][j][1]) + (v[q][j][2] * v[q][j][2] + v[q][j][3] * v[q][j][3]);
                u32x2 xw; xw.x = pk2(v[q][j][0], v[q][j][1]); xw.y = pk2(v[q][j][2], v[q][j][3]); *(u32x2*)(F.X1B + (size_t)row * DM + 4 * (F.lane + 64 * j)) = xw; }
            const float rstd2 = 1.0f / sqrtf(wave_sum(ss) * (1.0f / DM) + EPS);
#pragma unroll
            for (int j = 0; j < 4; ++j) { const f32x4 o = v[q][j] * rstd2 * cA[j] + cB[j]; u32x2 wv; wv.x = pk2(o[0], o[1]); wv.y = pk2(o[2], o[3]); *(u32x2*)(F.H + (size_t)row * DM + 4 * (F.lane + 64 * j)) = wv; } } }
    }
}
__device__ __forceinline__ void ph10_final(const Frame& F) {
    const int gw = blockIdx.x * 8 + F.wave, NGW = F.G * 8;
    int curb = -1; f32x4 c2[4];
#pragma unroll
    for (int j = 0; j < 4; ++j) c2[j] = (f32x4){0.f, 0.f, 0.f, 0.f};
    for (int row0 = gw; row0 < MLAT; row0 += 2 * NGW) {
        const int nr = (row0 + NGW < MLAT) ? 2 : 1;
        u32x2 xw[2][4], dw[2][4]; float sp2[2];
#pragma unroll
        for (int q = 0; q < 2; ++q) { const int row = (q < nr) ? row0 + q * NGW : row0;
#pragma unroll
            for (int j = 0; j < 4; ++j) { xw[q][j] = *((const u32x2*)(F.X1B + (size_t)row * DM) + F.lane + 64 * j); dw[q][j] = *((const u32x2*)(F.DOWN + (size_t)row * DM) + F.lane + 64 * j); }
            sp2[q] = F.lane < 16 ? F.SSQ2[(size_t)row * 16 + F.lane] : 0.f; }
#pragma unroll
        for (int q = 0; q < 2; ++q) { if (q < nr) { const int row = row0 + q * NGW; const int b = row >> 13;
            const float sq2 = wave_sum(sp2[q]);
            if (b != curb) { curb = b;
#pragma unroll
                for (int j = 0; j < 4; ++j) { const int col = 4 * (F.lane + 64 * j); const float* mb = F.MOD + b * NMOD; c2[j] = *(const f32x4*)(mb + 5 * DM + col) * *(const f32x4*)(F.g_post_ffn + col); } }
            const float rstd2 = 1.0f / sqrtf(sq2 * (1.0f / DM) + EPS);
#pragma unroll
            for (int j = 0; j < 4; ++j) { const f32x4 x1 = (f32x4){bflo(xw[q][j].x), bfhi(xw[q][j].x), bflo(xw[q][j].y), bfhi(xw[q][j].y)}, d = (f32x4){bflo(dw[q][j].x), bfhi(dw[q][j].x), bflo(dw[q][j].y), bfhi(dw[q][j].y)};
                const f32x4 o = x1 + c2[j] * (d * rstd2); __builtin_nontemporal_store(o, (f32x4*)(F.out + (size_t)row * DM) + F.lane + 64 * j); } } }
    }
}

struct Args { const float* in[20]; float* out; unsigned char* ws; int ph_lo, ph_hi; };
constexpr int NPHASES = 11;

__global__ void __launch_bounds__(NTHREADS, 2) mk_fwd(Args args) {
    extern __shared__ __attribute__((aligned(16))) unsigned char lds[];
    cg::grid_group grid = cg::this_grid();
    Frame F;
    F.lds = lds; F.tid = threadIdx.x; F.lane = F.tid & 63; F.wave = __builtin_amdgcn_readfirstlane(F.tid >> 6); F.G = gridDim.x;
    F.x = args.in[0]; F.c = args.in[1]; F.ctx = args.in[2]; F.c_ctx = args.in[3]; F.w_mod = args.in[4]; F.b_mod = args.in[5]; F.g_pre_mix = args.in[6]; F.g_post_mix = args.in[7];
    F.g_pre_ffn = args.in[8]; F.g_post_ffn = args.in[9]; F.w_in = args.in[10]; F.rpb = args.in[11]; F.wa2_f = args.in[12]; F.ba_f = args.in[13]; F.wa2_b = args.in[14]; F.ba_b = args.in[15];
    F.gla_norm = args.in[16]; F.w_out = args.in[17]; F.w_gu = args.in[18]; F.w_down = args.in[19]; F.out = args.out;
    unsigned char* ws = args.ws;
    F.MOD = (float*)(ws + WS_MOD); F.ROPE = (float*)(ws + WS_ROPE); F.DEC = (float*)(ws + WS_DEC); F.SSQ1 = (float*)(ws + WS_SSQ1); F.SSQ2 = (float*)(ws + WS_SSQ2);
    F.WMAIN = (bf16*)(ws + WS_WMAIN); F.WV = (bf16*)(ws + WS_WV); F.WOUT = (bf16*)(ws + WS_WOUT); F.WGU = (bf16*)(ws + WS_WGU); F.WDOWN = (bf16*)(ws + WS_WDOWN);
    F.H = (bf16*)(ws + WS_H); F.P1 = (bf16*)(ws + WS_P1); F.VT = (bf16*)(ws + WS_VT); F.KV = (bf16*)(ws + WS_KV); F.MIX = (bf16*)(ws + WS_MIX); F.Y = (bf16*)(ws + WS_Y); F.ACT = (bf16*)(ws + WS_ACT); F.DOWN = (bf16*)(ws + WS_DOWN); F.X1B = (bf16*)(ws + WS_X1B);
    PG8_LAS unsigned char* glds = (PG8_LAS unsigned char*)lds;
    const int lo = args.ph_lo, hi = args.ph_hi;
    volatile unsigned* MISC = (volatile unsigned*)(lds + LDS_BYTES - 128);
    if (F.tid < 32) MISC[F.tid] = 0u;
    __syncthreads();
    XcdBarrier xbar = xcd_barrier_post((unsigned*)(ws + WS_CTL) + 4096, MISC + 8);
#define IN(k) (lo <= (k) && (k) < hi)
#define REP(k) ((MK_REP_PHASE == (k)) ? 2 : 1)
#define SEAM(k) do { if (IN(k) && IN((k) + 1)) { if ((k) < MK_CG_SEAMS) grid.sync(); else xcd_barrier(xbar); } } while (0)

    if (IN(0)) for (int rep = 0; rep < REP(0); ++rep) ph0_mod(F);
    SEAM(0);
    if (IN(1)) for (int rep = 0; rep < REP(1); ++rep) ph1_rows(F);
    SEAM(1);
    if (IN(2)) for (int rep = 0; rep < REP(2); ++rep) {
        pg8::Gemm g1{F.H, F.WMAIN, MTOT, LDP, DM}, g2{F.WV, F.H, 1024, MTOT, DM};
        pg8::DualOrder S; S.o1.init(g1, F.G, (int)blockIdx.x); S.o2.init(g2, F.G, (int)blockIdx.x); S.G = F.G; S.c = (int)blockIdx.x;
        pg8::EpiDual E{pg8::EpiStore{F.P1, MTOT}, pg8::EpiStoreBlk{F.VT, 1024}};
        pg8::gemm_phase<pg8::EpiDual, pg8::DualOrder, true, true>(glds, g1, S, E);
        ph2_tail_weights(F, S.o1.nwg + S.o2.nwg);
    }
    SEAM(2);
    if (IN(3)) { for (int rep = 0; rep < REP(3); ++rep) ph3_gla_kv(F); for (int rep = 0; rep < REP(11); ++rep) ph5_na(F); }
    SEAM(3);
    if (IN(4)) ph4_gla_scan(F);
    if (MK_REP_PHASE == 4) { xcd_barrier(xbar); ph3_gla_kv(F); xcd_barrier(xbar); ph4_gla_scan(F); }
    SEAM(4);
    if (IN(5)) { for (int rep = 0; rep < REP(5); ++rep) ph5_gla_out(F); }
    SEAM(5);
    if (IN(6)) for (int rep = 0; rep < REP(6); ++rep) { pg8::Gemm g{F.MIX, F.WOUT, MLAT, DM, DM}; pg8::StaticOrder S; S.init(g, F.G, (int)blockIdx.x); pg8::EpiStoreSsq E{F.Y, DM, F.SSQ1};
        pg8::gemm_phase<pg8::EpiStoreSsq, pg8::StaticOrder, true, true>(glds, g, S, E); }
    SEAM(6);
    if (IN(7)) for (int rep = 0; rep < REP(7); ++rep) ph7_mid(F);
    SEAM(7);
    if (IN(8)) for (int rep = 0; rep < REP(8); ++rep) { pg8::Gemm g{F.H, F.WGU, MLAT, 2 * FFN, DM}; pg8::StaticOrder S; S.init(g, F.G, (int)blockIdx.x); pg8::EpiSwiglu E{F.ACT, FFN};
        pg8::gemm_phase<pg8::EpiSwiglu, pg8::StaticOrder, true, true>(glds, g, S, E); }
    SEAM(8);
    if (IN(9)) for (int rep = 0; rep < REP(9); ++rep) { pg8::Gemm g{F.ACT, F.WDOWN, MLAT, DM, FFN}; pg8::StaticOrder S; S.init(g, F.G, (int)blockIdx.x, 1); pg8::EpiStoreSsq E{F.DOWN, DM, F.SSQ2};
        pg8::gemm_phase<pg8::EpiStoreSsq, pg8::StaticOrder, true, true>(glds, g, S, E); }
    SEAM(9);
    if (IN(10)) for (int rep = 0; rep < REP(10); ++rep) ph10_final(F);
#undef IN
#undef SEAM
#undef REP
}

extern "C" void kernel_launch(void* const* d_in, const int* in_sizes, int n_in, void* d_out, int out_size, void* d_ws, size_t ws_size, hipStream_t stream) {
    static int grid = 0;
    if (grid == 0) {
        if (n_in != 20 || in_sizes[0] != MLAT * DM || out_size != MLAT * DM || ws_size < WS_END) { fprintf(stderr, "kernel_launch: unexpected shapes (n_in %d, in0 %d, out %d, ws %zu)\n", n_in, n_in > 0 ? in_sizes[0] : -1, out_size, ws_size); grid = -1; return; }
        int dev = 0, cus = 0, per_cu = 0;
        if (hipGetDevice(&dev) != hipSuccess || hipDeviceGetAttribute(&cus, hipDeviceAttributeMultiprocessorCount, dev) != hipSuccess) { fprintf(stderr, "kernel_launch: device query failed\n"); grid = -1; return; }
        if (hipFuncSetAttribute((const void*)mk_fwd, hipFuncAttributeMaxDynamicSharedMemorySize, LDS_BYTES) != hipSuccess) { fprintf(stderr, "kernel_launch: hipFuncSetAttribute failed\n"); grid = -1; return; }
        if (hipOccupancyMaxActiveBlocksPerMultiprocessor(&per_cu, (const void*)mk_fwd, NTHREADS, LDS_BYTES) != hipSuccess || per_cu < 1) { fprintf(stderr, "kernel_launch: occupancy query says %d blocks per CU\n", per_cu); (void)hipGetLastError(); grid = -1; return; }
        grid = cus;
    }
    if (grid < 0) return;
    if (hipMemsetAsync((char*)d_ws + WS_CTL, 0, CTL_ZERO_BYTES, stream) != hipSuccess) { fprintf(stderr, "kernel_launch: hipMemsetAsync failed\n"); return; }
    Args a{};
    for (int i = 0; i < 20; ++i) a.in[i] = (const float*)d_in[i];
    a.out = (float*)d_out; a.ws = (unsigned char*)d_ws;
#if MK_PER_PHASE
    for (int p = 0; p < NPHASES; ++p) { a.ph_lo = p; a.ph_hi = p + 1; void* kargs[] = {&a};
        hipError_t e = hipLaunchCooperativeKernel((const void*)mk_fwd, dim3(grid), dim3(NTHREADS), kargs, LDS_BYTES, stream);
        if (e != hipSuccess) { fprintf(stderr, "kernel_launch: launch of phase %d failed: %s\n", p, hipGetErrorString(e)); break; } }
#else
    a.ph_lo = 0; a.ph_hi = NPHASES; void* kargs[] = {&a};
    hipError_t e = hipLaunchCooperativeKernel((const void*)mk_fwd, dim3(grid), dim3(NTHREADS), kargs, LDS_BYTES, stream);
    if (e != hipSuccess) fprintf(stderr, "kernel_launch: cooperative launch failed: %s (grid %d)\n", hipGetErrorString(e), grid);
#endif
}
```

```cpp
#include <hip/hip_runtime.h>
#include <hip/hip_cooperative_groups.h>
#include <cstdio>
#include <cstdint>
namespace cg = cooperative_groups;

#ifndef MK_PER_PHASE
#define MK_PER_PHASE 0
#endif
#ifndef MK_REP_PHASE
#define MK_REP_PHASE -1
#endif
#ifndef MK_CG_SEAMS
#define MK_CG_SEAMS 0
#endif

namespace pg8 {
#define PG8_LAS __attribute__((address_space(3)))
typedef unsigned short bf16_t;
typedef short bf16x8 __attribute__((ext_vector_type(8)));
typedef float f32x4 __attribute__((ext_vector_type(4)));
typedef unsigned u32x4 __attribute__((ext_vector_type(4)));
constexpr int BM = 256, BK = 64, HALF = 128, HTB = HALF * BK * 2, STAGE_BYTES = 8 * HTB, NXCD = 8, WGM = 8;

__host__ __device__ __forceinline__ int lds_byte(int r, int c) { const int st = (r >> 4) * 2 + (c >> 5), rr = r & 15, cc = c & 31, ob = rr * 64 + cc * 2; return st * 1024 + (ob ^ (((ob >> 9) & 1) << 5)); }
__host__ __device__ __forceinline__ void stage_rc(int b, int& R, int& C) { const int st = b / 1024, sb = b % 1024, swz = sb ^ (((sb >> 9) & 1) << 5); R = (st >> 1) * 16 + swz / 64; C = (st & 1) * 32 + (swz % 64) / 2; }
__host__ __device__ __forceinline__ int perm32(int rho) { const int n = rho >> 4, i = rho & 15; return 8 * (i >> 2) + 4 * n + (i & 3); }

struct Unit { int pm, pn, kind; const char* a; const char* b; };
struct Gemm { const bf16_t* A; const bf16_t* Bt; int M, N, K; };

struct StaticOrder {
    int nM, nN, nwg, G, c, rev; const char* A; const char* Bt; size_t tstep;
    __host__ __device__ void init(const Gemm& g, int G_, int c_, int rev_ = 0) { nM = g.M / BM; nN = g.N / BM; nwg = nM * nN; G = G_; c = c_; rev = rev_; A = (const char*)g.A; Bt = (const char*)g.Bt; tstep = (size_t)BM * g.K * 2; }
    __host__ __device__ void map(int wgid, Unit& u) const {
        { const int q = nwg / NXCD, r = nwg % NXCD, xcd = wgid % NXCD, off = wgid / NXCD; wgid = (xcd < r ? xcd * (q + 1) : r * (q + 1) + (xcd - r) * q) + off; }
        const int nig = WGM * nN, gid = wgid / nig, fm = gid * WGM, gsz = (nM - fm) < WGM ? (nM - fm) : WGM;
        u.pm = fm + ((wgid % nig) % gsz); if (rev) u.pm = nM - 1 - u.pm; u.pn = (wgid % nig) / gsz; u.kind = 0; u.a = A + (size_t)u.pm * tstep; u.b = Bt + (size_t)u.pn * tstep;
    }
    __host__ __device__ bool next(int i, Unit& u) const { const long L = (long)i * G + c; if (L >= nwg) return false; map((int)L, u); return true; }
    __device__ __forceinline__ void a_ready(const Unit&) const {}
    __device__ __forceinline__ void done(const Unit&) const {}
};
struct DualOrder {
    StaticOrder o1, o2; int G, c;
    __host__ __device__ bool next(int i, Unit& u) const { const long L = (long)i * G + c; if (L >= o1.nwg + o2.nwg) return false;
        if (L < o1.nwg) o1.map((int)L, u); else { o2.map((int)(L - o1.nwg), u); u.kind = 1; } return true; }
    __device__ __forceinline__ void a_ready(const Unit&) const {}
    __device__ __forceinline__ void done(const Unit&) const {}
};

__device__ __forceinline__ unsigned cvt_pk_bf16(float lo, float hi) { unsigned r; asm volatile("v_cvt_pk_bf16_f32 %0, %1, %2" : "=v"(r) : "v"(lo), "v"(hi)); return r; }

struct EpiStore {
    static constexpr bool PERM = true, AFTER_DRAIN = false;
    bf16_t* O; int nrows;
    __device__ __forceinline__ void operator()(const f32x4 (&acc)[2][2][4][2], const Unit& u, int wr, int wc, int fr, int fq) const {
        const int row0 = u.pm * BM + wr * 64 + fr, col0 = wc * 32 + 8 * fq; bf16_t* blk = O + (size_t)u.pn * nrows * 256;
#pragma unroll
        for (int ai = 0; ai < 2; ++ai)
#pragma unroll
            for (int m = 0; m < 4; ++m) { bf16_t* rowp = blk + (size_t)(row0 + ai * HALF + m * 16) * 256 + col0;
#pragma unroll
                for (int bj = 0; bj < 2; ++bj) { const f32x4 v0 = acc[ai][bj][m][0], v1 = acc[ai][bj][m][1];
                    u32x4 w; w.x = cvt_pk_bf16(v0[0], v0[1]); w.y = cvt_pk_bf16(v0[2], v0[3]); w.z = cvt_pk_bf16(v1[0], v1[1]); w.w = cvt_pk_bf16(v1[2], v1[3]);
                    *(u32x4*)(rowp + bj * HALF) = w; } }
    }
};
struct EpiStoreBlk {
    static constexpr bool PERM = true, AFTER_DRAIN = false;
    bf16_t* O; int nrows;
    __device__ __forceinline__ void operator()(const f32x4 (&acc)[2][2][4][2], const Unit& u, int wr, int wc, int fr, int fq) const {
        const int row0 = u.pm * BM + wr * 64 + fr;
#pragma unroll
        for (int ai = 0; ai < 2; ++ai)
#pragma unroll
            for (int m = 0; m < 4; ++m) { const int r = row0 + ai * HALF + m * 16;
#pragma unroll
                for (int bj = 0; bj < 2; ++bj) { const f32x4 v0 = acc[ai][bj][m][0], v1 = acc[ai][bj][m][1];
                    u32x4 w; w.x = cvt_pk_bf16(v0[0], v0[1]); w.y = cvt_pk_bf16(v0[2], v0[3]); w.z = cvt_pk_bf16(v1[0], v1[1]); w.w = cvt_pk_bf16(v1[2], v1[3]);
                    const int g32 = u.pn * 8 + bj * 4 + wc;
                    *(u32x4*)(O + ((size_t)g32 * (nrows >> 4) + (r >> 4)) * 512 + fq * 128 + (r & 15) * 8) = w; } }
    }
};
struct EpiDual {
    static constexpr bool PERM = true, AFTER_DRAIN = false;
    EpiStore e0; EpiStoreBlk e1;
    __device__ __forceinline__ void operator()(const f32x4 (&acc)[2][2][4][2], const Unit& u, int wr, int wc, int fr, int fq) const { if (u.kind == 0) e0(acc, u, wr, wc, fr, fq); else e1(acc, u, wr, wc, fr, fq); }
};
struct EpiStoreRM {
    static constexpr bool PERM = true, AFTER_DRAIN = false;
    bf16_t* O; int ldc;
    __device__ __forceinline__ void operator()(const f32x4 (&acc)[2][2][4][2], const Unit& u, int wr, int wc, int fr, int fq) const {
        const int row0 = u.pm * BM + wr * 64 + fr, col0 = u.pn * BM + wc * 32 + 8 * fq;
#pragma unroll
        for (int ai = 0; ai < 2; ++ai)
#pragma unroll
            for (int m = 0; m < 4; ++m) { const int row = row0 + ai * HALF + m * 16; bf16_t* rowp = O + (size_t)row * ldc + col0;
#pragma unroll
                for (int bj = 0; bj < 2; ++bj) { const f32x4 v0 = acc[ai][bj][m][0], v1 = acc[ai][bj][m][1];
                    u32x4 w; w.x = cvt_pk_bf16(v0[0], v0[1]); w.y = cvt_pk_bf16(v0[2], v0[3]); w.z = cvt_pk_bf16(v1[0], v1[1]); w.w = cvt_pk_bf16(v1[2], v1[3]);
                    *(u32x4*)(rowp + bj * HALF) = w; } }
    }
};
struct EpiStoreSsq {
    static constexpr bool PERM = true, AFTER_DRAIN = false;
    bf16_t* O; int ldc; float* ssq;
    __device__ __forceinline__ void operator()(const f32x4 (&acc)[2][2][4][2], const Unit& u, int wr, int wc, int fr, int fq) const {
        const int row0 = u.pm * BM + wr * 64 + fr, col0 = u.pn * BM + wc * 32 + 8 * fq;
#pragma unroll
        for (int ai = 0; ai < 2; ++ai)
#pragma unroll
            for (int m = 0; m < 4; ++m) { const int row = row0 + ai * HALF + m * 16; bf16_t* rowp = O + (size_t)row * ldc + col0; float s = 0.f;
#pragma unroll
                for (int bj = 0; bj < 2; ++bj) { const f32x4 v0 = acc[ai][bj][m][0], v1 = acc[ai][bj][m][1];
                    s += (v0[0] * v0[0] + v0[1] * v0[1]) + (v0[2] * v0[2] + v0[3] * v0[3]) + (v1[0] * v1[0] + v1[1] * v1[1]) + (v1[2] * v1[2] + v1[3] * v1[3]);
                    u32x4 w; w.x = cvt_pk_bf16(v0[0], v0[1]); w.y = cvt_pk_bf16(v0[2], v0[3]); w.z = cvt_pk_bf16(v1[0], v1[1]); w.w = cvt_pk_bf16(v1[2], v1[3]);
                    *(u32x4*)(rowp + bj * HALF) = w; }
                s += __shfl_xor(s, 16); s += __shfl_xor(s, 32);
                if (fq == 0) ssq[(size_t)row * 16 + u.pn * 4 + wc] = s; }
    }
};
struct EpiSwiglu {
    static constexpr bool PERM = true, AFTER_DRAIN = false;
    bf16_t* O; int ldc;
    __device__ __forceinline__ void operator()(const f32x4 (&acc)[2][2][4][2], const Unit& u, int wr, int wc, int fr, int fq) const {
        const int row0 = u.pm * BM + wr * 64 + fr, col0 = u.pn * HALF + wc * 32 + 8 * fq;
#pragma unroll
        for (int ai = 0; ai < 2; ++ai)
#pragma unroll
            for (int m = 0; m < 4; ++m) { bf16_t* rowp = O + (size_t)(row0 + ai * HALF + m * 16) * ldc + col0; float a[8];
#pragma unroll
                for (int n = 0; n < 2; ++n)
#pragma unroll
                    for (int i = 0; i < 4; ++i) { const float g = acc[ai][0][m][n][i], uu = acc[ai][1][m][n][i]; a[n * 4 + i] = (g * uu) * __builtin_amdgcn_rcpf(1.0f + __builtin_amdgcn_exp2f(-g)); }
                u32x4 w; w.x = cvt_pk_bf16(a[0], a[1]); w.y = cvt_pk_bf16(a[2], a[3]); w.z = cvt_pk_bf16(a[4], a[5]); w.w = cvt_pk_bf16(a[6], a[7]);
                *(u32x4*)rowp = w; }
    }
};

template <class Epi, class Sched, bool ALIGN_EPI = false, bool SP2 = false>
__device__ __forceinline__ void gemm_phase(PG8_LAS unsigned char* lds, const Gemm g, const Sched& S, const Epi& E) {
    const int tid = threadIdx.x, wid = __builtin_amdgcn_readfirstlane(tid >> 6), lane = tid & 63, wr = wid >> 2, wc = wid & 3, fr = lane & 15, fq = lane >> 4;
    const int K = g.K, nt = K / BK;
    unsigned voffA[2], voffB[2];
#pragma unroll
    for (int i = 0; i < 2; ++i) { int R, C; stage_rc(tid * 16 + i * 8192, R, C); const int Rb = Epi::PERM ? ((R & ~31) + perm32(R & 31)) : R;
        voffA[i] = (unsigned)(R * K + C) * 2u; voffB[i] = (unsigned)(Rb * K + C) * 2u; }
    const size_t kstep = (size_t)(BK * 2);
    const size_t hstep = (size_t)HALF * K * 2;
    const unsigned ldsw = (unsigned)wid * 1024u;
    const int aoff = lds_byte(wr * 64 + fr, fq * 8), boff = lds_byte(wc * 32 + fr, fq * 8);
#define PG8_SA(b, h) (((b) * 2 + (h)) * HTB)
#define PG8_SB(b, h) ((4 + (b) * 2 + (h)) * HTB)
#define PG8_STAGE(bufoff, gbase, voff) do { _Pragma("unroll") for (int _i = 0; _i < 2; ++_i) \
        __builtin_amdgcn_global_load_lds((const unsigned*)((const char*)(gbase) + (voff)[_i]), (PG8_LAS unsigned*)(lds + (bufoff) + ldsw + _i * 8192), 16, 0, 0); } while (0)
#define PG8_LDA(dst, b, h) do { _Pragma("unroll") for (int m = 0; m < 4; ++m) _Pragma("unroll") for (int k = 0; k < 2; ++k) dst[m][k] = *(const PG8_LAS bf16x8*)(lds + PG8_SA(b, h) + aoff + m * 2048 + k * 1024); } while (0)
#define PG8_LDB(dst, b, h) do { _Pragma("unroll") for (int n = 0; n < 2; ++n) _Pragma("unroll") for (int k = 0; k < 2; ++k) dst[n][k] = *(const PG8_LAS bf16x8*)(lds + PG8_SB(b, h) + boff + n * 2048 + k * 1024); } while (0)
#define PG8_MMA(ai, bj, At, Bt) do { __builtin_amdgcn_s_setprio(1); _Pragma("unroll") for (int m = 0; m < 4; ++m) _Pragma("unroll") for (int n = 0; n < 2; ++n) _Pragma("unroll") for (int k = 0; k < 2; ++k) \
        acc[ai][bj][m][n] = __builtin_amdgcn_mfma_f32_16x16x32_bf16(Bt[n][k], At[m][k], acc[ai][bj][m][n], 0, 0, 0); __builtin_amdgcn_s_setprio(0); } while (0)
#define PG8_WAIT_V(n) asm volatile("s_waitcnt vmcnt(" #n ")" ::: "memory")
#define PG8_WAIT_L(n) asm volatile("s_waitcnt lgkmcnt(" #n ")" ::: "memory")
#define PG8_BAR __builtin_amdgcn_s_barrier()
#define PG8_SCHED __builtin_amdgcn_sched_barrier(0)
    Unit cur, nxt; int ui = 0;
    if (!S.next(0, cur)) return;
    f32x4 acc[2][2][4][2];
#pragma unroll
    for (int a = 0; a < 2; ++a)
#pragma unroll
        for (int b = 0; b < 2; ++b)
#pragma unroll
            for (int m = 0; m < 4; ++m)
#pragma unroll
                for (int n = 0; n < 2; ++n) acc[a][b][m][n] = (f32x4){0.f, 0.f, 0.f, 0.f};
    bf16x8 At[4][2], B0[2][2], B1[2][2];
    const char* cA = cur.a; const char* cB = cur.b;
    S.a_ready(cur);
    if constexpr (SP2) {
        PG8_STAGE(PG8_SB(0, 0), cB, voffB); PG8_STAGE(PG8_SB(0, 1), cB + hstep, voffB); PG8_STAGE(PG8_SA(0, 0), cA, voffA); PG8_STAGE(PG8_SA(0, 1), cA + hstep, voffA);
        if (wr == 1) PG8_BAR;
        PG8_WAIT_V(2); PG8_BAR;
        PG8_STAGE(PG8_SB(1, 0), cB + kstep, voffB); PG8_STAGE(PG8_SA(1, 0), cA + kstep, voffA); PG8_STAGE(PG8_SB(1, 1), cB + hstep + kstep, voffB);
        PG8_WAIT_V(6); PG8_BAR;
    } else {
        PG8_STAGE(PG8_SB(0, 0), cB, voffB); PG8_STAGE(PG8_SA(0, 0), cA, voffA); PG8_STAGE(PG8_SB(0, 1), cB + hstep, voffB); PG8_STAGE(PG8_SA(0, 1), cA + hstep, voffA);
        if (wr == 1) PG8_BAR;
        PG8_WAIT_V(4); PG8_BAR;
        PG8_STAGE(PG8_SB(1, 0), cB + kstep, voffB); PG8_STAGE(PG8_SA(1, 0), cA + kstep, voffA); PG8_STAGE(PG8_SB(1, 1), cB + hstep + kstep, voffB);
        PG8_WAIT_V(6); PG8_BAR;
    }
    for (;;) {
        const bool has_next = S.next(ui + 1, nxt);
        const char* nA = has_next ? nxt.a : cA; const char* nB = has_next ? nxt.b : cB;
        for (int t = 0; t < nt; t += 2) {
            const bool last = (t == nt - 2);
            const char* a1 = cA + (size_t)(t + 1) * kstep;
            const char* a2 = last ? nA : cA + (size_t)(t + 2) * kstep; const char* b2 = last ? nB : cB + (size_t)(t + 2) * kstep;
            const char* a3 = a2 + kstep; const char* b3 = b2 + kstep;
            if (last && has_next) S.a_ready(nxt);
            if constexpr (SP2) {
            PG8_LDB(B0, 0, 0); PG8_LDB(B1, 0, 1); PG8_SCHED; PG8_LDA(At, 0, 0); PG8_STAGE(PG8_SA(1, 1), a1 + hstep, voffA);
            PG8_WAIT_V(8); PG8_WAIT_L(0); PG8_BAR; PG8_MMA(0, 0, At, B0); PG8_MMA(0, 1, At, B1); PG8_BAR; PG8_SCHED;
            PG8_LDA(At, 0, 1); PG8_STAGE(PG8_SB(0, 0), b2, voffB); PG8_STAGE(PG8_SB(0, 1), b2 + hstep, voffB); PG8_STAGE(PG8_SA(0, 0), a2, voffA);
            PG8_WAIT_V(8); PG8_WAIT_L(0); PG8_BAR; PG8_MMA(1, 0, At, B0); PG8_MMA(1, 1, At, B1); PG8_BAR; PG8_SCHED;
            PG8_LDB(B0, 1, 0); PG8_LDB(B1, 1, 1); PG8_SCHED; PG8_LDA(At, 1, 0); PG8_STAGE(PG8_SA(0, 1), a2 + hstep, voffA);
            PG8_WAIT_V(8); PG8_WAIT_L(0); PG8_BAR; PG8_MMA(0, 0, At, B0); PG8_MMA(0, 1, At, B1); PG8_BAR; PG8_SCHED;
            PG8_LDA(At, 1, 1); PG8_STAGE(PG8_SB(1, 0), b3, voffB); PG8_STAGE(PG8_SB(1, 1), b3 + hstep, voffB); PG8_STAGE(PG8_SA(1, 0), a3, voffA);
            PG8_WAIT_V(8); PG8_WAIT_L(0); PG8_BAR; PG8_MMA(1, 0, At, B0); PG8_MMA(1, 1, At, B1); PG8_BAR; PG8_SCHED;
            } else {
            PG8_LDB(B0, 0, 0); PG8_SCHED; PG8_LDA(At, 0, 0); PG8_STAGE(PG8_SA(1, 1), a1 + hstep, voffA);
            PG8_WAIT_L(8); PG8_BAR; PG8_WAIT_L(0); PG8_MMA(0, 0, At, B0); PG8_BAR; PG8_SCHED;
            PG8_LDB(B1, 0, 1); PG8_STAGE(PG8_SB(0, 0), b2, voffB);
            PG8_BAR; PG8_WAIT_L(0); PG8_MMA(0, 1, At, B1); PG8_BAR;
            PG8_LDA(At, 0, 1); PG8_STAGE(PG8_SA(0, 0), a2, voffA);
            PG8_BAR; PG8_WAIT_L(0); PG8_MMA(1, 0, At, B0); PG8_BAR; PG8_SCHED;
            PG8_STAGE(PG8_SB(0, 1), b2 + hstep, voffB);
            PG8_WAIT_V(6); PG8_BAR; PG8_MMA(1, 1, At, B1); PG8_BAR;
            PG8_LDB(B0, 1, 0); PG8_SCHED; PG8_LDA(At, 1, 0); PG8_STAGE(PG8_SA(0, 1), a2 + hstep, voffA);
            PG8_WAIT_L(8); PG8_BAR; PG8_WAIT_L(0); PG8_MMA(0, 0, At, B0); PG8_BAR; PG8_SCHED;
            PG8_LDB(B1, 1, 1); PG8_STAGE(PG8_SB(1, 0), b3, voffB);
            PG8_BAR; PG8_WAIT_L(0); PG8_MMA(0, 1, At, B1); PG8_BAR;
            PG8_LDA(At, 1, 1); PG8_STAGE(PG8_SA(1, 0), a3, voffA);
            PG8_BAR; PG8_WAIT_L(0); PG8_MMA(1, 0, At, B0); PG8_BAR; PG8_SCHED;
            PG8_STAGE(PG8_SB(1, 1), b3 + hstep, voffB);
            PG8_WAIT_V(6); PG8_BAR; PG8_MMA(1, 1, At, B1); PG8_BAR;
            }
        }
        if constexpr (ALIGN_EPI) { if (wr == 0) PG8_BAR; }
        if constexpr (!Epi::AFTER_DRAIN) { E(acc, cur, wr, wc, fr, fq); S.done(cur); }
        if (!has_next) break;
#pragma unroll
        for (int a = 0; a < 2; ++a)
#pragma unroll
            for (int b = 0; b < 2; ++b)
#pragma unroll
                for (int m = 0; m < 4; ++m)
#pragma unroll
                    for (int n = 0; n < 2; ++n) acc[a][b][m][n] = (f32x4){0.f, 0.f, 0.f, 0.f};
        cur = nxt; cA = nA; cB = nB; ++ui;
        if constexpr (ALIGN_EPI) { if (wr == 1) PG8_BAR; }
    }
    PG8_WAIT_V(0);
    if constexpr (!ALIGN_EPI) { if (wr == 0) PG8_BAR; }
    PG8_BAR;
#undef PG8_SA
#undef PG8_SB
#undef PG8_STAGE
#undef PG8_LDA
#undef PG8_LDB
#undef PG8_MMA
#undef PG8_WAIT_V
#undef PG8_WAIT_L
#undef PG8_BAR
#undef PG8_SCHED
}
}

typedef unsigned short bf16;
typedef short bf16x8 __attribute__((ext_vector_type(8)));
typedef float f32x4 __attribute__((ext_vector_type(4)));
typedef unsigned u32x4 __attribute__((ext_vector_type(4)));
typedef unsigned u32x2 __attribute__((ext_vector_type(2)));
#define LAS __attribute__((address_space(3)))

constexpr int NB = 8, SEQ = 8192, DM = 1024, CTXL = 256;
constexpr int MLAT = NB * SEQ, MCTX = NB * CTXL, MTOT = MLAT + MCTX;
constexpr int LDP = 2304;
constexpr int CQ = 0, CK = 512, CGQ = 1024, CGK = 1280, CGR = 1536, CAF = 2048, CAB = 2064;
__device__ __forceinline__ size_t vt_off(int row, int tok) { return ((size_t)(tok >> 5) * 64 + (row >> 4)) * 512 + ((tok >> 3) & 3) * 128 + (row & 15) * 8; }
__device__ __forceinline__ size_t p1_off(int row, int col) { return ((size_t)(col >> 8) * MTOT + row) * 256 + (col & 255); }
constexpr int FFN = 2816, NMOD = 6 * DM;
constexpr int NCH = 132;
constexpr float EPS = 1e-6f;

constexpr size_t MiB = 1u << 20;
constexpr size_t WS_CTL = 0, CTL_ZERO_BYTES = 1 * MiB;
constexpr size_t WS_MOD = 1 * MiB;
constexpr size_t WS_ROPE = 1 * MiB + 512 * 1024;
constexpr size_t WS_WMAIN = 2 * MiB;
constexpr size_t WS_WV = 7 * MiB;
constexpr size_t WS_WOUT = 9 * MiB;
constexpr size_t WS_WGU = 11 * MiB;
constexpr size_t WS_WDOWN = 22 * MiB;
constexpr size_t WS_H = 32 * MiB;
constexpr size_t WS_P1 = 164 * MiB;
constexpr size_t WS_VT = 461 * MiB;
constexpr size_t WS_KV = 593 * MiB;
constexpr size_t WS_DEC = 725 * MiB;
constexpr size_t WS_SSQ1 = 728 * MiB;
constexpr size_t WS_SSQ2 = 732 * MiB;
constexpr size_t WS_MIX = 736 * MiB;
constexpr size_t WS_Y = WS_KV;
constexpr size_t WS_ACT = WS_P1;
constexpr size_t WS_DOWN = WS_MIX;
constexpr size_t WS_X1B = 869 * MiB + 8448;
constexpr size_t WS_END = 998 * MiB;
static_assert(WS_P1 + (size_t)MTOT * LDP * 2 <= WS_VT && WS_VT + (size_t)1024 * MTOT * 2 <= WS_KV && WS_KV + (size_t)64 * NCH * 128 * 64 * 2 <= WS_DEC, "ws map");
static_assert(WS_ACT + (size_t)MLAT * FFN * 2 <= WS_KV && WS_H + (size_t)MTOT * DM * 2 <= WS_P1 && WS_MIX + (size_t)MLAT * DM * 2 <= WS_END, "ws map 2");

constexpr int LDS_BYTES = 147456;
constexpr int NTHREADS = 512;

__device__ __forceinline__ unsigned f2bf(float f) { unsigned u = __builtin_bit_cast(unsigned, f); return (u + 0x7fffu + ((u >> 16) & 1u)) >> 16; }
typedef float f32x2_t __attribute__((ext_vector_type(2)));
typedef __bf16 bf16x2_t __attribute__((ext_vector_type(2)));
__device__ __forceinline__ unsigned pk2(float lo, float hi) { const f32x2_t v = {lo, hi}; return __builtin_bit_cast(unsigned, __builtin_convertvector(v, bf16x2_t)); }
__device__ __forceinline__ float bflo(unsigned w) { return __builtin_bit_cast(float, w << 16); }
__device__ __forceinline__ float bfhi(unsigned w) { return __builtin_bit_cast(float, w & 0xffff0000u); }
__device__ __forceinline__ float wave_sum(float v) {
#pragma unroll
    for (int o = 1; o < 64; o <<= 1) v += __shfl_xor(v, o);
    return v;
}
__device__ __forceinline__ void unpack8(const u32x4 w, float (&o)[8]) { o[0] = bflo(w.x); o[1] = bfhi(w.x); o[2] = bflo(w.y); o[3] = bfhi(w.y); o[4] = bflo(w.z); o[5] = bfhi(w.z); o[6] = bflo(w.w); o[7] = bfhi(w.w); }
__device__ __forceinline__ float logsig16(float z) { return (fminf(z, 0.f) - __builtin_amdgcn_logf(1.0f + __builtin_amdgcn_exp2f(-fabsf(z)))) * (1.0f / 16.0f); }

#define XB_TMO      128
#define XB_XCNT(j)  (256  + 64 * (j))
#define XB_XSUB(j)  (1280 + 64 * (j))
#define XB_XGEN(j)  (2304 + 64 * (j))
#define XB_TOP      3328
#define XB_TOPGEN   3392
#define XCD_BAR_WORDS 3456
#define XB_SPIN_CAP (1u << 18)
__device__ __forceinline__ unsigned xb_ld(unsigned* p)              { return __hip_atomic_load(p, __ATOMIC_RELAXED, __HIP_MEMORY_SCOPE_AGENT); }
__device__ __forceinline__ unsigned xb_add(unsigned* p, unsigned v) { return __hip_atomic_fetch_add(p, v, __ATOMIC_RELAXED, __HIP_MEMORY_SCOPE_AGENT); }
__device__ __forceinline__ unsigned xb_xcc_id() { return (unsigned)__builtin_amdgcn_s_getreg((3 << 11) | 20) & 0xFu; }
#define XB_SPIN(cond, bar) do { unsigned _sp = 0; while (cond) { __builtin_amdgcn_s_sleep(1); \
    if ((++_sp & 255u) == 0u) { if (xb_ld(&(bar)[XB_TMO])) break; if (_sp > XB_SPIN_CAP) { atomicAdd(&(bar)[XB_TMO], 1u); break; } } } } while (0)
struct XcdBarrier { unsigned* bar; unsigned x; volatile unsigned* st; };
__device__ __forceinline__ XcdBarrier xcd_barrier_post(unsigned* bar, volatile unsigned* st) {
    XcdBarrier b; b.bar = bar; b.x = xb_xcc_id(); b.st = st;
    if (threadIdx.x == 0) (void)xb_add(&bar[XB_XCNT(b.x)], 1u);
    return b;
}
__device__ __forceinline__ void xcd_barrier_complete(unsigned* bar, unsigned x, unsigned& nloc, unsigned& nx) {
    const unsigned G = gridDim.x * gridDim.y * gridDim.z;
    unsigned sum, cnt, mine, sp = 0u;
    for (;;) {
        sum = 0u; cnt = 0u; mine = 0u;
#pragma unroll
        for (unsigned j = 0; j < 16; ++j) { const unsigned c = xb_ld(&bar[XB_XCNT(j)]); sum += c; cnt += (c > 0u) ? 1u : 0u; mine = (j == x) ? c : mine; }
        if (sum == G) break;
        __builtin_amdgcn_s_sleep(1);
        if ((++sp & 255u) == 0u) { if (xb_ld(&bar[XB_TMO])) break; if (sp > XB_SPIN_CAP) { atomicAdd(&bar[XB_TMO], 1u); break; } }
    }
    nloc = mine > 0u ? mine : 1u; nx = cnt > 0u ? cnt : 1u;
}
__device__ __forceinline__ void xcd_barrier(const XcdBarrier& b) {
    asm volatile("s_waitcnt vmcnt(0)" ::: "memory");
    __syncthreads();
    if (threadIdx.x == 0) {
        unsigned* bar = b.bar;
        __builtin_amdgcn_s_waitcnt(0);
        unsigned nloc = b.st[0], nx = b.st[1];
        if (nloc == 0u) { xcd_barrier_complete(bar, b.x, nloc, nx); b.st[0] = nloc; b.st[1] = nx; }
        const unsigned old = xb_add(&bar[XB_XSUB(b.x)], 1u);
        const unsigned gen = old / nloc;
        if (old + 1u == (gen + 1u) * nloc) {
            __builtin_amdgcn_fence(__ATOMIC_RELEASE, "agent");
            asm volatile("s_waitcnt vmcnt(0)" ::: "memory");
            const unsigned og = xb_add(&bar[XB_TOP], 1u);
            const unsigned tg = og / nx;
            if (og + 1u == (tg + 1u) * nx) xb_add(&bar[XB_TOPGEN], 1u);
            else XB_SPIN(xb_ld(&bar[XB_TOPGEN]) == tg, bar);
            __builtin_amdgcn_fence(__ATOMIC_ACQUIRE, "agent");
            xb_add(&bar[XB_XGEN(b.x)], 1u);
            asm volatile("s_waitcnt vmcnt(0)" ::: "memory");
        } else {
            XB_SPIN(xb_ld(&bar[XB_XGEN(b.x)]) == gen, bar);
            __builtin_amdgcn_fence(__ATOMIC_ACQUIRE, "agent");
            asm volatile("s_waitcnt vmcnt(0)" ::: "memory");
        }
    }
    __syncthreads();
}

struct Frame {
    unsigned char* lds;
    int tid, lane, wave, G;
    const float *x, *c, *ctx, *c_ctx, *w_mod, *b_mod, *g_pre_mix, *g_post_mix, *g_pre_ffn, *g_post_ffn, *w_in, *rpb, *wa2_f, *ba_f, *wa2_b, *ba_b, *gla_norm, *w_out, *w_gu, *w_down;
    float* out;
    float *MOD, *ROPE, *DEC, *SSQ1, *SSQ2;
    bf16 *WMAIN, *WV, *WOUT, *WGU, *WDOWN, *H, *P1, *VT, *KV, *MIX, *Y, *ACT, *DOWN, *X1B;
};

__device__ __forceinline__ void ph0_mod(const Frame& F) {
    float* S = (float*)F.lds;
    float* PART = S + 9 * 1024;
    for (int i = F.tid; i < 9 * 1024; i += NTHREADS) { const int r = i >> 10, k = i & 1023; const float v = r < 8 ? F.c[r * 1024 + k] : F.c_ctx[k]; S[i] = v * __builtin_amdgcn_rcpf(1.0f + __expf(-v)); }
    __syncthreads();
    for (int cgp = blockIdx.x; cgp < 256; cgp += F.G) {
        const int n0 = cgp * 24, cgi = F.tid % 6, ks = F.tid / 6;
        float acc[9][4];
#pragma unroll
        for (int r = 0; r < 9; ++r)
#pragma unroll
            for (int j = 0; j < 4; ++j) acc[r][j] = 0.f;
        if (ks < 85) {
            f32x4 wv[13];
#pragma unroll
            for (int i = 0; i < 13; ++i) { const int k = ks + 85 * i; wv[i] = (k < 1024) ? *(const f32x4*)(F.w_mod + (size_t)k * NMOD + n0 + 4 * cgi) : (f32x4){0.f, 0.f, 0.f, 0.f}; }
#pragma unroll
            for (int i = 0; i < 13; ++i) { const int k = (ks + 85 * i < 1024) ? ks + 85 * i : 1023; const f32x4 w = wv[i];
#pragma unroll
                for (int r = 0; r < 9; ++r) { const float s = S[r * 1024 + k]; acc[r][0] += s * w[0]; acc[r][1] += s * w[1]; acc[r][2] += s * w[2]; acc[r][3] += s * w[3]; } }
#pragma unroll
            for (int r = 0; r < 9; ++r)
#pragma unroll
                for (int j = 0; j < 4; ++j) PART[(ks * 9 + r) * 24 + cgi * 4 + j] = acc[r][j];
        }
        __syncthreads();
        if (F.tid < 216) { const int r = F.tid / 24, col = F.tid % 24; float s = 0.f; for (int k2 = 0; k2 < 85; ++k2) s += PART[(k2 * 9 + r) * 24 + col]; F.MOD[r * NMOD + n0 + col] = s + F.b_mod[n0 + col]; }
        __syncthreads();
    }
}

__device__ __forceinline__ void transpose_item(const float* W, int ldn, int k0, int nsrc0, bf16* WT, int ldk, int drow0, float* scr, int lane, float scale = 1.0f) {
#pragma unroll
    for (int i = 0; i < 32; ++i) { const int kk = 2 * i + (lane >> 5); scr[kk * 33 + (lane & 31)] = W[(size_t)(k0 + kk) * ldn + nsrc0 + (lane & 31)] * scale; }
    __builtin_amdgcn_wave_barrier();
    const int c = lane & 7;
#pragma unroll
    for (int j = 0; j < 4; ++j) { const int n = (lane >> 3) + 8 * j; const float* s = scr + (8 * c) * 33 + n;
        u32x4 o; o.x = pk2(s[0 * 33], s[1 * 33]); o.y = pk2(s[2 * 33], s[3 * 33]); o.z = pk2(s[4 * 33], s[5 * 33]); o.w = pk2(s[6 * 33], s[7 * 33]);
        *(u32x4*)(WT + (size_t)(drow0 + n) * ldk + k0 + 8 * c) = o; }
    __builtin_amdgcn_wave_barrier();
}
constexpr int TI_MAIN = 16 * 65, TI_V = 16 * 32, TI_OUT = 16 * 32, TI_GU = 16 * 176, TI_DOWN = 44 * 32, TI_ALL = TI_MAIN + TI_V + TI_OUT + TI_GU + TI_DOWN;
__device__ __forceinline__ void transpose_dispatch(const Frame& F, int it, float* scr) {
    int r = it;
    if (r < TI_MAIN) { const int kb = r / 65, nb = r % 65, dr = nb * 32; const int sc = dr < 1024 ? dr : (dr < 1536 ? dr + 512 : dr + 1024); transpose_item(F.w_in, 3104, kb * 64, sc, F.WMAIN, DM, dr, scr, F.lane, (dr >= CGR && dr < CAF) ? 1.4426950408889634f : 1.0f); return; } r -= TI_MAIN;
    if (r < TI_V) { const int kb = r / 32, nb = r % 32, dr = nb * 32; const int sc = dr < 512 ? dr + 1024 : dr + 1536; transpose_item(F.w_in, 3104, kb * 64, sc, F.WV, DM, dr, scr, F.lane); return; } r -= TI_V;
    if (r < TI_OUT) { const int kb = r / 32, nb = r % 32; transpose_item(F.w_out, DM, kb * 64, nb * 32, F.WOUT, DM, nb * 32, scr, F.lane); return; } r -= TI_OUT;
    if (r < TI_GU) { const int kb = r / 176, nb = r % 176, dr = nb * 32, pn = dr >> 8, jj = dr & 255; const int sc = jj < 128 ? 128 * pn + jj : FFN + 128 * pn + (jj - 128); transpose_item(F.w_gu, 2 * FFN, kb * 64, sc, F.WGU, DM, dr, scr, F.lane, jj < 128 ? 1.4426950408889634f : 0.6931471805599453f); return; } r -= TI_GU;
    { const int kb = r / 32, nb = r % 32; transpose_item(F.w_down, DM, kb * 64, nb * 32, F.WDOWN, FFN, nb * 32, scr, F.lane); }
}
__device__ __forceinline__ u32x4* gate_wb_global(const Frame& F) { return (u32x4*)((unsigned char*)F.ROPE + 65536); }
__device__ __forceinline__ float* gate_bias_global(const Frame& F) { return (float*)((unsigned char*)F.ROPE + 65536 + 32768); }
__device__ __forceinline__ void build_small_tables(const Frame& F, int rank, int nidle) {
    for (int t = rank; t < 9; t += nidle) {
        if (t < 4) { const int i = t * NTHREADS + F.tid;
            const int pos = i >> 4, ii = i & 15; const float inv = (float)pow(10000.0, -(double)ii / 16.0); const float ang = (float)pos * inv;
            F.ROPE[i] = (float)cos((double)ang); F.ROPE[2048 + i] = (float)sin((double)ang);
        } else if (t < 8) { const int e = (t - 4) * NTHREADS + F.tid; const int ln = e & 63, dt = (e >> 6) & 3, dirh = e >> 8, fq = ln >> 4, dd = ln & 15; const float* wa = (dirh >> 2) ? F.wa2_b : F.wa2_f; const int hh = dirh & 3;
            u32x4 v = (u32x4){0u, 0u, 0u, 0u};
            if (fq < 2) { float tt[8];
#pragma unroll
                for (int jj = 0; jj < 8; ++jj) tt[jj] = wa[(8 * fq + jj) * 256 + hh * 64 + 16 * dt + dd] * 1.4426950408889634f;
                v.x = pk2(tt[0], tt[1]); v.y = pk2(tt[2], tt[3]); v.z = pk2(tt[4], tt[5]); v.w = pk2(tt[6], tt[7]); }
            gate_wb_global(F)[e] = v;
        } else { const int dh = F.tid >> 6, dd = F.tid & 63; gate_bias_global(F)[F.tid] = ((dh >> 2) ? F.ba_b : F.ba_f)[(dh & 3) * 64 + dd] * 1.4426950408889634f; }
    }
}
__device__ __forceinline__ void ph2_tail_weights(const Frame& F, int nunits) {
    const int nfull = nunits % F.G, c = (int)blockIdx.x;
    const int rank = (c >= nfull) ? c - nfull : -1, nidle = F.G - nfull;
    __syncthreads();
    if (rank < 0) return;
    float* scr = (float*)(F.lds + F.wave * 16384);
    for (int it = TI_MAIN + TI_V + rank * 8 + F.wave; it < TI_ALL; it += nidle * 8) transpose_dispatch(F, it, scr);
    build_small_tables(F, rank, nidle);
}
__device__ __forceinline__ void ph1_rows(const Frame& F) {
    const int gw = blockIdx.x * 8 + F.wave, NGW = F.G * 8;
    float* CA = (float*)F.lds; float* CB = CA + 9 * DM;
    { f32x4 m0[5], m1[5], gp[5];
#pragma unroll
      for (int k = 0; k < 5; ++k) { int i4 = F.tid + k * NTHREADS; i4 = i4 < 9 * 256 ? i4 : 0; const int bb = i4 >> 8, col = 4 * (i4 & 255); m0[k] = *(const f32x4*)(F.MOD + bb * NMOD + col); m1[k] = *(const f32x4*)(F.MOD + bb * NMOD + DM + col); gp[k] = *(const f32x4*)(F.g_pre_mix + col); }
#pragma unroll
      for (int k = 0; k < 5; ++k) { const int i4 = F.tid + k * NTHREADS; if (i4 < 9 * 256) { *(f32x4*)(CA + 4 * i4) = gp[k] * (m1[k] + 1.0f); *(f32x4*)(CB + 4 * i4) = m0[k]; } } }
    __syncthreads();
    int curb = -1; f32x4 cA[4], cB[4];
#pragma unroll
    for (int j = 0; j < 4; ++j) { cA[j] = (f32x4){0.f, 0.f, 0.f, 0.f}; cB[j] = cA[j]; }
    for (int row0 = gw; row0 < MTOT; row0 += 2 * NGW) {
        const int nr = (row0 + NGW < MTOT) ? 2 : 1;
        f32x4 v[2][4];
#pragma unroll
        for (int q = 0; q < 2; ++q) { const int row = (q < nr) ? row0 + q * NGW : row0; const float* src = row < MLAT ? F.x + (size_t)row * DM : F.ctx + (size_t)(row - MLAT) * DM;
#pragma unroll
            for (int j = 0; j < 4; ++j) v[q][j] = __builtin_nontemporal_load((const f32x4*)src + F.lane + 64 * j); }
#pragma unroll
        for (int q = 0; q < 2; ++q) { if (q < nr) { const int row = row0 + q * NGW; const int b = row < MLAT ? (row >> 13) : 8; float ss = 0.f;
#pragma unroll
            for (int j = 0; j < 4; ++j) ss += (v[q][j][0] * v[q][j][0] + v[q][j][1] * v[q][j][1]) + (v[q][j][2] * v[q][j][2] + v[q][j][3] * v[q][j][3]);
            if (b != curb) { curb = b;
#pragma unroll
                for (int j = 0; j < 4; ++j) { const int o = b * DM + 4 * (F.lane + 64 * j); cA[j] = *(const f32x4*)(CA + o); cB[j] = *(const f32x4*)(CB + o); } }
            const float rstd = __builtin_amdgcn_rsqf(wave_sum(ss) * (1.0f / DM) + EPS);
#pragma unroll
            for (int j = 0; j < 4; ++j) { const f32x4 o = v[q][j] * rstd * cA[j] + cB[j]; u32x2 w; w.x = pk2(o[0], o[1]); w.y = pk2(o[2], o[3]); *(u32x2*)(F.H + (size_t)row * DM + 4 * (F.lane + 64 * j)) = w; } } }
    }
    __syncthreads();
    float* scr = (float*)(F.lds + F.wave * 16384);
    for (int it = gw; it < TI_MAIN + TI_V; it += NGW) transpose_dispatch(F, it, scr);
    for (int i = blockIdx.x * NTHREADS + F.tid; i < 224 * 1024 / 8; i += F.G * NTHREADS) *((u32x4*)(F.WMAIN + (size_t)2080 * DM) + i) = (u32x4){0u, 0u, 0u, 0u};
}

struct RopeCS { f32x4 c0, c1, s0, s1; };
__device__ __forceinline__ void rope_cs_issue(const float* rope, int dc, int posr, int posc, RopeCS& R) {
    const int pos = (dc >> 2) ? posc : posr, i0 = 8 * (dc & 1);
    R.c0 = *(const f32x4*)(rope + pos * 16 + i0); R.c1 = *(const f32x4*)(rope + pos * 16 + i0 + 4); R.s0 = *(const f32x4*)(rope + 2048 + pos * 16 + i0); R.s1 = *(const f32x4*)(rope + 2048 + pos * 16 + i0 + 4);
}
__device__ __forceinline__ int rope_partner(int dc) { return ((dc & 3) < 2) ? dc + 2 : dc - 2; }
__device__ __forceinline__ void rope_apply(const u32x4 mine, const u32x4 part, const RopeCS& R, int dc, bool do_rope, float (&o)[8]) {
    float a[8]; unpack8(mine, a);
    if (!do_rope) {
#pragma unroll
        for (int j = 0; j < 8; ++j) o[j] = a[j];
        return; }
    float p[8]; unpack8(part, p);
    const float sg = ((dc & 3) < 2) ? -1.0f : 1.0f;
    const float cs[8] = {R.c0[0], R.c0[1], R.c0[2], R.c0[3], R.c1[0], R.c1[1], R.c1[2], R.c1[3]}, sn[8] = {R.s0[0], R.s0[1], R.s0[2], R.s0[3], R.s1[0], R.s1[1], R.s1[2], R.s1[3]};
#pragma unroll
    for (int j = 0; j < 8; ++j) o[j] = __builtin_fmaf(p[j], sn[j] * sg, a[j] * cs[j]);
}
__device__ __forceinline__ void stage_gate_weights(const Frame& F, u32x4* WB, float* BAS) {
    const u32x4* WBG = gate_wb_global(F);
#pragma unroll
    for (int k = 0; k < 2048 / NTHREADS; ++k) WB[F.tid + k * NTHREADS] = WBG[F.tid + k * NTHREADS];
    BAS[F.tid] = gate_bias_global(F)[F.tid];
}

__device__ __forceinline__ void gate_mfma4(const bf16x8 (&a)[2][2], const bf16x8 wb, f32x4 (&z)[2][2]) {
#pragma unroll
    for (int h2 = 0; h2 < 2; ++h2)
#pragma unroll
        for (int t = 0; t < 2; ++t) z[h2][t] = __builtin_amdgcn_mfma_f32_16x16x32_bf16(a[h2][t], wb, (f32x4){0.f, 0.f, 0.f, 0.f}, 0, 0, 0);
}
__device__ __forceinline__ void gate_cum16(const f32x4 (&z)[2][2], float ba, int dir, int lane, float (&r)[2][8], float& bend) {
    const int fq = lane >> 4;
#pragma unroll
    for (int h2 = 0; h2 < 2; ++h2)
#pragma unroll
        for (int t = 0; t < 2; ++t)
#pragma unroll
            for (int q = 0; q < 4; ++q) r[h2][4 * t + q] = logsig16(z[h2][t][q] + ba);
    if (dir == 0) {
#pragma unroll
        for (int h2 = 0; h2 < 2; ++h2)
#pragma unroll
            for (int i = 1; i < 8; ++i) r[h2][i] += r[h2][i - 1];
    } else {
#pragma unroll
        for (int h2 = 0; h2 < 2; ++h2)
#pragma unroll
            for (int i = 6; i >= 0; --i) r[h2][i] += r[h2][i + 1];
    }
    const float T0 = dir ? r[0][0] : r[0][7], T1 = dir ? r[1][0] : r[1][7];
    const float a0 = __shfl_xor(T0, 16), a1 = __shfl_xor(T1, 16);
    const float p0 = T0 + a0, p1 = T1 + a1;
    const float q0 = __shfl_xor(p0, 32), q1 = __shfl_xor(p1, 32);
    const float s0 = p0 + q0, s1 = p1 + q1;
    const bool lo1 = (fq & 1) != 0, lo2 = (fq & 2) != 0;
    float o0 = dir ? ((lo1 ? 0.f : a0) + (lo2 ? 0.f : q0)) : ((lo1 ? a0 : 0.f) + (lo2 ? q0 : 0.f));
    float o1 = dir ? ((lo1 ? 0.f : a1) + (lo2 ? 0.f : q1)) : ((lo1 ? a1 : 0.f) + (lo2 ? q1 : 0.f));
    if (dir == 0) o1 += s0; else o0 += s1;
    bend = s0 + s1;
#pragma unroll
    for (int i = 0; i < 8; ++i) { r[0][i] += o0; r[1][i] += o1; }
}

__device__ __forceinline__ void ph3_gla_kv(const Frame& F) {
    float* KF = (float*)F.lds;
    bf16* KETF = (bf16*)(KF + 64 * 68);
    bf16* KETB = KETF + 64 * 72;
    u32x4* WB = (u32x4*)(KETB + 64 * 72);
    float* BAS = (float*)(WB + 2048);
    float* RT = BAS + 512;
    const int tid = F.tid, lane = F.lane, w = F.wave;
    const int c = tid >> 3, dc = tid & 7, pdc = rope_partner(dc), fr = lane & 15, fq = lane >> 4;
    auto geom = [&](int it, int& h, int& ch, int& tok0, bool& isctx, size_t& itf, size_t& itb) {
        const int n = it % NCH, bh = it / NCH; h = bh & 3; const int b = bh >> 2;
        isctx = n < 4; ch = isctx ? n : n - 4;
        tok0 = isctx ? MLAT + b * CTXL + 64 * ch : b * SEQ + 64 * ch;
        const int nb = isctx ? 3 - n : 4 + (127 - ch);
        itf = (size_t)(bh * 2) * NCH + n; itb = (size_t)(bh * 2 + 1) * NCH + nb;
    };
    const int gdir = w >> 2, gdt = w & 3, gd = 16 * gdt + fr, gkap = 8 * (fr >> 2) + (fr & 3);
    u32x4 pkm, pkp; bf16x8 pbv[2], pga[2][2];
    const unsigned okm = (unsigned)(p1_off(c, CGK + 8 * dc) * 2), okp = (unsigned)(p1_off(c, CGK + 8 * pdc) * 2), oga = (unsigned)(p1_off(gkap, CAF + 16 * gdir + 8 * (fq & 1)) * 2);
    const unsigned ovt = (unsigned)((w * 512 + fq * 128 + fr * 8) * 2), okv = (unsigned)(((16 * w + fr) * 64 + 8 * fq) * 2);
    const char* P1c = (const char*)F.P1; const char* VTc = (const char*)F.VT; char* KVc = (char*)F.KV;
    auto issue_a = [&](int it) { int h, ch, tok0; bool isctx; size_t itf, itb; geom(it, h, ch, tok0, isctx, itf, itb);
        const char* bk = P1c + ((size_t)tok0 * 256 + h * 64) * 2;
        pkm = *(const u32x4*)(bk + okm); pkp = *(const u32x4*)(bk + okp);
        const char* ba = P1c + (size_t)tok0 * 512;
#pragma unroll
        for (int h2 = 0; h2 < 2; ++h2)
#pragma unroll
            for (int t = 0; t < 2; ++t) pga[h2][t] = *(const bf16x8*)(ba + (h2 * 32 + t * 4) * 512 + oga);
        };
    auto issue_c = [&](int it) { int h, ch, tok0; bool isctx; size_t itf, itb; geom(it, h, ch, tok0, isctx, itf, itb);
        const char* bv = VTc + ((size_t)((tok0 >> 5) * 64 + 32 + 8 * h) * 512) * 2;
        pbv[0] = *(const bf16x8*)(bv + ovt); pbv[1] = *(const bf16x8*)(bv + 64 * 512 * 2 + ovt); };
    const int NIT = 32 * NCH;
    if ((int)blockIdx.x < NIT) { issue_a(blockIdx.x); issue_c(blockIdx.x); }
    stage_gate_weights(F, WB, BAS);
#pragma unroll
    for (int k = 0; k < 2; ++k) ((f32x4*)RT)[tid + k * NTHREADS] = ((const f32x4*)F.ROPE)[tid + k * NTHREADS];
    __syncthreads();
    for (int it = blockIdx.x; it < NIT; it += F.G) {
        int h, ch, tok0; bool isctx; size_t itf, itb; geom(it, h, ch, tok0, isctx, itf, itb);
        const int itn = (it + F.G < NIT) ? it + F.G : it;
        float gr_[2][8], bend;
        {
            float k8[8];
            RopeCS pcs; rope_cs_issue(RT, dc, ch, c, pcs);
            rope_apply(pkm, pkp, pcs, dc, !isctx, k8);
            *(f32x4*)(KF + c * 68 + 8 * dc) = (f32x4){k8[0], k8[1], k8[2], k8[3]}; *(f32x4*)(KF + c * 68 + 8 * dc + 4) = (f32x4){k8[4], k8[5], k8[6], k8[7]};
            const bf16x8 wb = __builtin_bit_cast(bf16x8, WB[((gdir * 4 + h) * 4 + gdt) * 64 + lane]); const float ba = BAS[(gdir * 4 + h) * 64 + gd];
            f32x4 gz[2][2]; gate_mfma4(pga, wb, gz);
            issue_a(itn);
            gate_cum16(gz, ba, gdir, lane, gr_, bend);
        }
        __syncthreads();
        {
            bf16* KET = gdir ? KETB : KETF;
#pragma unroll
            for (int h2 = 0; h2 < 2; ++h2) { float ke[8];
#pragma unroll
                for (int i = 0; i < 8; ++i) ke[i] = KF[(32 * h2 + 8 * fq + i) * 68 + gd] * __builtin_amdgcn_exp2f(bend - gr_[h2][i]);
                u32x4 o; o.x = pk2(ke[0], ke[1]); o.y = pk2(ke[2], ke[3]); o.z = pk2(ke[4], ke[5]); o.w = pk2(ke[6], ke[7]);
                *(u32x4*)(KET + gd * 72 + 32 * h2 + 8 * fq) = o; }
            if (fq == 0) F.DEC[(gdir ? itb : itf) * 64 + gd] = __builtin_amdgcn_exp2f(bend);
        }
        __syncthreads();
        {
            const bf16x8 bv0 = pbv[0], bv1 = pbv[1];
            bf16* dstf = (bf16*)(KVc + itf * (128 * 64 * 2) + okv); bf16* dstb = (bf16*)(KVc + itb * (128 * 64 * 2) + okv);
            const int kapr = 8 * (fr >> 2) + (fr & 3);
#pragma unroll
            for (int p = 0; p < 2; ++p) { f32x4 af_[2], ab_[2];
#pragma unroll
                for (int t = 0; t < 2; ++t) { const int row = 32 * p + kapr + 4 * t; f32x4 accf = (f32x4){0.f, 0.f, 0.f, 0.f}, accb = accf;
                    const bf16x8 af0 = *(const bf16x8*)(KETF + row * 72 + 8 * fq), af1 = *(const bf16x8*)(KETF + row * 72 + 32 + 8 * fq);
                    const bf16x8 ab0 = *(const bf16x8*)(KETB + row * 72 + 8 * fq), ab1 = *(const bf16x8*)(KETB + row * 72 + 32 + 8 * fq);
                    accf = __builtin_amdgcn_mfma_f32_16x16x32_bf16(af0, bv0, accf, 0, 0, 0); accb = __builtin_amdgcn_mfma_f32_16x16x32_bf16(ab0, bv0, accb, 0, 0, 0);
                    accf = __builtin_amdgcn_mfma_f32_16x16x32_bf16(af1, bv1, accf, 0, 0, 0); accb = __builtin_amdgcn_mfma_f32_16x16x32_bf16(ab1, bv1, accb, 0, 0, 0);
                    af_[t] = accf; ab_[t] = accb; }
                u32x4 o; o.x = pk2(af_[0][0], af_[0][1]); o.y = pk2(af_[0][2], af_[0][3]); o.z = pk2(af_[1][0], af_[1][1]); o.w = pk2(af_[1][2], af_[1][3]); *(u32x4*)(dstf + 32 * p) = o;
                o.x = pk2(ab_[0][0], ab_[0][1]); o.y = pk2(ab_[0][2], ab_[0][3]); o.z = pk2(ab_[1][0], ab_[1][1]); o.w = pk2(ab_[1][2], ab_[1][3]); *(u32x4*)(dstb + 32 * p) = o; }
            issue_c(itn);
        }
    }
    __syncthreads();
}

__device__ __forceinline__ void ph4_gla_scan(const Frame& F) {
    constexpr int UB = 22, NBAT = NCH / UB;
    static_assert(NBAT * UB == NCH && (NBAT & 1) == 0, "scan batching");
    float* DECs = (float*)F.lds;
    for (int idx = blockIdx.x * NTHREADS + F.tid; idx < 64 * 2048; idx += F.G * NTHREADS) {
        const int seq = idx >> 11, within = idx & 2047, e = within >> 4, d = 4 * (within & 15);
        bf16* p = F.KV + ((size_t)seq * NCH * 128 + e) * 64 + d;
        __syncthreads();
        { const f32x4* src = (const f32x4*)(F.DEC + (size_t)seq * NCH * 64); for (int i = F.tid; i < NCH * 16; i += NTHREADS) ((f32x4*)DECs)[i] = src[i]; }
        u32x2 kvA[UB], kvB[UB];
#pragma unroll
        for (int u = 0; u < UB; ++u) kvA[u] = *(const u32x2*)(p + (size_t)u * 128 * 64);
        __syncthreads();
        float s0 = 0.f, s1 = 0.f, s2 = 0.f, s3 = 0.f;
        auto run = [&](int n0, const u32x2 (&kv)[UB]) {
#pragma unroll
            for (int u = 0; u < UB; ++u) { const f32x4 dc = *(const f32x4*)(DECs + (n0 + u) * 64 + d);
                u32x2 o; o.x = pk2(s0, s1); o.y = pk2(s2, s3); *(u32x2*)(p + (size_t)(n0 + u) * 128 * 64) = o;
                s0 = dc[0] * s0 + bflo(kv[u].x); s1 = dc[1] * s1 + bfhi(kv[u].x); s2 = dc[2] * s2 + bflo(kv[u].y); s3 = dc[3] * s3 + bfhi(kv[u].y); } };
        for (int n0 = 0; n0 < NCH; n0 += 2 * UB) {
#pragma unroll
            for (int u = 0; u < UB; ++u) kvB[u] = *(const u32x2*)(p + (size_t)(n0 + UB + u) * 128 * 64);
            run(n0, kvA);
            if (n0 + 2 * UB < NCH) {
#pragma unroll
                for (int u = 0; u < UB; ++u) kvA[u] = *(const u32x2*)(p + (size_t)(n0 + 2 * UB + u) * 128 * 64); }
            run(n0 + UB, kvB);
        }
    }
    __syncthreads();
}

__device__ __forceinline__ void ph5_gla_out(const Frame& F) {
    float* BCF = (float*)F.lds;
    float* BCB = BCF + 64 * 68;
    float* SS = BCB + 64 * 68;
    bf16* QDF = (bf16*)(SS + 512);
    bf16* KIF = QDF + 64 * 72;
    bf16* QDB = KIF + 64 * 72;
    bf16* KIB = QDB + 64 * 72;
    bf16* AT = KIB + 64 * 72;
    u32x4* WB = (u32x4*)(AT + 64 * 72);
    float* BAS = (float*)(WB + 2048);
    float* GN = BAS + 512;
    float* RT = GN + 512;
    const int tid = F.tid, lane = F.lane, w = F.wave, fr = lane & 15, fq = lane >> 4;
    const int c = tid >> 3, dc = tid & 7, pdc = rope_partner(dc);
    const int gdir = w >> 2, gdt = w & 3, gd = 16 * gdt + fr, gkap = 8 * (fr >> 2) + (fr & 3);
    u32x4 pqm, pqp, pkm, pkp; u32x2 pgr[4]; bf16x8 pav[2], pasf[2], pasb[2], pga[2][2];
    const unsigned oqm = (unsigned)(p1_off(c, CGQ + 8 * dc) * 2), oqp = (unsigned)(p1_off(c, CGQ + 8 * pdc) * 2), okm = (unsigned)(p1_off(c, CGK + 8 * dc) * 2), okp = (unsigned)(p1_off(c, CGK + 8 * pdc) * 2);
    const unsigned oga = (unsigned)(p1_off(gkap, CAF + 16 * gdir + 8 * (fq & 1)) * 2), ogr = (unsigned)(p1_off(fr, CGR + 16 * w + 4 * fq) * 2);
    const unsigned ovt = (unsigned)((w * 512 + fq * 128 + fr * 8) * 2), okv = (unsigned)(((16 * w + fr) * 64 + 8 * fq) * 2);
    const char* P1c = (const char*)F.P1; const char* VTc = (const char*)F.VT; const char* KVc = (const char*)F.KV;
    auto issue_a = [&](int it) { const int j = it & 127, h = (it >> 7) & 3, b = it >> 9; const int tok0 = b * SEQ + 64 * j;
        const char* bq = P1c + ((size_t)tok0 * 256 + h * 64) * 2;
        pqm = *(const u32x4*)(bq + oqm); pqp = *(const u32x4*)(bq + oqp); pkm = *(const u32x4*)(bq + okm); pkp = *(const u32x4*)(bq + okp);
        const char* ba = P1c + (size_t)tok0 * 512;
#pragma unroll
        for (int h2 = 0; h2 < 2; ++h2)
#pragma unroll
            for (int t = 0; t < 2; ++t) pga[h2][t] = *(const bf16x8*)(ba + (h2 * 32 + t * 4) * 512 + oga);
        const char* bg = P1c + (((size_t)(h >> 1) * MTOT + tok0) * 256 + 128 * (h & 1)) * 2;
#pragma unroll
        for (int ct = 0; ct < 4; ++ct) pgr[ct] = *(const u32x2*)(bg + ct * 16 * 512 + ogr); };
    auto issue_e = [&](int it) { const int j = it & 127, h = (it >> 7) & 3, b = it >> 9; const int tok0 = b * SEQ + 64 * j;
        const int seqf = (b * 4 + h) * 2, seqb = seqf + 1;
        const char* bv = VTc + ((size_t)((tok0 >> 5) * 64 + 32 + 8 * h) * 512) * 2;
        const char* bsf = KVc + ((size_t)(seqf * NCH + 4 + j) * 128 * 64) * 2; const char* bsb = KVc + ((size_t)(seqb * NCH + 4 + (127 - j)) * 128 * 64) * 2;
        pav[0] = *(const bf16x8*)(bv + ovt); pav[1] = *(const bf16x8*)(bv + 64 * 512 * 2 + ovt);
        pasf[0] = *(const bf16x8*)(bsf + okv); pasf[1] = *(const bf16x8*)(bsf + 64 + okv); pasb[0] = *(const bf16x8*)(bsb + okv); pasb[1] = *(const bf16x8*)(bsb + 64 + okv); };
    const int NIT = NB * 4 * 128;
    if ((int)blockIdx.x < NIT) { issue_a(blockIdx.x); issue_e(blockIdx.x); }
    stage_gate_weights(F, WB, BAS);
    GN[tid] = F.gla_norm[tid] * 0.6931471805599453f;
#pragma unroll
    for (int k = 0; k < 2; ++k) ((f32x4*)RT)[tid + k * NTHREADS] = ((const f32x4*)F.ROPE)[tid + k * NTHREADS];
    __syncthreads();
    for (int it = blockIdx.x; it < NIT; it += F.G) {
        const int j = it & 127, h = (it >> 7) & 3, b = it >> 9;
        const int tok0 = b * SEQ + 64 * j;
        const int itn = (it + F.G < NIT) ? it + F.G : it;
        float q8[8], k8[8]; u32x2 gr[4];
        {
            RopeCS pcs; rope_cs_issue(RT, dc, j, c, pcs);
            rope_apply(pqm, pqp, pcs, dc, true, q8);
            rope_apply(pkm, pkp, pcs, dc, true, k8);
#pragma unroll
            for (int ct = 0; ct < 4; ++ct) gr[ct] = pgr[ct];
            const bf16x8 wb = __builtin_bit_cast(bf16x8, WB[((gdir * 4 + h) * 4 + gdt) * 64 + lane]); const float ba = BAS[(gdir * 4 + h) * 64 + gd];
            f32x4 gz[2][2]; gate_mfma4(pga, wb, gz);
            issue_a(itn);
            float r[2][8], bend; gate_cum16(gz, ba, gdir, lane, r, bend);
            float* BC = gdir ? BCB : BCF;
#pragma unroll
            for (int h2 = 0; h2 < 2; ++h2)
#pragma unroll
                for (int i = 0; i < 8; ++i) BC[(32 * h2 + 8 * fq + i) * 68 + gd] = r[h2][i];
        }
        __syncthreads();
        {
            const f32x4 f0 = *(const f32x4*)(BCF + c * 68 + 8 * dc), f1 = *(const f32x4*)(BCF + c * 68 + 8 * dc + 4), b0 = *(const f32x4*)(BCB + c * 68 + 8 * dc), b1 = *(const f32x4*)(BCB + c * 68 + 8 * dc + 4);
            const float bf[8] = {f0[0], f0[1], f0[2], f0[3], f1[0], f1[1], f1[2], f1[3]}, bb[8] = {b0[0], b0[1], b0[2], b0[3], b1[0], b1[1], b1[2], b1[3]};
            float qf[8], kf[8], qb[8], kb[8];
#pragma unroll
            for (int i = 0; i < 8; ++i) { qf[i] = q8[i] * __builtin_amdgcn_exp2f(bf[i]) * 0.125f; kf[i] = k8[i] * __builtin_amdgcn_exp2f(-bf[i]); qb[i] = q8[i] * __builtin_amdgcn_exp2f(bb[i]) * 0.125f; kb[i] = k8[i] * __builtin_amdgcn_exp2f(-bb[i]); }
            u32x4 o;
            o.x = pk2(qf[0], qf[1]); o.y = pk2(qf[2], qf[3]); o.z = pk2(qf[4], qf[5]); o.w = pk2(qf[6], qf[7]); *(u32x4*)(QDF + c * 72 + 8 * dc) = o;
            o.x = pk2(kf[0], kf[1]); o.y = pk2(kf[2], kf[3]); o.z = pk2(kf[4], kf[5]); o.w = pk2(kf[6], kf[7]); *(u32x4*)(KIF + c * 72 + 8 * dc) = o;
            o.x = pk2(qb[0], qb[1]); o.y = pk2(qb[2], qb[3]); o.z = pk2(qb[4], qb[5]); o.w = pk2(qb[6], qb[7]); *(u32x4*)(QDB + c * 72 + 8 * dc) = o;
            o.x = pk2(kb[0], kb[1]); o.y = pk2(kb[2], kb[3]); o.z = pk2(kb[4], kb[5]); o.w = pk2(kb[6], kb[7]); *(u32x4*)(KIB + c * 72 + 8 * dc) = o;
        }
        __syncthreads();
        {
            const int ct = w & 3, sp = w >> 2;
            const bf16x8 bqf0 = *(const bf16x8*)(QDF + (16 * ct + fr) * 72 + 8 * fq), bqf1 = *(const bf16x8*)(QDF + (16 * ct + fr) * 72 + 32 + 8 * fq);
            const bf16x8 bqb0 = *(const bf16x8*)(QDB + (16 * ct + fr) * 72 + 8 * fq), bqb1 = *(const bf16x8*)(QDB + (16 * ct + fr) * 72 + 32 + 8 * fq);
            bf16x8 kf_[2][2], kb_[2][2];
#pragma unroll
            for (int t = 0; t < 2; ++t) { const int ro = (16 * (2 * sp + t) + fr) * 72 + 8 * fq;
                kf_[t][0] = *(const bf16x8*)(KIF + ro); kf_[t][1] = *(const bf16x8*)(KIF + ro + 32); kb_[t][0] = *(const bf16x8*)(KIB + ro); kb_[t][1] = *(const bf16x8*)(KIB + ro + 32); }
            f32x4 af[2], ab[2];
#pragma unroll
            for (int t = 0; t < 2; ++t) { const f32x4 z = (f32x4){0.f, 0.f, 0.f, 0.f};
                af[t] = __builtin_amdgcn_mfma_f32_16x16x32_bf16(kf_[t][0], bqf0, z, 0, 0, 0); ab[t] = __builtin_amdgcn_mfma_f32_16x16x32_bf16(kb_[t][0], bqb0, z, 0, 0, 0); }
#pragma unroll
            for (int t = 0; t < 2; ++t) { af[t] = __builtin_amdgcn_mfma_f32_16x16x32_bf16(kf_[t][1], bqf1, af[t], 0, 0, 0); ab[t] = __builtin_amdgcn_mfma_f32_16x16x32_bf16(kb_[t][1], bqb1, ab[t], 0, 0, 0); }
            u32x2 ow[2]; const int cc = 16 * ct + fr;
#pragma unroll
            for (int t = 0; t < 2; ++t) { const int s0 = 16 * (2 * sp + t) + 4 * fq; float tt[4];
#pragma unroll
                for (int r = 0; r < 4; ++r) { const int s = s0 + r; tt[r] = (s <= cc ? af[t][r] : 0.f) + (s >= cc ? ab[t][r] : 0.f); }
                ow[t].x = pk2(tt[0], tt[1]); ow[t].y = pk2(tt[2], tt[3]); }
#pragma unroll
            for (int t = 0; t < 2; ++t) *(u32x2*)(AT + cc * 72 + 16 * (2 * sp + t) + 4 * fq) = ow[t];
        }
        __syncthreads();
        f32x4 o4[4];
        {
            float pp[4];
#pragma unroll
            for (int cp = 0; cp < 2; ++cp) {
                bf16x8 ba[2][2], bf_[2][2], bb_[2][2];
#pragma unroll
                for (int u = 0; u < 2; ++u)
#pragma unroll
                    for (int ks = 0; ks < 2; ++ks) { const int ro = (16 * (2 * cp + u) + fr) * 72 + 32 * ks + 8 * fq;
                        ba[u][ks] = *(const bf16x8*)(AT + ro); bf_[u][ks] = *(const bf16x8*)(QDF + ro); bb_[u][ks] = *(const bf16x8*)(QDB + ro); }
#pragma unroll
                for (int u = 0; u < 2; ++u) { const f32x4 z = (f32x4){0.f, 0.f, 0.f, 0.f};
                    f32x4 c0 = __builtin_amdgcn_mfma_f32_16x16x32_bf16(pav[0], ba[u][0], z, 0, 0, 0), c1 = __builtin_amdgcn_mfma_f32_16x16x32_bf16(pasf[0], bf_[u][0], z, 0, 0, 0), c2 = __builtin_amdgcn_mfma_f32_16x16x32_bf16(pasb[0], bb_[u][0], z, 0, 0, 0);
                    c0 = __builtin_amdgcn_mfma_f32_16x16x32_bf16(pav[1], ba[u][1], c0, 0, 0, 0); c1 = __builtin_amdgcn_mfma_f32_16x16x32_bf16(pasf[1], bf_[u][1], c1, 0, 0, 0); c2 = __builtin_amdgcn_mfma_f32_16x16x32_bf16(pasb[1], bb_[u][1], c2, 0, 0, 0);
                    const f32x4 acc = (c0 + c1) + c2; o4[2 * cp + u] = acc;
                    pp[2 * cp + u] = (acc[0] * acc[0] + acc[1] * acc[1]) + (acc[2] * acc[2] + acc[3] * acc[3]); } }
            { const bool lo1 = (fq & 1) != 0, lo2 = (fq & 2) != 0;
              const float v0 = (lo1 ? pp[1] : pp[0]) + __shfl_xor(lo1 ? pp[0] : pp[1], 16);
              const float v1 = (lo1 ? pp[3] : pp[2]) + __shfl_xor(lo1 ? pp[2] : pp[3], 16);
              const float tv = (lo2 ? v1 : v0) + __shfl_xor(lo2 ? v0 : v1, 32);
              SS[(16 * fq + fr) * 8 + w] = tv; }
            issue_e(itn);
        }
        __syncthreads();
        {
            const f32x4 gn = *(const f32x4*)(GN + h * 128 + 16 * w + 4 * fq);
#pragma unroll
            for (int ct = 0; ct < 4; ++ct) { const int cc = 16 * ct + fr; float tot = 0.f;
#pragma unroll
                for (int w2 = 0; w2 < 2; ++w2) { const f32x4 t4 = *(const f32x4*)(SS + cc * 8 + 4 * w2); tot += (t4[0] + t4[1]) + (t4[2] + t4[3]); }
                const float rs = __builtin_amdgcn_rsqf(tot * (1.0f / 128.0f) + EPS);
                const float g[4] = {bflo(gr[ct].x), bfhi(gr[ct].x), bflo(gr[ct].y), bfhi(gr[ct].y)}; float y[4];
#pragma unroll
                for (int r = 0; r < 4; ++r) y[r] = o4[ct][r] * rs * gn[r] * (g[r] * __builtin_amdgcn_rcpf(1.0f + __builtin_amdgcn_exp2f(-g[r])));
                u32x2 o; o.x = pk2(y[0], y[1]); o.y = pk2(y[2], y[3]); *(u32x2*)(F.MIX + (size_t)(tok0 + cc) * DM + 512 + h * 128 + 16 * w + 4 * fq) = o; }
        }
    }
    __syncthreads();
}

__device__ __forceinline__ float vmax2(float a, float b) { return __builtin_amdgcn_fmed3f(a, b, __builtin_inff()); }
__device__ __forceinline__ float vmax8(const float (&v)[8]) { return vmax2(vmax2(vmax2(v[0], v[1]), vmax2(v[2], v[3])), vmax2(vmax2(v[4], v[5]), vmax2(v[6], v[7]))); }
__device__ __forceinline__ float vmax3(float a, float b, float c) { float r; asm("v_max3_f32 %0, %1, %2, %3" : "=v"(r) : "v"(a), "v"(b), "v"(c)); return r; }
__device__ __forceinline__ void ph5_na(const Frame& F) {
    constexpr int NT = 4;
    constexpr float LOG2E = 1.4426950408889634f, QS = 0.125f * LOG2E;
    bf16* CKs = (bf16*)F.lds;
    bf16* CVs = CKs + 256 * 72;
    float* RPB = (float*)(CVs + 64 * 264);
    bf16* QSw = (bf16*)(RPB + 468) + F.wave * (4 * 16 * 64);
    const int tid = F.tid, lane = F.lane, w = F.wave, qi = lane & 15, fq = lane >> 4;
    const int j = w & 3, sub = w >> 2;
    const int c = 16 * j + qi;
    const int kc0 = (j == 0) ? 0 : (j == 1) ? 8 : (j == 2) ? 24 : 32;
    const int cs = (c - 8 < 0) ? 0 : (c - 8 > 48 ? 48 : c - 8);
    const int kap = 8 * (qi >> 2) + (qi & 3);
    unsigned cmask = 0;
#pragma unroll
    for (int e = 0; e < 8; ++e) { const int kc = kc0 + 8 * fq + e; if (kc >= cs && kc < cs + 16) cmask |= 1u << e; }
    const int dc0 = kc0 + 8 * fq - c + 15;
    const float NEG_INF = -__builtin_inff();
    const int ipw = (1024 + F.G - 1) / F.G;
    int cur_bh = -1;
    for (int it = blockIdx.x * ipw; it < (blockIdx.x + 1) * ipw && it < 1024; ++it) {
        const int rg = it & 15, bh = it >> 4, head = bh & 7, b = bh >> 3;
        const int rA = 8 * rg + 4 * sub;
        bf16x8 qt[NT][2];
#pragma unroll
        for (int nt = 0; nt < NT; ++nt) { const bf16* qp = F.P1 + p1_off(b * SEQ + (rA + nt) * 64 + c, CQ + head * 64 + 8 * fq); qt[nt][0] = *(const bf16x8*)qp; qt[nt][1] = *(const bf16x8*)(qp + 32); }
        if (bh != cur_bh) {
            cur_bh = bh;
            __syncthreads();
            { const int row = tid >> 1, hf = tid & 1; const bf16* src = F.P1 + p1_off(MLAT + b * CTXL + row, CK + head * 64 + 32 * hf);
              u32x4 v0 = *(const u32x4*)src, v1 = *(const u32x4*)(src + 8), v2 = *(const u32x4*)(src + 16), v3 = *(const u32x4*)(src + 24);
              bf16* dst = CKs + row * 72 + 32 * hf; *(u32x4*)dst = v0; *(u32x4*)(dst + 8) = v1; *(u32x4*)(dst + 16) = v2; *(u32x4*)(dst + 24) = v3; }
            { const int row = tid >> 3, sg = tid & 7; const int t0 = MLAT + b * CTXL + 32 * sg;
              u32x4 v0 = *(const u32x4*)(F.VT + vt_off(head * 64 + row, t0)), v1 = *(const u32x4*)(F.VT + vt_off(head * 64 + row, t0 + 8)), v2 = *(const u32x4*)(F.VT + vt_off(head * 64 + row, t0 + 16)), v3 = *(const u32x4*)(F.VT + vt_off(head * 64 + row, t0 + 24));
              bf16* dst = CVs + row * 264 + 32 * sg; *(u32x4*)dst = v0; *(u32x4*)(dst + 8) = v1; *(u32x4*)(dst + 16) = v2; *(u32x4*)(dst + 24) = v3; }
            if (tid < 465) RPB[tid] = F.rpb[head * 465 + tid] * LOG2E;
            __syncthreads();
        }
        {
#pragma unroll
            for (int nt = 0; nt < NT; ++nt)
#pragma unroll
                for (int ks = 0; ks < 2; ++ks) { float qf[8]; unpack8(__builtin_bit_cast(u32x4, qt[nt][ks]), qf);
                    u32x4 qw; qw.x = pk2(qf[0] * QS, qf[1] * QS); qw.y = pk2(qf[2] * QS, qf[3] * QS); qw.z = pk2(qf[4] * QS, qf[5] * QS); qw.w = pk2(qf[6] * QS, qf[7] * QS);
                    *(u32x4*)(QSw + (nt * 16 + qi) * 64 + 8 * ((4 * ks + fq) ^ (qi & 7))) = qw; }
        }
        float l[NT]; f32x4 NM[NT], O[4][NT];
#pragma unroll
        for (int nt = 0; nt < NT; ++nt) { NM[nt] = (f32x4){0.f, 0.f, 0.f, 0.f}; l[nt] = 0.f;
#pragma unroll
            for (int dt = 0; dt < 4; ++dt) O[dt][nt] = (f32x4){0.f, 0.f, 0.f, 0.f}; }
        auto na_loadq = [&](int nt, bf16x8 (&q)[2]) { q[0] = *(const bf16x8*)(QSw + (nt * 16 + qi) * 64 + 8 * (fq ^ (qi & 7))); q[1] = *(const bf16x8*)(QSw + (nt * 16 + qi) * 64 + 8 * ((4 + fq) ^ (qi & 7))); };
        auto na_tile = [&](int nt, bool local, bool first, int kr, const bf16x8 (&kf)[2][2], const bf16x8 (&vf)[4], const bf16x8 (&qq)[2]) {
            const int r = rA + nt;
            const bf16x8 q0 = qq[0], q1 = qq[1];
            f32x4 s0 = __builtin_amdgcn_mfma_f32_16x16x32_bf16(kf[0][0], q0, NM[nt], 0, 0, 0); s0 = __builtin_amdgcn_mfma_f32_16x16x32_bf16(kf[0][1], q1, s0, 0, 0, 0);
            f32x4 s1 = __builtin_amdgcn_mfma_f32_16x16x32_bf16(kf[1][0], q0, NM[nt], 0, 0, 0); s1 = __builtin_amdgcn_mfma_f32_16x16x32_bf16(kf[1][1], q1, s1, 0, 0, 0);
            float sc[8];
            if (local) { const float* rp = RPB + (kr - r + 7) * 31 + dc0; float bias[8];
#pragma unroll
                for (int e = 0; e < 8; ++e) bias[e] = rp[e];
#pragma unroll
                for (int e = 0; e < 8; ++e) { const float a = (e < 4) ? s0[e & 3] : s1[e & 3]; sc[e] = ((cmask >> e) & 1u) ? a + bias[e] : NEG_INF; }
            } else {
#pragma unroll
                for (int e = 0; e < 8; ++e) sc[e] = (e < 4) ? s0[e & 3] : s1[e & 3];
            }
            float p[8], ps;
            if (local) {
                const float lmax = vmax3(vmax3(sc[0], sc[1], sc[2]), vmax3(sc[3], sc[4], sc[5]), vmax3(sc[6], sc[7], sc[7]));
                if (!__all(lmax <= 11.0f)) {
                    float mx = fmaxf(lmax, __shfl_xor(lmax, 16)); mx = fmaxf(mx, __shfl_xor(mx, 32));
                    const float d = fmaxf(mx, 0.f);
                    NM[nt] = NM[nt] - d;
#pragma unroll
                    for (int e = 0; e < 8; ++e) sc[e] -= d;
                    const float alpha = __builtin_amdgcn_exp2f(-d); l[nt] *= alpha;
#pragma unroll
                    for (int dt = 0; dt < 4; ++dt) O[dt][nt] = O[dt][nt] * alpha; }
#pragma unroll
                for (int e = 0; e < 8; ++e) p[e] = __builtin_amdgcn_exp2f(sc[e]);
            } else {
#pragma unroll
                for (int e = 0; e < 8; ++e) p[e] = __builtin_amdgcn_exp2f(sc[e]);
                int im = 0;
#pragma unroll
                for (int e = 0; e < 8; ++e) { const int x = __builtin_bit_cast(int, p[e]); im = im > x ? im : x; }
                if (first || !__all(im <= 0x45000000)) {
                    const float lmax = vmax8(sc);
                    float mx = fmaxf(lmax, __shfl_xor(lmax, 16)); mx = fmaxf(mx, __shfl_xor(mx, 32));
                    const float d = first ? mx : fmaxf(mx, 0.f);
                    NM[nt] = NM[nt] - d;
#pragma unroll
                    for (int e = 0; e < 8; ++e) p[e] = __builtin_amdgcn_exp2f(sc[e] - d);
                    if (!first) { const float alpha = __builtin_amdgcn_exp2f(-d); l[nt] *= alpha;
#pragma unroll
                        for (int dt = 0; dt < 4; ++dt) O[dt][nt] = O[dt][nt] * alpha; } }
            }
            ps = p[0];
#pragma unroll
            for (int e = 1; e < 8; ++e) ps += p[e];
            l[nt] += ps;
            u32x4 pw; pw.x = pk2(p[0], p[1]); pw.y = pk2(p[2], p[3]); pw.z = pk2(p[4], p[5]); pw.w = pk2(p[6], p[7]);
            const bf16x8 pf = __builtin_bit_cast(bf16x8, pw);
#pragma unroll
            for (int dt = 0; dt < 4; ++dt) O[dt][nt] = __builtin_amdgcn_mfma_f32_16x16x32_bf16(vf[dt], pf, O[dt][nt], 0, 0, 0);
            __builtin_amdgcn_sched_barrier(0);
        };
        const int rsA = (rA - 4 < 0) ? 0 : (rA - 4 > 120 ? 120 : rA - 4);
        const int rlast = rA + NT - 1; const int rsB = (rlast - 4 < 0) ? 0 : (rlast - 4 > 120 ? 120 : rlast - 4);
        const int nloc = rsB + 8 - rsA, slast = nloc - 1;
        auto na_loadk = [&](int s, bf16x8 (&kf)[2][2]) {
            const int base_tok = b * SEQ + (rsA + s) * 64 + kc0;
#pragma unroll
            for (int t = 0; t < 2; ++t) { const bf16* kp = F.P1 + p1_off(base_tok + kap + 4 * t, CK + head * 64 + 8 * fq); kf[t][0] = *(const bf16x8*)kp; kf[t][1] = *(const bf16x8*)(kp + 32); }
        };
        auto na_loadv = [&](int s, bf16x8 (&vf)[4]) {
            const int base_tok = b * SEQ + (rsA + s) * 64 + kc0;
#pragma unroll
            for (int dt = 0; dt < 4; ++dt) vf[dt] = *(const bf16x8*)(F.VT + vt_off(head * 64 + dt * 16 + qi, base_tok + 8 * fq));
        };
        bf16x8 kfA[2][2], kfB[2][2], vfA[4], vfB[4];
        na_loadk(0, kfA); na_loadv(0, vfA);
        bf16x8 qA[2], qB[2];
        na_loadq(0, qA); na_loadq(1, qB);
#pragma unroll 1
        for (int s = 0; s < 8; ++s) {
            bf16x8 kf[2][2], vf[4];
#pragma unroll
            for (int t = 0; t < 2; ++t) { const bf16* kp = CKs + (32 * s + kap + 4 * t) * 72 + 8 * fq; kf[t][0] = *(const bf16x8*)kp; kf[t][1] = *(const bf16x8*)(kp + 32); }
#pragma unroll
            for (int dt = 0; dt < 4; ++dt) vf[dt] = *(const bf16x8*)(CVs + (dt * 16 + qi) * 264 + 32 * s + 8 * fq);
            na_tile(0, false, s == 0, 0, kf, vf, qA); na_loadq(2, qA);
            na_tile(1, false, s == 0, 0, kf, vf, qB); na_loadq(3, qB);
            na_tile(2, false, s == 0, 0, kf, vf, qA); na_loadq(0, qA);
            na_tile(3, false, s == 0, 0, kf, vf, qB); na_loadq(1, qB);
        }
        auto na_step = [&](int s, const bf16x8 (&kf)[2][2], const bf16x8 (&vf)[4]) {
            const int kr = rsA + s;
            bool fresh = true;
#pragma unroll
            for (int nt = 0; nt < NT; ++nt) {
                const int r = rA + nt; const int rs = (r - 4 < 0) ? 0 : (r - 4 > 120 ? 120 : r - 4);
                if (kr < rs || kr >= rs + 8) continue;
                if (fresh) { fresh = false; if (nt & 1) na_loadq(nt, qB); else na_loadq(nt, qA); }
                if (nt + 1 < NT) { if (nt & 1) na_loadq(nt + 1, qA); else na_loadq(nt + 1, qB); }
                if (nt & 1) na_tile(nt, true, false, kr, kf, vf, qB); else na_tile(nt, true, false, kr, kf, vf, qA);
            }
        };
        for (int s = 0; s < slast; s += 2) {
            na_loadk(s + 1, kfB); na_loadv(s + 1, vfB);
            na_step(s, kfA, vfA);
            { const int s2 = (s + 2 < slast) ? s + 2 : slast; na_loadk(s2, kfA); na_loadv(s2, vfA); }
            na_step(s + 1, kfB, vfB);
        }
        if (nloc & 1) na_step(slast, kfA, vfA);
#pragma unroll
        for (int nt = 0; nt < NT; ++nt) { float lt = l[nt]; lt += __shfl_xor(lt, 16); lt += __shfl_xor(lt, 32); const float inv = __builtin_amdgcn_rcpf(lt);
            bf16* op = F.MIX + (size_t)(b * SEQ + (rA + nt) * 64 + c) * DM + head * 64 + 4 * fq;
#pragma unroll
            for (int dt = 0; dt < 4; ++dt) { const f32x4 o = O[dt][nt] * inv; u32x2 ow; ow.x = pk2(o[0], o[1]); ow.y = pk2(o[2], o[3]); *(u32x2*)(op + 16 * dt) = ow; } }
    }
    __syncthreads();
}

__device__ __forceinline__ void ph7_mid(const Frame& F) {
    const int gw = blockIdx.x * 8 + F.wave, NGW = F.G * 8;
    float* C1 = (float*)F.lds; float* CA = C1 + 8 * DM; float* CB = CA + 8 * DM;
    { f32x4 m2[4], m3[4], m4[4], gp[4], gf[4];
#pragma unroll
      for (int k = 0; k < 4; ++k) { const int i4 = F.tid + k * NTHREADS, bb = i4 >> 8, col = 4 * (i4 & 255); const float* mb = F.MOD + bb * NMOD;
          m2[k] = *(const f32x4*)(mb + 2 * DM + col); m3[k] = *(const f32x4*)(mb + 3 * DM + col); m4[k] = *(const f32x4*)(mb + 4 * DM + col); gp[k] = *(const f32x4*)(F.g_post_mix + col); gf[k] = *(const f32x4*)(F.g_pre_ffn + col); }
#pragma unroll
      for (int k = 0; k < 4; ++k) { const int i = 4 * (F.tid + k * NTHREADS); *(f32x4*)(C1 + i) = m2[k] * gp[k]; *(f32x4*)(CA + i) = gf[k] * (m4[k] + 1.0f); *(f32x4*)(CB + i) = m3[k]; } }
    __syncthreads();
    int curb = -1; f32x4 c1[4], cA[4], cB[4];
#pragma unroll
    for (int j = 0; j < 4; ++j) { c1[j] = (f32x4){0.f, 0.f, 0.f, 0.f}; cA[j] = c1[j]; cB[j] = c1[j]; }
    for (int row0 = gw; row0 < MLAT; row0 += 2 * NGW) {
        const int nr = (row0 + NGW < MLAT) ? 2 : 1;
        f32x4 v[2][4]; u32x2 yw[2][4];
#pragma unroll
        for (int q = 0; q < 2; ++q) { const int row = (q < nr) ? row0 + q * NGW : row0;
#pragma unroll
            for (int j = 0; j < 4; ++j) { v[q][j] = __builtin_nontemporal_load((const f32x4*)(F.x + (size_t)row * DM) + F.lane + 64 * j); yw[q][j] = *((const u32x2*)(F.Y + (size_t)row * DM) + F.lane + 64 * j); } }
#pragma unroll
        for (int q = 0; q < 2; ++q) { if (q < nr) { const int row = row0 + q * NGW; const int b = row >> 13;
            float sy = 0.f;
#pragma unroll
            for (int j = 0; j < 4; ++j) { const float y0 = bflo(yw[q][j].x), y1 = bfhi(yw[q][j].x), y2 = bflo(yw[q][j].y), y3 = bfhi(yw[q][j].y); sy += (y0 * y0 + y1 * y1) + (y2 * y2 + y3 * y3); }
            const float sq1 = wave_sum(sy);
            if (b != curb) { curb = b;
#pragma unroll
                for (int j = 0; j < 4; ++j) { const int o = b * DM + 4 * (F.lane + 64 * j); c1[j] = *(const f32x4*)(C1 + o); cA[j] = *(const f32x4*)(CA + o); cB[j] = *(const f32x4*)(CB + o); } }
            const float rstd1 = __builtin_amdgcn_rsqf(sq1 * (1.0f / DM) + EPS);
            float ss = 0.f;
#pragma unroll
            for (int j = 0; j < 4; ++j) { const f32x4 y = (f32x4){bflo(yw[q][j].x), bfhi(yw[q][j].x), bflo(yw[q][j].y), bfhi(yw[q][j].y)}; v[q][j] = v[q][j] + c1[j] * (y * rstd1);
                ss += (v[q][j][0] * v[q][j][0] + v[q][j][1] * v[q][j][1]) + (v[q][j][2] * v[q][j][2] + v[q][j][3] * v[q][j][3]);
                u32x2 xw; xw.x = pk2(v[q][j][0], v[q][j][1]); xw.y = pk2(v[q][j][2], v[q][j][3]); *(u32x2*)(F.X1B + (size_t)row * DM + 4 * (F.lane + 64 * j)) = xw; }
            const float rstd2 = __builtin_amdgcn_rsqf(wave_sum(ss) * (1.0f / DM) + EPS);
#pragma unroll
            for (int j = 0; j < 4; ++j) { const f32x4 o = v[q][j] * rstd2 * cA[j] + cB[j]; u32x2 wv; wv.x = pk2(o[0], o[1]); wv.y = pk2(o[2], o[3]); *(u32x2*)(F.H + (size_t)row * DM + 4 * (F.lane + 64 * j)) = wv; } } }
    }
}
__device__ __forceinline__ void ph10_final(const Frame& F) {
    const int gw = blockIdx.x * 8 + F.wave, NGW = F.G * 8;
    float* C2 = (float*)F.lds;
    { f32x4 m5[4], gp[4];
#pragma unroll
      for (int k = 0; k < 4; ++k) { const int i4 = F.tid + k * NTHREADS, bb = i4 >> 8, col = 4 * (i4 & 255); m5[k] = *(const f32x4*)(F.MOD + bb * NMOD + 5 * DM + col); gp[k] = *(const f32x4*)(F.g_post_ffn + col); }
#pragma unroll
      for (int k = 0; k < 4; ++k) *(f32x4*)(C2 + 4 * (F.tid + k * NTHREADS)) = m5[k] * gp[k]; }
    __syncthreads();
    int curb = -1; f32x4 c2[4];
#pragma unroll
    for (int j = 0; j < 4; ++j) c2[j] = (f32x4){0.f, 0.f, 0.f, 0.f};
    for (int row0 = gw; row0 < MLAT; row0 += 2 * NGW) {
        const int nr = (row0 + NGW < MLAT) ? 2 : 1;
        u32x2 xw[2][4], dw[2][4];
#pragma unroll
        for (int q = 0; q < 2; ++q) { const int row = (q < nr) ? row0 + q * NGW : row0;
#pragma unroll
            for (int j = 0; j < 4; ++j) { xw[q][j] = __builtin_nontemporal_load((const u32x2*)(F.X1B + (size_t)row * DM) + F.lane + 64 * j); dw[q][j] = *((const u32x2*)(F.DOWN + (size_t)row * DM) + F.lane + 64 * j); } }
#pragma unroll
        for (int q = 0; q < 2; ++q) { if (q < nr) { const int row = row0 + q * NGW; const int b = row >> 13;
            float sd = 0.f;
#pragma unroll
            for (int j = 0; j < 4; ++j) { const float d0 = bflo(dw[q][j].x), d1 = bfhi(dw[q][j].x), d2 = bflo(dw[q][j].y), d3 = bfhi(dw[q][j].y); sd += (d0 * d0 + d1 * d1) + (d2 * d2 + d3 * d3); }
            const float sq2 = wave_sum(sd);
            if (b != curb) { curb = b;
#pragma unroll
                for (int j = 0; j < 4; ++j) c2[j] = *(const f32x4*)(C2 + b * DM + 4 * (F.lane + 64 * j)); }
            const float rstd2 = __builtin_amdgcn_rsqf(sq2 * (1.0f / DM) + EPS);
#pragma unroll
            for (int j = 0; j < 4; ++j) { const f32x4 x1 = (f32x4){bflo(xw[q][j].x), bfhi(xw[q][j].x), bflo(xw[q][j].y), bfhi(xw[q][j].y)}, d = (f32x4){bflo(dw[q][j].x), bfhi(dw[q][j].x), bflo(dw[q][j].y), bfhi(dw[q][j].y)};
                const f32x4 o = x1 + c2[j] * (d * rstd2); __builtin_nontemporal_store(o, (f32x4*)(F.out + (size_t)row * DM) + F.lane + 64 * j); } } }
    }
}

struct Args { const float* in[20]; float* out; unsigned char* ws; int ph_lo, ph_hi; };
constexpr int NPHASES = 11;

__global__ void __launch_bounds__(NTHREADS, 2) mk_fwd(Args args) {
    extern __shared__ __attribute__((aligned(16))) unsigned char lds[];
    cg::grid_group grid = cg::this_grid();
    Frame F;
    F.lds = lds; F.tid = threadIdx.x; F.lane = F.tid & 63; F.wave = __builtin_amdgcn_readfirstlane(F.tid >> 6); F.G = gridDim.x;
    F.x = args.in[0]; F.c = args.in[1]; F.ctx = args.in[2]; F.c_ctx = args.in[3]; F.w_mod = args.in[4]; F.b_mod = args.in[5]; F.g_pre_mix = args.in[6]; F.g_post_mix = args.in[7];
    F.g_pre_ffn = args.in[8]; F.g_post_ffn = args.in[9]; F.w_in = args.in[10]; F.rpb = args.in[11]; F.wa2_f = args.in[12]; F.ba_f = args.in[13]; F.wa2_b = args.in[14]; F.ba_b = args.in[15];
    F.gla_norm = args.in[16]; F.w_out = args.in[17]; F.w_gu = args.in[18]; F.w_down = args.in[19]; F.out = args.out;
    unsigned char* ws = args.ws;
    F.MOD = (float*)(ws + WS_MOD); F.ROPE = (float*)(ws + WS_ROPE); F.DEC = (float*)(ws + WS_DEC); F.SSQ1 = (float*)(ws + WS_SSQ1); F.SSQ2 = (float*)(ws + WS_SSQ2);
    F.WMAIN = (bf16*)(ws + WS_WMAIN); F.WV = (bf16*)(ws + WS_WV); F.WOUT = (bf16*)(ws + WS_WOUT); F.WGU = (bf16*)(ws + WS_WGU); F.WDOWN = (bf16*)(ws + WS_WDOWN);
    F.H = (bf16*)(ws + WS_H); F.P1 = (bf16*)(ws + WS_P1); F.VT = (bf16*)(ws + WS_VT); F.KV = (bf16*)(ws + WS_KV); F.MIX = (bf16*)(ws + WS_MIX); F.Y = (bf16*)(ws + WS_Y); F.ACT = (bf16*)(ws + WS_ACT); F.DOWN = (bf16*)(ws + WS_DOWN); F.X1B = (bf16*)(ws + WS_X1B);
    PG8_LAS unsigned char* glds = (PG8_LAS unsigned char*)lds;
    const int lo = args.ph_lo, hi = args.ph_hi;
    volatile unsigned* MISC = (volatile unsigned*)(lds + LDS_BYTES - 128);
    if (F.tid < 32) MISC[F.tid] = 0u;
    __syncthreads();
    XcdBarrier xbar = xcd_barrier_post((unsigned*)(ws + WS_CTL) + 4096, MISC + 8);
#define IN(k) (lo <= (k) && (k) < hi)
#define REP(k) ((MK_REP_PHASE == (k)) ? 2 : 1)
#define SEAM(k) do { if (IN(k) && IN((k) + 1)) { if ((k) < MK_CG_SEAMS) grid.sync(); else xcd_barrier(xbar); } } while (0)

    if (IN(0)) for (int rep = 0; rep < REP(0); ++rep) ph0_mod(F);
    SEAM(0);
    if (IN(1)) for (int rep = 0; rep < REP(1); ++rep) ph1_rows(F);
    SEAM(1);
    if (IN(2)) for (int rep = 0; rep < REP(2); ++rep) {
        pg8::Gemm g1{F.H, F.WMAIN, MTOT, LDP, DM}, g2{F.WV, F.H, 1024, MTOT, DM};
        pg8::DualOrder S; S.o1.init(g1, F.G, (int)blockIdx.x); S.o2.init(g2, F.G, (int)blockIdx.x); S.G = F.G; S.c = (int)blockIdx.x;
        pg8::EpiDual E{pg8::EpiStore{F.P1, MTOT}, pg8::EpiStoreBlk{F.VT, 1024}};
        pg8::gemm_phase<pg8::EpiDual, pg8::DualOrder, true, true>(glds, g1, S, E);
        ph2_tail_weights(F, S.o1.nwg + S.o2.nwg);
    }
    SEAM(2);
    if (IN(3)) { for (int rep = 0; rep < REP(3); ++rep) ph3_gla_kv(F); for (int rep = 0; rep < REP(11); ++rep) ph5_na(F); }
    SEAM(3);
    if (IN(4)) ph4_gla_scan(F);
    if (MK_REP_PHASE == 4) { xcd_barrier(xbar); ph3_gla_kv(F); xcd_barrier(xbar); ph4_gla_scan(F); }
    SEAM(4);
    if (IN(5)) { for (int rep = 0; rep < REP(5); ++rep) ph5_gla_out(F); }
    SEAM(5);
    if (IN(6)) for (int rep = 0; rep < REP(6); ++rep) { pg8::Gemm g{F.MIX, F.WOUT, MLAT, DM, DM}; pg8::StaticOrder S; S.init(g, F.G, (int)blockIdx.x); pg8::EpiStoreRM E{F.Y, DM};
        pg8::gemm_phase<pg8::EpiStoreRM, pg8::StaticOrder, true, true>(glds, g, S, E); }
    SEAM(6);
    if (IN(7)) for (int rep = 0; rep < REP(7); ++rep) ph7_mid(F);
    SEAM(7);
    if (IN(8)) for (int rep = 0; rep < REP(8); ++rep) { pg8::Gemm g{F.H, F.WGU, MLAT, 2 * FFN, DM}; pg8::StaticOrder S; S.init(g, F.G, (int)blockIdx.x); pg8::EpiSwiglu E{F.ACT, FFN};
        pg8::gemm_phase<pg8::EpiSwiglu, pg8::StaticOrder, true, true>(glds, g, S, E); }
    SEAM(8);
    if (IN(9)) for (int rep = 0; rep < REP(9); ++rep) { pg8::Gemm g{F.ACT, F.WDOWN, MLAT, DM, FFN}; pg8::StaticOrder S; S.init(g, F.G, (int)blockIdx.x, 1); pg8::EpiStoreRM E{F.DOWN, DM};
        pg8::gemm_phase<pg8::EpiStoreRM, pg8::StaticOrder, true, true>(glds, g, S, E); }
    SEAM(9);
    if (IN(10)) for (int rep = 0; rep < REP(10); ++rep) ph10_final(F);
#undef IN
#undef SEAM
#undef REP
}

extern "C" void kernel_launch(void* const* d_in, const int* in_sizes, int n_in, void* d_out, int out_size, void* d_ws, size_t ws_size, hipStream_t stream) {
    static int grid = 0;
    if (grid == 0) {
        if (n_in != 20 || in_sizes[0] != MLAT * DM || out_size != MLAT * DM || ws_size < WS_END) { fprintf(stderr, "kernel_launch: unexpected shapes (n_in %d, in0 %d, out %d, ws %zu)\n", n_in, n_in > 0 ? in_sizes[0] : -1, out_size, ws_size); grid = -1; return; }
        int dev = 0, cus = 0, per_cu = 0;
        if (hipGetDevice(&dev) != hipSuccess || hipDeviceGetAttribute(&cus, hipDeviceAttributeMultiprocessorCount, dev) != hipSuccess) { fprintf(stderr, "kernel_launch: device query failed\n"); grid = -1; return; }
        if (hipFuncSetAttribute((const void*)mk_fwd, hipFuncAttributeMaxDynamicSharedMemorySize, LDS_BYTES) != hipSuccess) { fprintf(stderr, "kernel_launch: hipFuncSetAttribute failed\n"); grid = -1; return; }
        if (hipOccupancyMaxActiveBlocksPerMultiprocessor(&per_cu, (const void*)mk_fwd, NTHREADS, LDS_BYTES) != hipSuccess || per_cu < 1) { fprintf(stderr, "kernel_launch: occupancy query says %d blocks per CU\n", per_cu); (void)hipGetLastError(); grid = -1; return; }
        grid = cus;
    }
    if (grid < 0) return;
    if (hipMemsetAsync((char*)d_ws + WS_CTL, 0, CTL_ZERO_BYTES, stream) != hipSuccess) { fprintf(stderr, "kernel_launch: hipMemsetAsync failed\n"); return; }
    Args a{};
    for (int i = 0; i < 20; ++i) a.in[i] = (const float*)d_in[i];
    a.out = (float*)d_out; a.ws = (unsigned char*)d_ws;
#if MK_PER_PHASE
    for (int p = 0; p < NPHASES; ++p) { a.ph_lo = p; a.ph_hi = p + 1; void* kargs[] = {&a};
        hipError_t e = hipLaunchCooperativeKernel((const void*)mk_fwd, dim3(grid), dim3(NTHREADS), kargs, LDS_BYTES, stream);
        if (e != hipSuccess) { fprintf(stderr, "kernel_launch: launch of phase %d failed: %s\n", p, hipGetErrorString(e)); break; } }
#else
    a.ph_lo = 0; a.ph_hi = NPHASES; void* kargs[] = {&a};
    hipError_t e = hipLaunchCooperativeKernel((const void*)mk_fwd, dim3(grid), dim3(NTHREADS), kargs, LDS_BYTES, stream);
    if (e != hipSuccess) fprintf(stderr, "kernel_launch: cooperative launch failed: %s (grid %d)\n", hipGetErrorString(e), grid);
#endif
}
```
